# Optimizing an MI355X kernel written in HIP

```python
import math
import jax, jax.numpy as jnp
from jax import lax
import numpy as np

D_MODEL = 4096
BATCH = 2
SEQ = 4096
DEPTH = 2

HEAD_DIM = 128
DIFF_V_DIM = 2 * HEAD_DIM
DIFF_HEADS = D_MODEL // (4 * DIFF_V_DIM)
MOBA_HEADS = (D_MODEL - DIFF_HEADS * DIFF_V_DIM) // (2 * HEAD_DIM)
FOX_HEADS = MOBA_HEADS
MOBA_WIDTH = MOBA_HEADS * HEAD_DIM
FOX_WIDTH = FOX_HEADS * HEAD_DIM
DIFF_QK_WIDTH = DIFF_HEADS * 2 * HEAD_DIM
DIFF_WIDTH = DIFF_HEADS * DIFF_V_DIM
MIX_WIDTH = MOBA_WIDTH + FOX_WIDTH + DIFF_WIDTH
IN_SIZES = [MOBA_WIDTH] * 3 + [FOX_WIDTH] * 3 + [FOX_HEADS] + [DIFF_QK_WIDTH] * 2 + [DIFF_WIDTH]
IN_WIDTH = sum(IN_SIZES)
FFN_DIM = -(-8 * D_MODEL // (3 * 256)) * 256
MOBA_BLOCK = 256
MOBA_TOPK = 3
MOBA_QCHUNK = 32
DENSE_QBLOCK = 128
ROPE_THETA = 10000.0
NORM_EPS = 1e-6
NEG_INF = -1e30

kernel_name = "hybrid_moba_fox_diff_parallel_heads"


def rms_norm(x, g):
    xf = x.astype(jnp.float32)
    y = xf * lax.rsqrt(jnp.mean(xf * xf, axis=-1, keepdims=True) + NORM_EPS)
    return (y * g.astype(jnp.float32)).astype(x.dtype)


def rotary_tables(seq):
    inv_freq = 1.0 / (ROPE_THETA ** (jnp.arange(0, HEAD_DIM, 2, dtype=jnp.float32) / HEAD_DIM))
    ang = jnp.arange(seq, dtype=jnp.float32)[:, None] * inv_freq[None, :]
    return jnp.cos(ang), jnp.sin(ang)


def apply_rotary(x, cos, sin):
    half = x.shape[-1] // 2
    shape = (x.shape[1],) + (1,) * (x.ndim - 3) + (half,)
    c, s = cos.reshape(shape), sin.reshape(shape)
    xf = x.astype(jnp.float32)
    x1, x2 = xf[..., :half], xf[..., half:]
    return jnp.concatenate([x1 * c - x2 * s, x2 * c + x1 * s], axis=-1).astype(x.dtype)


def _causal_mask(start, end):
    q_pos = jnp.arange(start, end)
    k_pos = jnp.arange(end)
    return k_pos[None, :] <= q_pos[:, None]


def _sweep_query_blocks(block_fn, seq):
    return jnp.concatenate([block_fn(s, s + DENSE_QBLOCK) for s in range(0, seq, DENSE_QBLOCK)], axis=1)


def moba_attention(q, k, v):
    B, S, H, D = q.shape
    nb = -(-S // MOBA_BLOCK)
    s_pad = nb * MOBA_BLOCK
    if s_pad != S:
        pw = ((0, 0), (0, s_pad - S), (0, 0), (0, 0))
        q, k, v = jnp.pad(q, pw), jnp.pad(k, pw), jnp.pad(v, pw)
    scale = D ** -0.5
    qh = q.transpose(0, 2, 1, 3)
    kb = k.transpose(0, 2, 1, 3).reshape(B, H, nb, MOBA_BLOCK, D)
    vb = v.transpose(0, 2, 1, 3).reshape(B, H, nb, MOBA_BLOCK, D)
    topk = min(MOBA_TOPK, nb - 1)
    if topk > 0:
        k_mean = jnp.mean(kb.astype(jnp.float32), axis=3)
        gate = jnp.einsum('bhsd,bhnd->bhsn', qh.astype(jnp.float32), k_mean)
        q_block = jnp.arange(s_pad) // MOBA_BLOCK
        fully_past = jnp.arange(nb)[None, :] < q_block[:, None]
        gate = jnp.where(fully_past, gate, NEG_INF)
        _, sel = lax.top_k(gate, topk)
        sel_valid = sel < q_block[None, None, :, None]
    gather_blocks = jax.vmap(jax.vmap(lambda blocks, idx: blocks[idx]))

    def chunk(i):
        start = i * MOBA_QCHUNK
        blk = start // MOBA_BLOCK
        q_c = lax.dynamic_slice_in_dim(qh, start, MOBA_QCHUNK, axis=2)
        k_own = lax.dynamic_index_in_dim(kb, blk, axis=2, keepdims=False)
        v_own = lax.dynamic_index_in_dim(vb, blk, axis=2, keepdims=False)
        q_pos = start + jnp.arange(MOBA_QCHUNK)
        k_pos = blk * MOBA_BLOCK + jnp.arange(MOBA_BLOCK)
        s_own = jnp.einsum('bhcd,bhkd->bhck', q_c, k_own).astype(jnp.float32) * scale
        s_own = jnp.where(k_pos[None, :] <= q_pos[:, None], s_own, NEG_INF)
        if topk == 0:
            p = jax.nn.softmax(s_own, axis=-1).astype(v.dtype)
            return jnp.einsum('bhck,bhkd->bhcd', p, v_own)
        sel_c = lax.dynamic_slice_in_dim(sel, start, MOBA_QCHUNK, axis=2)
        valid_c = lax.dynamic_slice_in_dim(sel_valid, start, MOBA_QCHUNK, axis=2)
        k_sel = gather_blocks(kb, sel_c)
        v_sel = gather_blocks(vb, sel_c)
        s_sel = jnp.einsum('bhcd,bhcjkd->bhcjk', q_c, k_sel).astype(jnp.float32) * scale
        s_sel = jnp.where(valid_c[..., None], s_sel, NEG_INF)
        s_all = jnp.concatenate([s_sel.reshape(B, H, MOBA_QCHUNK, topk * MOBA_BLOCK), s_own], axis=-1)
        p = jax.nn.softmax(s_all, axis=-1).astype(v.dtype)
        p_sel = p[..., :topk * MOBA_BLOCK].reshape(B, H, MOBA_QCHUNK, topk, MOBA_BLOCK)
        p_own = p[..., topk * MOBA_BLOCK:]
        return (jnp.einsum('bhcjk,bhcjkd->bhcd', p_sel, v_sel)
                + jnp.einsum('bhck,bhkd->bhcd', p_own, v_own))

    outs = lax.map(chunk, jnp.arange(s_pad // MOBA_QCHUNK))
    out = outs.transpose(1, 0, 3, 2, 4).reshape(B, s_pad, H, D)
    return out[:, :S]


def forgetting_attention(q, k, v, log_f):
    S, D = q.shape[1], q.shape[-1]
    scale = D ** -0.5
    cum = jnp.cumsum(log_f.astype(jnp.float32), axis=1).transpose(0, 2, 1)

    def block(start, end):
        s = jnp.einsum('bqhd,bkhd->bhqk', q[:, start:end], k[:, :end]).astype(jnp.float32) * scale
        s = s + cum[:, :, start:end, None] - cum[:, :, None, :end]
        s = jnp.where(_causal_mask(start, end), s, NEG_INF)
        p = jax.nn.softmax(s, axis=-1).astype(v.dtype)
        return jnp.einsum('bhqk,bkhd->bqhd', p, v[:, :end])

    return _sweep_query_blocks(block, S)


def differential_attention(q, k, v, lam):
    S, D = q.shape[1], q.shape[-1]
    scale = D ** -0.5

    def block(start, end):
        s = jnp.einsum('bqhmd,bkhmd->bhmqk', q[:, start:end], k[:, :end]).astype(jnp.float32) * scale
        s = jnp.where(_causal_mask(start, end), s, NEG_INF)
        p = jax.nn.softmax(s, axis=-1)
        p = (p[:, :, 0] - lam * p[:, :, 1]).astype(v.dtype)
        return jnp.einsum('bhqk,bkhe->bqhe', p, v[:, :end])

    return _sweep_query_blocks(block, S)


def setup_inputs(seed: int = 0) -> dict:
    key = jax.random.key(seed)
    ks = jax.random.split(key, 24)
    f32 = jnp.float32
    nrm = lambda k, shape, scale: jax.random.normal(k, shape, f32) * scale
    gain = lambda k, shape: 1.0 + 0.02 * jax.random.normal(k, shape, f32)
    return {
        "x": nrm(ks[0], (BATCH, SEQ, D_MODEL), 1.0),
        "attn_norm": gain(ks[1], (DEPTH, D_MODEL)),
        "w_in": nrm(ks[2], (DEPTH, D_MODEL, IN_WIDTH), D_MODEL ** -0.5),
        "moba_q_norm": gain(ks[3], (DEPTH, HEAD_DIM)),
        "moba_k_norm": gain(ks[4], (DEPTH, HEAD_DIM)),
        "fox_q_norm": gain(ks[5], (DEPTH, HEAD_DIM)),
        "fox_k_norm": gain(ks[6], (DEPTH, HEAD_DIM)),
        "fox_forget_bias": jax.random.uniform(ks[7], (DEPTH, FOX_HEADS), f32, 1.0, 4.0),
        "diff_q_norm": gain(ks[8], (DEPTH, HEAD_DIM)),
        "diff_k_norm": gain(ks[9], (DEPTH, HEAD_DIM)),
        "diff_lambda_q1": nrm(ks[10], (DEPTH, HEAD_DIM), 0.1),
        "diff_lambda_k1": nrm(ks[11], (DEPTH, HEAD_DIM), 0.1),
        "diff_lambda_q2": nrm(ks[12], (DEPTH, HEAD_DIM), 0.1),
        "diff_lambda_k2": nrm(ks[13], (DEPTH, HEAD_DIM), 0.1),
        "diff_sub_norm": gain(ks[14], (DEPTH, DIFF_V_DIM)),
        "w_out": nrm(ks[15], (DEPTH, MIX_WIDTH, D_MODEL), MIX_WIDTH ** -0.5),
        "ffn_norm": gain(ks[16], (DEPTH, D_MODEL)),
        "w_gate": nrm(ks[17], (DEPTH, D_MODEL, FFN_DIM), D_MODEL ** -0.5),
        "w_up": nrm(ks[18], (DEPTH, D_MODEL, FFN_DIM), D_MODEL ** -0.5),
        "w_down": nrm(ks[19], (DEPTH, FFN_DIM, D_MODEL), FFN_DIM ** -0.5),
    }


def reference(x, attn_norm, w_in, moba_q_norm, moba_k_norm, fox_q_norm, fox_k_norm,
              fox_forget_bias, diff_q_norm, diff_k_norm, diff_lambda_q1, diff_lambda_k1,
              diff_lambda_q2, diff_lambda_k2, diff_sub_norm, w_out, ffn_norm, w_gate, w_up, w_down):
    B, S, _ = x.shape
    cos, sin = rotary_tables(S)
    split_idx = np.cumsum(IN_SIZES)[:-1].tolist()
    for l in range(DEPTH):
        h = rms_norm(x, attn_norm[l])
        proj = jnp.einsum('bsd,de->bse', h, w_in[l])
        q_m, k_m, v_m, q_f, k_f, v_f, f_logit, q_d, k_d, v_d = jnp.split(proj, split_idx, axis=-1)

        q_m = apply_rotary(rms_norm(q_m.reshape(B, S, MOBA_HEADS, HEAD_DIM), moba_q_norm[l]), cos, sin)
        k_m = apply_rotary(rms_norm(k_m.reshape(B, S, MOBA_HEADS, HEAD_DIM), moba_k_norm[l]), cos, sin)
        o_a = moba_attention(q_m, k_m, v_m.reshape(B, S, MOBA_HEADS, HEAD_DIM))

        q_f = rms_norm(q_f.reshape(B, S, FOX_HEADS, HEAD_DIM), fox_q_norm[l])
        k_f = rms_norm(k_f.reshape(B, S, FOX_HEADS, HEAD_DIM), fox_k_norm[l])
        log_f = jax.nn.log_sigmoid(f_logit.astype(jnp.float32) + fox_forget_bias[l].astype(jnp.float32))
        o_b = forgetting_attention(q_f, k_f, v_f.reshape(B, S, FOX_HEADS, HEAD_DIM), log_f)

        lam_init = 0.8 - 0.6 * math.exp(-0.3 * l)
        lam = (jnp.exp(jnp.sum(diff_lambda_q1[l].astype(jnp.float32) * diff_lambda_k1[l].astype(jnp.float32)))
               - jnp.exp(jnp.sum(diff_lambda_q2[l].astype(jnp.float32) * diff_lambda_k2[l].astype(jnp.float32)))
               + lam_init)
        q_d = apply_rotary(rms_norm(q_d.reshape(B, S, DIFF_HEADS, 2, HEAD_DIM), diff_q_norm[l]), cos, sin)
        k_d = apply_rotary(rms_norm(k_d.reshape(B, S, DIFF_HEADS, 2, HEAD_DIM), diff_k_norm[l]), cos, sin)
        o_c = differential_attention(q_d, k_d, v_d.reshape(B, S, DIFF_HEADS, DIFF_V_DIM), lam)
        o_c = rms_norm(o_c, diff_sub_norm[l]) * (1.0 - lam_init)

        mixed = jnp.concatenate([o_a.reshape(B, S, MOBA_WIDTH), o_b.reshape(B, S, FOX_WIDTH),
                                 o_c.reshape(B, S, DIFF_WIDTH)], axis=-1)
        x = x + jnp.einsum('bse,ed->bsd', mixed, w_out[l])

        h = rms_norm(x, ffn_norm[l])
        g = jnp.einsum('bsd,df->bsf', h, w_gate[l])
        u = jnp.einsum('bsd,df->bsf', h, w_up[l])
        x = x + jnp.einsum('bsf,fd->bsd', jax.nn.silu(g) * u, w_down[l])
    return x
```

```cpp
#include <hip/hip_runtime.h>
#include <cstdio>
#include <cstdint>
#include <cmath>
namespace pg8 {
#define PG8_LAS __attribute__((address_space(3)))
typedef unsigned short bf16_t;
typedef short bf16x8 __attribute__((ext_vector_type(8)));
typedef float f32x4 __attribute__((ext_vector_type(4)));
typedef unsigned u32x4 __attribute__((ext_vector_type(4)));
constexpr int BM = 256, BK = 64, HALF = 128, HTB = HALF * BK * 2  , STAGE_BYTES = 8 * HTB, NXCD = 8, WGM = 8;

__host__ __device__ __forceinline__ int lds_byte(int r, int c) { const int st = (r >> 4) * 2 + (c >> 5), rr = r & 15, cc = c & 31, ob = rr * 64 + cc * 2; return st * 1024 + (ob ^ (((ob >> 9) & 1) << 5)); }
__host__ __device__ __forceinline__ void stage_rc(int b, int& R, int& C) { const int st = b / 1024, sb = b % 1024, swz = sb ^ (((sb >> 9) & 1) << 5); R = (st >> 1) * 16 + swz / 64; C = (st & 1) * 32 + (swz % 64) / 2; }
__host__ __device__ __forceinline__ int perm32(int rho) { const int n = rho >> 4, i = rho & 15; return 8 * (i >> 2) + 4 * n + (i & 3); }

struct Unit { int pm, pn; };
struct Gemm { const bf16_t* A; const bf16_t* Bt; int M, N, K; };

struct StaticOrder {
    int nM, nN, nwg, G, c;
    __host__ __device__ void init(int M, int N, int G_, int c_) { nM = M / BM; nN = N / BM; nwg = nM * nN; G = G_; c = c_; }
    __host__ __device__ bool next(int i, Unit& u) const {
        const long L = (long)i * G + c; if (L >= nwg) return false;
        int wgid = (int)L; { const int q = nwg / NXCD, r = nwg % NXCD, xcd = wgid % NXCD, off = wgid / NXCD; wgid = (xcd < r ? xcd * (q + 1) : r * (q + 1) + (xcd - r) * q) + off; }
        const int nig = WGM * nN, gid = wgid / nig, fm = gid * WGM, gsz = (nM - fm) < WGM ? (nM - fm) : WGM;
        u.pm = fm + ((wgid % nig) % gsz); u.pn = (wgid % nig) / gsz; return true;
    }
    __device__ __forceinline__ void a_ready(const Unit&) const {}
    __device__ __forceinline__ void done(const Unit&) const {}
};

__device__ __forceinline__ unsigned cvt_pk_bf16(float lo, float hi) { unsigned r; asm volatile("v_cvt_pk_bf16_f32 %0, %1, %2" : "=v"(r) : "v"(lo), "v"(hi)); return r; }
struct EpiStoreBf16 {
    static constexpr bool PERM = true, AFTER_DRAIN = false;
    bf16_t* O; int ldc;
    __device__ __forceinline__ void operator()(const f32x4 (&acc)[2][2][4][2], const Unit& u, int wr, int wc, int fr, int fq) const {
        const int row0 = u.pm * BM + wr * 64 + fr, col0 = u.pn * BM + wc * 32 + 8 * fq;
#pragma unroll
        for (int ai = 0; ai < 2; ++ai)
#pragma unroll
            for (int m = 0; m < 4; ++m) { bf16_t* rowp = O + (size_t)(row0 + ai * HALF + m * 16) * ldc + col0;
#pragma unroll
                for (int bj = 0; bj < 2; ++bj) { const f32x4 v0 = acc[ai][bj][m][0], v1 = acc[ai][bj][m][1];
                    u32x4 w; w.x = cvt_pk_bf16(v0[0], v0[1]); w.y = cvt_pk_bf16(v0[2], v0[3]); w.z = cvt_pk_bf16(v1[0], v1[1]); w.w = cvt_pk_bf16(v1[2], v1[3]);
                    *(u32x4*)(rowp + bj * HALF) = w; } }
    }
};
__device__ __forceinline__ float silu_mul(float g, float u) { const float e = __builtin_amdgcn_exp2f(-g * 1.4426950408889634f); return g * __builtin_amdgcn_rcpf(1.0f + e) * u; }
struct EpiSwiGLU {
    static constexpr bool PERM = true, AFTER_DRAIN = false;
    bf16_t* O; int ldc;
    __device__ __forceinline__ void operator()(const f32x4 (&acc)[2][2][4][2], const Unit& u, int wr, int wc, int fr, int fq) const {
        const int row0 = u.pm * BM + wr * 64 + fr, col0 = u.pn * HALF + wc * 32 + 8 * fq;
#pragma unroll
        for (int ai = 0; ai < 2; ++ai)
#pragma unroll
            for (int m = 0; m < 4; ++m) { bf16_t* rowp = O + (size_t)(row0 + ai * HALF + m * 16) * ldc + col0;
                const f32x4 g0 = acc[ai][0][m][0], g1 = acc[ai][0][m][1], u0 = acc[ai][1][m][0], u1 = acc[ai][1][m][1];
                u32x4 w; w.x = cvt_pk_bf16(silu_mul(g0[0], u0[0]), silu_mul(g0[1], u0[1])); w.y = cvt_pk_bf16(silu_mul(g0[2], u0[2]), silu_mul(g0[3], u0[3]));
                w.z = cvt_pk_bf16(silu_mul(g1[0], u1[0]), silu_mul(g1[1], u1[1])); w.w = cvt_pk_bf16(silu_mul(g1[2], u1[2]), silu_mul(g1[3], u1[3]));
                *(u32x4*)rowp = w; }
    }
};
struct EpiResid {
    static constexpr bool PERM = false, AFTER_DRAIN = false;
    const float* base; float* out; int ldc;
    __device__ __forceinline__ void operator()(const f32x4 (&acc)[2][2][4][2], const Unit& u, int wr, int wc, int fr, int fq) const {
        const int row0 = u.pm * BM + wr * 64 + fr, col0 = u.pn * BM + wc * 32 + 4 * fq;
#pragma unroll
        for (int ai = 0; ai < 2; ++ai)
#pragma unroll
            for (int m = 0; m < 4; ++m) { const size_t off = (size_t)(row0 + ai * HALF + m * 16) * ldc + col0;
#pragma unroll
                for (int bj = 0; bj < 2; ++bj)
#pragma unroll
                    for (int n = 0; n < 2; ++n) { const f32x4 b = *(const f32x4*)(base + off + bj * HALF + n * 16); *(f32x4*)(out + off + bj * HALF + n * 16) = b + acc[ai][bj][m][n]; } }
    }
};

template <class Epi, class Sched, bool ALIGN_EPI = false, bool SP2 = false>
__device__ __forceinline__ void gemm_phase(PG8_LAS unsigned char* lds, const Gemm g, const Sched& S, const Epi& E) {
    int tid_ = threadIdx.x; asm volatile("" : "+v"(tid_));
    const int tid = tid_, wid = __builtin_amdgcn_readfirstlane(tid >> 6), lane = tid & 63, wr = wid >> 2, wc = wid & 3, fr = lane & 15, fq = lane >> 4;
    const int K = g.K, nt = K / BK;
    unsigned voffA[2], voffB[2];
#pragma unroll
    for (int i = 0; i < 2; ++i) { int R, C; stage_rc(tid * 16 + i * 8192, R, C); const int Rb = Epi::PERM ? ((R & ~31) + perm32(R & 31)) : R;
        voffA[i] = (unsigned)(R * K + C) * 2u; voffB[i] = (unsigned)(Rb * K + C) * 2u; }
    const size_t kstep = (size_t)(BK * 2);
    const size_t hstep = (size_t)HALF * K * 2;
    const size_t tstep = 2 * hstep;
    const unsigned ldsw = (unsigned)wid * 1024u;
    const int aoff = lds_byte(wr * 64 + fr, fq * 8), boff = lds_byte(wc * 32 + fr, fq * 8);
#define PG8_SA(b, h) (((b) * 2 + (h)) * HTB)
#define PG8_SB(b, h) ((4 + (b) * 2 + (h)) * HTB)
#define PG8_STAGE(bufoff, gbase, voff) do { _Pragma("unroll") for (int _i = 0; _i < 2; ++_i) \
        __builtin_amdgcn_global_load_lds((const unsigned*)((const char*)(gbase) + (voff)[_i]), (PG8_LAS unsigned*)(lds + (bufoff) + ldsw + _i * 8192), 16, 0, 0); } while (0)
#define PG8_LDA(dst, b, h) do { _Pragma("unroll") for (int m = 0; m < 4; ++m) _Pragma("unroll") for (int k = 0; k < 2; ++k) dst[m][k] = *(const PG8_LAS bf16x8*)(lds + PG8_SA(b, h) + aoff + m * 2048 + k * 1024); } while (0)
#define PG8_LDB(dst, b, h) do { _Pragma("unroll") for (int n = 0; n < 2; ++n) _Pragma("unroll") for (int k = 0; k < 2; ++k) dst[n][k] = *(const PG8_LAS bf16x8*)(lds + PG8_SB(b, h) + boff + n * 2048 + k * 1024); } while (0)
#define PG8_MMA(ai, bj, At, Bt) do { __builtin_amdgcn_s_setprio(1); _Pragma("unroll") for (int m = 0; m < 4; ++m) _Pragma("unroll") for (int n = 0; n < 2; ++n) _Pragma("unroll") for (int k = 0; k < 2; ++k) \
        acc[ai][bj][m][n] = __builtin_amdgcn_mfma_f32_16x16x32_bf16(Bt[n][k], At[m][k], acc[ai][bj][m][n], 0, 0, 0); __builtin_amdgcn_s_setprio(0); } while (0)
#define PG8_WAIT_V(n) asm volatile("s_waitcnt vmcnt(" #n ")" ::: "memory")
#define PG8_WAIT_L(n) asm volatile("s_waitcnt lgkmcnt(" #n ")" ::: "memory")
#define PG8_BAR __builtin_amdgcn_s_barrier()
#define PG8_SCHED __builtin_amdgcn_sched_barrier(0)
    Unit cur, nxt; int ui = 0;
    if (!S.next(0, cur)) return;
    f32x4 acc[2][2][4][2];
#pragma unroll
    for (int a = 0; a < 2; ++a)
#pragma unroll
        for (int b = 0; b < 2; ++b)
#pragma unroll
            for (int m = 0; m < 4; ++m)
#pragma unroll
                for (int n = 0; n < 2; ++n) acc[a][b][m][n] = (f32x4){0.f, 0.f, 0.f, 0.f};
    bf16x8 At[4][2], B0[2][2], B1[2][2];
    const char* cA = (const char*)g.A + (size_t)cur.pm * tstep; const char* cB = (const char*)g.Bt + (size_t)cur.pn * tstep;
    S.a_ready(cur);
    if constexpr (SP2) {
        PG8_STAGE(PG8_SB(0, 0), cB, voffB); PG8_STAGE(PG8_SB(0, 1), cB + hstep, voffB); PG8_STAGE(PG8_SA(0, 0), cA, voffA); PG8_STAGE(PG8_SA(0, 1), cA + hstep, voffA);
        if (wr == 1) PG8_BAR;
        PG8_WAIT_V(2); PG8_BAR;
        PG8_STAGE(PG8_SB(1, 0), cB + kstep, voffB); PG8_STAGE(PG8_SA(1, 0), cA + kstep, voffA); PG8_STAGE(PG8_SB(1, 1), cB + hstep + kstep, voffB);
        PG8_WAIT_V(6); PG8_BAR;
    } else {
        PG8_STAGE(PG8_SB(0, 0), cB, voffB); PG8_STAGE(PG8_SA(0, 0), cA, voffA); PG8_STAGE(PG8_SB(0, 1), cB + hstep, voffB); PG8_STAGE(PG8_SA(0, 1), cA + hstep, voffA);
        if (wr == 1) PG8_BAR;
        PG8_WAIT_V(4); PG8_BAR;
        PG8_STAGE(PG8_SB(1, 0), cB + kstep, voffB); PG8_STAGE(PG8_SA(1, 0), cA + kstep, voffA); PG8_STAGE(PG8_SB(1, 1), cB + hstep + kstep, voffB);
        PG8_WAIT_V(6); PG8_BAR;
    }
    for (;;) {
        const bool has_next = S.next(ui + 1, nxt);
        const char* nA = has_next ? (const char*)g.A + (size_t)nxt.pm * tstep : cA; const char* nB = has_next ? (const char*)g.Bt + (size_t)nxt.pn * tstep : cB;
        for (int t = 0; t < nt; t += 2) {
            const bool last = (t == nt - 2);
            const char* a1 = cA + (size_t)(t + 1) * kstep;
            const char* a2 = last ? nA : cA + (size_t)(t + 2) * kstep; const char* b2 = last ? nB : cB + (size_t)(t + 2) * kstep;
            const char* a3 = a2 + kstep; const char* b3 = b2 + kstep;
            if (last && has_next) S.a_ready(nxt);
            if constexpr (SP2) {
            PG8_LDB(B0, 0, 0); PG8_LDB(B1, 0, 1); PG8_SCHED; PG8_LDA(At, 0, 0); PG8_STAGE(PG8_SA(1, 1), a1 + hstep, voffA);
            PG8_WAIT_V(8); PG8_WAIT_L(0); PG8_BAR; PG8_MMA(0, 0, At, B0); PG8_MMA(0, 1, At, B1); PG8_BAR; PG8_SCHED;
            PG8_LDA(At, 0, 1); PG8_STAGE(PG8_SB(0, 0), b2, voffB); PG8_STAGE(PG8_SB(0, 1), b2 + hstep, voffB); PG8_STAGE(PG8_SA(0, 0), a2, voffA);
            PG8_WAIT_V(8); PG8_WAIT_L(0); PG8_BAR; PG8_MMA(1, 0, At, B0); PG8_MMA(1, 1, At, B1); PG8_BAR; PG8_SCHED;
            PG8_LDB(B0, 1, 0); PG8_LDB(B1, 1, 1); PG8_SCHED; PG8_LDA(At, 1, 0); PG8_STAGE(PG8_SA(0, 1), a2 + hstep, voffA);
            PG8_WAIT_V(8); PG8_WAIT_L(0); PG8_BAR; PG8_MMA(0, 0, At, B0); PG8_MMA(0, 1, At, B1); PG8_BAR; PG8_SCHED;
            PG8_LDA(At, 1, 1); PG8_STAGE(PG8_SB(1, 0), b3, voffB); PG8_STAGE(PG8_SB(1, 1), b3 + hstep, voffB); PG8_STAGE(PG8_SA(1, 0), a3, voffA);
            PG8_WAIT_V(8); PG8_WAIT_L(0); PG8_BAR; PG8_MMA(1, 0, At, B0); PG8_MMA(1, 1, At, B1); PG8_BAR; PG8_SCHED;
            } else {
            PG8_LDB(B0, 0, 0); PG8_SCHED; PG8_LDA(At, 0, 0); PG8_STAGE(PG8_SA(1, 1), a1 + hstep, voffA);
            PG8_WAIT_L(8); PG8_BAR; PG8_WAIT_L(0); PG8_MMA(0, 0, At, B0); PG8_BAR; PG8_SCHED;
            PG8_LDB(B1, 0, 1); PG8_STAGE(PG8_SB(0, 0), b2, voffB);
            PG8_BAR; PG8_WAIT_L(0); PG8_MMA(0, 1, At, B1); PG8_BAR;
            PG8_LDA(At, 0, 1); PG8_STAGE(PG8_SA(0, 0), a2, voffA);
            PG8_BAR; PG8_WAIT_L(0); PG8_MMA(1, 0, At, B0); PG8_BAR; PG8_SCHED;
            PG8_STAGE(PG8_SB(0, 1), b2 + hstep, voffB);
            PG8_WAIT_V(6); PG8_BAR; PG8_MMA(1, 1, At, B1); PG8_BAR;
            PG8_LDB(B0, 1, 0); PG8_SCHED; PG8_LDA(At, 1, 0); PG8_STAGE(PG8_SA(0, 1), a2 + hstep, voffA);
            PG8_WAIT_L(8); PG8_BAR; PG8_WAIT_L(0); PG8_MMA(0, 0, At, B0); PG8_BAR; PG8_SCHED;
            PG8_LDB(B1, 1, 1); PG8_STAGE(PG8_SB(1, 0), b3, voffB);
            PG8_BAR; PG8_WAIT_L(0); PG8_MMA(0, 1, At, B1); PG8_BAR;
            PG8_LDA(At, 1, 1); PG8_STAGE(PG8_SA(1, 0), a3, voffA);
            PG8_BAR; PG8_WAIT_L(0); PG8_MMA(1, 0, At, B0); PG8_BAR; PG8_SCHED;
            PG8_STAGE(PG8_SB(1, 1), b3 + hstep, voffB);
            PG8_WAIT_V(6); PG8_BAR; PG8_MMA(1, 1, At, B1); PG8_BAR;
            }
        }
        if constexpr (ALIGN_EPI) { if (wr == 0) PG8_BAR; }
        if constexpr (!Epi::AFTER_DRAIN) { E(acc, cur, wr, wc, fr, fq); S.done(cur); }
        if (!has_next) break;
#pragma unroll
        for (int a = 0; a < 2; ++a)
#pragma unroll
            for (int b = 0; b < 2; ++b)
#pragma unroll
                for (int m = 0; m < 4; ++m)
#pragma unroll
                    for (int n = 0; n < 2; ++n) acc[a][b][m][n] = (f32x4){0.f, 0.f, 0.f, 0.f};
        cur = nxt; cA = nA; cB = nB; ++ui;
        if constexpr (ALIGN_EPI) { if (wr == 1) PG8_BAR; }
    }
    PG8_WAIT_V(0);
    if constexpr (!ALIGN_EPI) { if (wr == 0) PG8_BAR; }
    PG8_BAR;
    if constexpr (Epi::AFTER_DRAIN) { E.fused(acc, cur, wr, wc, fr, fq, lds, wid, lane); S.done(cur); }
#undef PG8_SA
#undef PG8_SB
#undef PG8_STAGE
#undef PG8_LDA
#undef PG8_LDB
#undef PG8_MMA
#undef PG8_WAIT_V
#undef PG8_WAIT_L
#undef PG8_BAR
#undef PG8_SCHED
}
}
#ifndef MK_N_LAUNCHES
#define MK_N_LAUNCHES 0
#endif
constexpr int NWAVES = 8;
constexpr int BATCH = 2, SEQ = 4096, DM = 4096, M = BATCH * SEQ, DEPTH = 2;
constexpr int HD = 128, NH_M = 12, NH_F = 12, NH_D = 4;
constexpr int INW = 12300;
constexpr int PW = 12288;
constexpr int FF = 11008, NGU = 2 * FF;
constexpr int C_QM = 0, C_KM = 1536, C_VM = 3072, C_QF = 4608, C_KF = 6144, C_VF = 7680, C_QD = 9216, C_KD = 10240, C_VD = 11264;
constexpr int NBLK = SEQ / 256;
constexpr float NORM_EPS = 1e-6f;
constexpr int NATT = 40;
constexpr int NPH = 1 + 10 * DEPTH;
constexpr size_t MiB = 1u << 20;
constexpr size_t WS_CTL = 0, CTL_ZERO_BYTES = 1 * MiB;
constexpr size_t WS_ROPE = 1 * MiB;
constexpr size_t WS_WF = 3 * MiB;
constexpr size_t WS_LOGF = 4 * MiB;
constexpr size_t WS_BRAW = 5 * MiB;
constexpr size_t WS_SELM = 6 * MiB;
constexpr size_t WS_KPART = 7 * MiB;
constexpr size_t WS_WIN = 16 * MiB;
constexpr size_t WS_WOUT = 208 * MiB;
constexpr size_t WS_WGU = 272 * MiB;
constexpr size_t WS_WD = 616 * MiB;
constexpr size_t WS_XN = 788 * MiB;
constexpr size_t WS_PROJ = 852 * MiB;
constexpr size_t WS_HB = 852 * MiB;
constexpr size_t WS_MIX = 1044 * MiB;
constexpr size_t WS_DIFF = 1108 * MiB;
constexpr size_t WS_XB = 1140 * MiB;
constexpr size_t WS_END = 1268 * MiB;
static_assert(WS_WIN + (size_t)DEPTH * PW * DM * 2 <= WS_WOUT && WS_WOUT + (size_t)DEPTH * DM * DM * 2 <= WS_WGU && WS_WGU + (size_t)DEPTH * NGU * DM * 2 <= WS_WD && WS_WD + (size_t)DEPTH * DM * FF * 2 <= WS_XN, "ws map (weights)");
static_assert(WS_XN + (size_t)M * DM * 2 <= WS_PROJ && WS_PROJ + (size_t)M * PW * 2 <= WS_MIX && WS_HB + (size_t)M * FF * 2 <= WS_MIX && WS_MIX + (size_t)M * DM * 2 <= WS_DIFF && WS_DIFF + (size_t)2 * M * 1024 * 2 <= WS_XB && WS_XB + (size_t)M * DM * 4 <= WS_END, "ws map (activations)");
constexpr int CW_TMO = 0, CW_CODE = 1, CW_BAR = 4096;
constexpr int RING_OFF = 0, RING_BYTES = 131072;
constexpr int LDSCTL_OFF = RING_BYTES, MISC_OFF = LDSCTL_OFF + 320;
constexpr int LDS_BYTES = 147456;

#define GAS __attribute__((address_space(1)))
#define LAS __attribute__((address_space(3)))
typedef unsigned short bf16;
typedef unsigned v4u __attribute__((ext_vector_type(4)));
typedef unsigned v2u __attribute__((ext_vector_type(2)));
typedef float f32x4 __attribute__((ext_vector_type(4)));
typedef float f32x2 __attribute__((ext_vector_type(2)));
typedef short bf16x8 __attribute__((ext_vector_type(8)));
typedef GAS unsigned gu32;
#define RLX_AGENT __ATOMIC_RELAXED, __HIP_MEMORY_SCOPE_AGENT
#define LDS_WAIT() asm volatile("s_waitcnt lgkmcnt(0)" ::: "memory")
#define VM_WAIT() asm volatile("s_waitcnt vmcnt(0)" ::: "memory")
__device__ __forceinline__ unsigned f2bf(float f) { unsigned u = __builtin_bit_cast(unsigned, f); return (u + 0x7fffu + ((u >> 16) & 1u)) >> 16; }
__device__ __forceinline__ unsigned pk2(float lo, float hi) { return f2bf(lo) | (f2bf(hi) << 16); }
__device__ __forceinline__ float bflo(unsigned w) { return __uint_as_float(w << 16); }
__device__ __forceinline__ float bfhi(unsigned w) { return __uint_as_float(w & 0xffff0000u); }
__device__ __forceinline__ float bf2f(bf16 b) { return __uint_as_float((unsigned)b << 16); }
__device__ __forceinline__ float wave_sum(float v) {
#pragma unroll
    for (int o = 1; o < 64; o <<= 1) v += __shfl_xor(v, o);
    return v;
}
#define FRESH_IDS(vcu_) int tid = threadIdx.x; asm volatile("" : "+v"(tid)); const int lane = tid & 63, wave = __builtin_amdgcn_readfirstlane(tid >> 6); const int gw = (vcu_) * NWAVES + wave; (void)gw; (void)lane; (void)wave
__device__ __forceinline__ float wave_max(float v) {
#pragma unroll
    for (int o = 1; o < 64; o <<= 1) v = fmaxf(v, __shfl_xor(v, o));
    return v;
}

#define XB_TMO      128
#define XB_XCNT(j)  (256  + 64 * (j))
#define XB_XSUB(j)  (1280 + 64 * (j))
#define XB_XGEN(j)  (2304 + 64 * (j))
#define XB_TOP      3328
#define XB_TOPGEN   3392
#define XCD_BAR_WORDS 3456
#define XB_SPIN_CAP (1u << 18)

__device__ __forceinline__ unsigned xb_ld(unsigned* p)              { return __hip_atomic_load(p, __ATOMIC_RELAXED, __HIP_MEMORY_SCOPE_AGENT); }
__device__ __forceinline__ unsigned xb_add(unsigned* p, unsigned v) { return __hip_atomic_fetch_add(p, v, __ATOMIC_RELAXED, __HIP_MEMORY_SCOPE_AGENT); }
__device__ __forceinline__ unsigned xb_xcc_id() { return (unsigned)__builtin_amdgcn_s_getreg((3 << 11) | 20) & 0xFu; }
#define XB_SPIN(cond, bar) do { unsigned _sp = 0; while (cond) { __builtin_amdgcn_s_sleep(1); \
    if ((++_sp & 255u) == 0u) { if (xb_ld(&(bar)[XB_TMO])) break; if (_sp > XB_SPIN_CAP) { atomicAdd(&(bar)[XB_TMO], 1u); break; } } } } while (0)

struct XcdBarrier {
    unsigned* bar; unsigned x;
    volatile LAS unsigned* st;
};

__device__ __forceinline__ XcdBarrier xcd_barrier_post(unsigned* bar, volatile LAS unsigned* st) {
    XcdBarrier b; b.bar = bar; b.x = xb_xcc_id(); b.st = st;
    if (threadIdx.x == 0) (void)xb_add(&bar[XB_XCNT(b.x)], 1u);
    return b;
}
__device__ __forceinline__ void xcd_barrier_complete(unsigned* bar, unsigned x, unsigned& nloc, unsigned& nx) {
    const unsigned G = gridDim.x * gridDim.y * gridDim.z;
    unsigned sum, cnt, mine, sp = 0u;
    for (;;) {
        sum = 0u; cnt = 0u; mine = 0u;
#pragma unroll
        for (unsigned j = 0; j < 16; ++j) { const unsigned c = xb_ld(&bar[XB_XCNT(j)]); sum += c; cnt += (c > 0u) ? 1u : 0u; mine = (j == x) ? c : mine; }
        if (sum == G) break;
        __builtin_amdgcn_s_sleep(1);
        if ((++sp & 255u) == 0u) { if (xb_ld(&bar[XB_TMO])) break; if (sp > XB_SPIN_CAP) { atomicAdd(&bar[XB_TMO], 1u); break; } }
    }
    nloc = mine > 0u ? mine : 1u; nx = cnt > 0u ? cnt : 1u;
}

__device__ __forceinline__ void xcd_barrier(const XcdBarrier& b) {
    asm volatile("s_waitcnt vmcnt(0)" ::: "memory");
    __syncthreads();
    if (threadIdx.x == 0) {
        unsigned* bar = b.bar;
        __builtin_amdgcn_s_waitcnt(0);
        unsigned nloc = b.st[0], nx = b.st[1];
        if (nloc == 0u) { xcd_barrier_complete(bar, b.x, nloc, nx); b.st[0] = nloc; b.st[1] = nx; }
        const unsigned old = xb_add(&bar[XB_XSUB(b.x)], 1u);
        const unsigned gen = old / nloc;
        if (old + 1u == (gen + 1u) * nloc) {
            __builtin_amdgcn_fence(__ATOMIC_RELEASE, "agent");
            asm volatile("s_waitcnt vmcnt(0)" ::: "memory");
            const unsigned og = xb_add(&bar[XB_TOP], 1u);
            const unsigned tg = og / nx;
            if (og + 1u == (tg + 1u) * nx) xb_add(&bar[XB_TOPGEN], 1u);
            else XB_SPIN(xb_ld(&bar[XB_TOPGEN]) == tg, bar);
            __builtin_amdgcn_fence(__ATOMIC_ACQUIRE, "agent");
            xb_add(&bar[XB_XGEN(b.x)], 1u);
            asm volatile("s_waitcnt vmcnt(0)" ::: "memory");
        } else {
            XB_SPIN(xb_ld(&bar[XB_XGEN(b.x)]) == gen, bar);
            __builtin_amdgcn_fence(__ATOMIC_ACQUIRE, "agent");
            asm volatile("s_waitcnt vmcnt(0)" ::: "memory");
        }
    }
    __syncthreads();
}


__device__ __forceinline__ void p0_transpose_item(const float* W, int srcStride, int srcCol0, int k0, bf16* WT, int K, int dstRow0, LAS float* scr, int lane) {
#pragma unroll 8
    for (int i = 0; i < 32; ++i) { const int kk = 2 * i + (lane >> 5); scr[kk * 33 + (lane & 31)] = W[(size_t)(k0 + kk) * srcStride + srcCol0 + (lane & 31)]; }
    LDS_WAIT(); asm volatile("" ::: "memory");
    const int c = lane & 7;
#pragma unroll
    for (int j = 0; j < 4; ++j) { const int n = (lane >> 3) + 8 * j; const LAS float* s = scr + (8 * c) * 33 + n;
        v4u o; o.x = pk2(s[0 * 33], s[1 * 33]); o.y = pk2(s[2 * 33], s[3 * 33]); o.z = pk2(s[4 * 33], s[5 * 33]); o.w = pk2(s[6 * 33], s[7 * 33]);
        *(GAS v4u*)(WT + (size_t)(dstRow0 + n) * K + k0 + 8 * c) = o; }
    LDS_WAIT(); asm volatile("" ::: "memory");
}
constexpr int I_IN = (DM / 64) * (PW / 32), I_OUT = (DM / 64) * (DM / 32), I_G = (DM / 64) * (FF / 32), I_D = (FF / 64) * (DM / 32);
constexpr int I_LAYER = I_IN + I_OUT + 2 * I_G + I_D;
__device__ __forceinline__ void p0_prologue(const float* const (&in)[20], unsigned char* ws, LAS unsigned char* lds, int vcu, int NGW) {
    FRESH_IDS(vcu);
    LAS float* scr = (LAS float*)(lds + RING_OFF + wave * 16384);
    for (int it0 = gw; it0 < DEPTH * I_LAYER; it0 += NGW) {
        const int l = it0 / I_LAYER; int r = it0 - l * I_LAYER;
        if (r < I_IN) { const int nblk = PW / 32, kb = r / nblk, nb = r - kb * nblk, n0 = nb * 32;
            p0_transpose_item(in[2] + (size_t)l * DM * INW, INW, n0 + (n0 >= C_QD ? 12 : 0), 64 * kb, (bf16*)(ws + WS_WIN) + (size_t)l * PW * DM, DM, n0, scr, lane); continue; }
        r -= I_IN;
        if (r < I_OUT) { const int nblk = DM / 32, kb = r / nblk, nb = r - kb * nblk;
            p0_transpose_item(in[15] + (size_t)l * DM * DM, DM, nb * 32, 64 * kb, (bf16*)(ws + WS_WOUT) + (size_t)l * DM * DM, DM, nb * 32, scr, lane); continue; }
        r -= I_OUT;
        if (r < 2 * I_G) { const int which = r >= I_G; if (which) r -= I_G; const int nblk = FF / 32, kb = r / nblk, nb = r - kb * nblk, n0 = nb * 32;
            p0_transpose_item((which ? in[18] : in[17]) + (size_t)l * DM * FF, FF, n0, 64 * kb, (bf16*)(ws + WS_WGU) + (size_t)l * NGU * DM, DM, (n0 >> 7) * 256 + which * 128 + (n0 & 127), scr, lane); continue; }
        r -= 2 * I_G;
        { const int nblk = DM / 32, kb = r / nblk, nb = r - kb * nblk;
            p0_transpose_item(in[19] + (size_t)l * FF * DM, DM, nb * 32, 64 * kb, (bf16*)(ws + WS_WD) + (size_t)l * DM * FF, FF, nb * 32, scr, lane); }
    }
    const int gt = gw * 64 + lane, NGT = NGW * 64;
    for (int i = gt; i < DEPTH * 16 * DM; i += NGT) { const int l = i / (16 * DM), c = (i / DM) & 15, k = i % DM;
        ((bf16*)(ws + WS_WF))[i] = (c < 12) ? (bf16)f2bf(in[2][((size_t)l * DM + k) * INW + 9216 + c]) : (bf16)0; }
    for (int i = gt; i < SEQ * 64; i += NGT) { const int pos = i >> 6, fi = i & 63;
        const float invf = 1.0f / powf(10000.0f, (float)fi * (1.0f / 64.0f)); const float ang = (float)pos * invf;
        const double rev = (double)ang * 0.15915494309189533576888; const float fr = (float)(rev - rint(rev));
        ((f32x2*)(ws + WS_ROPE))[i] = (f32x2){__builtin_amdgcn_cosf(fr), __builtin_amdgcn_sinf(fr)}; }
}

__device__ __forceinline__ void rmsnorm_phase(const float* x, const float* g, bf16* XN, int vcu, int NGW) {
    FRESH_IDS(vcu);
    const GAS f32x4* gr = (const GAS f32x4*)g + lane;
    for (int m = gw; m < M; m += NGW) {
        const GAS f32x4* xr = (const GAS f32x4*)(x + (size_t)m * DM) + lane;
        f32x4 v[16]; float s = 0.f;
#pragma unroll
        for (int j = 0; j < 16; ++j) { v[j] = xr[64 * j]; s += (v[j].x * v[j].x + v[j].y * v[j].y) + (v[j].z * v[j].z + v[j].w * v[j].w); }
        const float rstd = 1.0f / sqrtf(wave_sum(s) * (1.0f / DM) + NORM_EPS);
        GAS v2u* o8 = (GAS v2u*)(XN + (size_t)m * DM) + lane;
#pragma unroll
        for (int j = 0; j < 16; ++j) { const f32x4 gg = gr[64 * j]; v2u o; o.x = pk2(v[j].x * rstd * gg.x, v[j].y * rstd * gg.y); o.y = pk2(v[j].z * rstd * gg.z, v[j].w * rstd * gg.w); o8[64 * j] = o; }
    }
}
constexpr int T3A_ITEMS = (M / 32) * 16, T3B_ITEMS = M / 16;
__device__ __forceinline__ void t3_phase(const float* const (&in)[20], unsigned char* ws, int l, int vcu, int NGW) {
    FRESH_IDS(vcu);
    bf16* PROJ = (bf16*)(ws + WS_PROJ);
    for (int it = gw; it < T3A_ITEMS + T3B_ITEMS; it += NGW) {
        if (it < T3A_ITEMS) {
            const int chunk = it >> 4, g = it & 15;
            int col0; const float* gsel; bool rot, km = false;
            if (g < 3) { col0 = C_QM + 512 * g; gsel = in[3]; rot = true; }
            else if (g < 6) { col0 = C_KM + 512 * (g - 3); gsel = in[4]; rot = true; km = true; }
            else if (g < 9) { col0 = C_QF + 512 * (g - 6); gsel = in[5]; rot = false; }
            else if (g < 12) { col0 = C_KF + 512 * (g - 9); gsel = in[6]; rot = false; }
            else if (g < 14) { col0 = C_QD + 512 * (g - 12); gsel = in[8]; rot = true; }
            else { col0 = C_KD + 512 * (g - 14); gsel = in[9]; rot = true; }
            const int hv = lane >> 4, c8 = (lane & 15) * 8;
            const float* gp = gsel + l * HD + c8; float gn[8];
#pragma unroll
            for (int e = 0; e < 8; ++e) gn[e] = gp[e];
            float ks[8];
#pragma unroll
            for (int e = 0; e < 8; ++e) ks[e] = 0.f;
            for (int rr = 0; rr < 32; ++rr) {
                const int row = chunk * 32 + rr, pos = row & (SEQ - 1);
                GAS v4u* p = (GAS v4u*)(PROJ + (size_t)row * PW + col0 + hv * 128 + c8);
                const v4u w = *p; float y[8];
                y[0] = bflo(w.x); y[1] = bfhi(w.x); y[2] = bflo(w.y); y[3] = bfhi(w.y); y[4] = bflo(w.z); y[5] = bfhi(w.z); y[6] = bflo(w.w); y[7] = bfhi(w.w);
                float ss = 0.f;
#pragma unroll
                for (int e = 0; e < 8; ++e) ss += y[e] * y[e];
                ss += __shfl_xor(ss, 1); ss += __shfl_xor(ss, 2); ss += __shfl_xor(ss, 4); ss += __shfl_xor(ss, 8);
                const float sc = 1.0f / sqrtf(ss * (1.0f / HD) + NORM_EPS);
#pragma unroll
                for (int e = 0; e < 8; ++e) y[e] = y[e] * sc * gn[e];
                if (rot) {
                    const GAS f32x4* rp = (const GAS f32x4*)((const float*)(ws + WS_ROPE) + ((size_t)pos * 64 + (c8 & 63)) * 2);
                    const f32x4 r0 = rp[0], r1 = rp[1], r2 = rp[2], r3 = rp[3];
                    const float cs[8] = {r0.x, r0.z, r1.x, r1.z, r2.x, r2.z, r3.x, r3.z}, sn[8] = {r0.y, r0.w, r1.y, r1.w, r2.y, r2.w, r3.y, r3.w};
                    const bool up = (lane & 8) != 0;
#pragma unroll
                    for (int e = 0; e < 8; ++e) { const float o = __shfl_xor(y[e], 8); y[e] = up ? (y[e] * cs[e] + o * sn[e]) : (y[e] * cs[e] - o * sn[e]); }
                }
                v4u o; o.x = pk2(y[0], y[1]); o.y = pk2(y[2], y[3]); o.z = pk2(y[4], y[5]); o.w = pk2(y[6], y[7]);
                *p = o;
                if (km) {
#pragma unroll
                    for (int e = 0; e < 8; ++e) ks[e] += y[e];
                }
            }
            if (km) {
                const int b = chunk >> 7, blk = (chunk & 127) >> 3, sub = chunk & 7, h = 4 * (g - 3) + hv;
                float* kp = (float*)(ws + WS_KPART) + ((((size_t)(b * 12 + h) * NBLK + blk) * 8 + sub) * HD) + c8;
                *(f32x4*)kp = (f32x4){ks[0], ks[1], ks[2], ks[3]}; *(f32x4*)(kp + 4) = (f32x4){ks[4], ks[5], ks[6], ks[7]};
            }
        } else {
            const int t = it - T3A_ITEMS;
            const bf16* A = (const bf16*)(ws + WS_XN) + (size_t)(16 * t + (lane & 15)) * DM + 8 * (lane >> 4);
            const bf16* B = (const bf16*)(ws + WS_WF) + (size_t)l * 16 * DM + (size_t)(lane & 15) * DM + 8 * (lane >> 4);
            f32x4 acc = {0.f, 0.f, 0.f, 0.f};
#pragma unroll 8
            for (int i = 0; i < DM / 32; ++i) { const bf16x8 a = *(const bf16x8*)(A + 32 * i), b = *(const bf16x8*)(B + 32 * i); acc = __builtin_amdgcn_mfma_f32_16x16x32_bf16(a, b, acc, 0, 0, 0); }
            const int c = lane & 15;
            if (c < 12) { const float fb = in[7][l * 12 + c];
#pragma unroll
                for (int r = 0; r < 4; ++r) { const float z = acc[r] + fb; const float ls = fminf(z, 0.f) - log1pf(expf(-fabsf(z)));
                    ((float*)(ws + WS_LOGF))[(size_t)(16 * t + 4 * (lane >> 4) + r) * 16 + c] = ls; } }
        }
    }
}
__device__ __forceinline__ void t4_phase(unsigned char* ws, LAS unsigned char* lds, int vcu, int G) {
    FRESH_IDS(vcu);
    LAS float* kmean = (LAS float*)(lds + RING_OFF);
    const bf16* PROJ = (const bf16*)(ws + WS_PROJ);
    for (int it = vcu; it < BATCH * 12 * NBLK + BATCH * 12; it += G) {
        if (it < BATCH * 12 * NBLK) {
            const int bh = it / NBLK, j = it % NBLK, b = bh / 12, h = bh % 12;
            for (int idx = tid; idx < j * HD; idx += NWAVES * 64) { const int n = idx >> 7, d = idx & 127;
                const float* kp = (const float*)(ws + WS_KPART) + (((size_t)bh * NBLK + n) * 8) * HD + d; float s = 0.f;
#pragma unroll
                for (int sub = 0; sub < 8; ++sub) s += kp[sub * HD];
                kmean[idx] = s * (1.0f / 256.0f); }
            __syncthreads();
            if (tid < 256) {
                const int s_ = 256 * j + tid; const size_t row = (size_t)b * SEQ + s_;
                const GAS v4u* qp = (const GAS v4u*)(PROJ + row * PW + C_QM + h * HD);
                float best[3] = {-INFINITY, -INFINITY, -INFINITY}; int bi[3] = {-1, -1, -1};
                for (int n = 0; n < j; ++n) { float gsum = 0.f;
#pragma unroll
                    for (int c = 0; c < 16; ++c) { const v4u w = qp[c]; const LAS f32x4* km = (const LAS f32x4*)(kmean + n * HD + 8 * c); const f32x4 k0 = km[0], k1 = km[1];
                        gsum += bflo(w.x) * k0.x + bfhi(w.x) * k0.y + bflo(w.y) * k0.z + bfhi(w.y) * k0.w + bflo(w.z) * k1.x + bfhi(w.z) * k1.y + bflo(w.w) * k1.z + bfhi(w.w) * k1.w; }
                    if (gsum > best[0]) { best[2] = best[1]; bi[2] = bi[1]; best[1] = best[0]; bi[1] = bi[0]; best[0] = gsum; bi[0] = n; }
                    else if (gsum > best[1]) { best[2] = best[1]; bi[2] = bi[1]; best[1] = gsum; bi[1] = n; }
                    else if (gsum > best[2]) { best[2] = gsum; bi[2] = n; } }
                unsigned mask = 1u << j;
#pragma unroll
                for (int q = 0; q < 3; ++q) if (bi[q] >= 0) mask |= 1u << bi[q];
                ((unsigned*)(ws + WS_SELM))[(size_t)bh * SEQ + s_] = mask;
            }
            __syncthreads();
        } else if (wave == 0) {
            const int bh = it - BATCH * 12 * NBLK, b = bh / 12, h = bh % 12;
            const float* lf = (const float*)(ws + WS_LOGF) + ((size_t)b * SEQ + 64 * lane) * 16 + h;
            double loc = 0.0;
            for (int i = 0; i < 64; ++i) loc += (double)lf[i * 16];
            double inc = loc;
#pragma unroll
            for (int o = 1; o < 64; o <<= 1) { const double t = __shfl_up(inc, o); if (lane >= o) inc += t; }
            double run = inc - loc;
            float* br = (float*)(ws + WS_BRAW) + (size_t)bh * SEQ + 64 * lane;
            for (int i = 0; i < 64; ++i) { run += (double)lf[i * 16]; br[i] = (float)(-run * 11.313708498984761); }
        }
    }
}
struct AttnDesc { int qcol, kcol, vcol, type; bf16* obase; int opitch, ocol; };
__device__ __forceinline__ AttnDesc attn_desc(int hidx, unsigned char* ws) {
    AttnDesc d;
    if (hidx < 12) { d.type = 0; d.qcol = C_QM + hidx * HD; d.kcol = C_KM + hidx * HD; d.vcol = C_VM + hidx * HD; d.obase = (bf16*)(ws + WS_MIX); d.opitch = DM; d.ocol = hidx * HD; }
    else if (hidx < 24) { const int h = hidx - 12; d.type = 1; d.qcol = C_QF + h * HD; d.kcol = C_KF + h * HD; d.vcol = C_VF + h * HD; d.obase = (bf16*)(ws + WS_MIX); d.opitch = DM; d.ocol = 1536 + h * HD; }
    else { const int x = hidx - 24, h = x >> 2, mp = (x >> 1) & 1, e = x & 1; d.type = 2; d.qcol = C_QD + h * 256 + mp * HD; d.kcol = C_KD + h * 256 + mp * HD; d.vcol = C_VD + h * 256 + e * HD;
        d.obase = (bf16*)(ws + WS_DIFF) + (size_t)mp * M * 1024; d.opitch = 1024; d.ocol = h * 256 + e * HD; }
    return d;
}
__device__ __forceinline__ void attn_naive_phase(unsigned char* ws, int vcu, int NGW) {
    FRESH_IDS(vcu);
    const bf16* PROJ = (const bf16*)(ws + WS_PROJ);
    for (int it = gw; it < BATCH * NATT * SEQ; it += NGW) {
        const int k_ = it / SEQ; int i = it % SEQ; if (k_ & 1) i = SEQ - 1 - i;
        const int b = k_ / NATT, hidx = k_ % NATT;
        const AttnDesc d = attn_desc(hidx, ws);
        const size_t rowq = (size_t)b * SEQ + i;
        float q[128];
        { const GAS v4u* qp = (const GAS v4u*)(PROJ + rowq * PW + d.qcol);
#pragma unroll
          for (int c = 0; c < 16; ++c) { const v4u w = qp[c]; q[8 * c] = bflo(w.x); q[8 * c + 1] = bfhi(w.x); q[8 * c + 2] = bflo(w.y); q[8 * c + 3] = bfhi(w.y); q[8 * c + 4] = bflo(w.z); q[8 * c + 5] = bfhi(w.z); q[8 * c + 6] = bflo(w.w); q[8 * c + 7] = bfhi(w.w); } }
        unsigned selm = 0xffffffffu; const float* br = nullptr;
        if (d.type == 0) selm = ((const unsigned*)(ws + WS_SELM))[(size_t)(b * 12 + hidx) * SEQ + i];
        if (d.type == 1) br = (const float*)(ws + WS_BRAW) + (size_t)(b * 12 + (hidx - 12)) * SEQ;
        float mrun = -1e30f, lrun = 0.f, o0 = 0.f, o1 = 0.f;
        for (int c0 = 0; c0 <= i; c0 += 64) {
            if (!((selm >> (c0 >> 8)) & 1u)) continue;
            const int j = c0 + lane; const bool valid = j <= i;
            float s = -INFINITY;
            if (valid) { const GAS v4u* kp = (const GAS v4u*)(PROJ + ((size_t)b * SEQ + j) * PW + d.kcol); float a = 0.f;
#pragma unroll
                for (int c = 0; c < 16; ++c) { const v4u w = kp[c];
                    a += q[8 * c] * bflo(w.x) + q[8 * c + 1] * bfhi(w.x) + q[8 * c + 2] * bflo(w.y) + q[8 * c + 3] * bfhi(w.y) + q[8 * c + 4] * bflo(w.z) + q[8 * c + 5] * bfhi(w.z) + q[8 * c + 6] * bflo(w.w) + q[8 * c + 7] * bfhi(w.w); }
                if (br) a += br[j] - br[i];
                s = a * 0.08838834764831845f; }
            const float cm = wave_max(s), mn = fmaxf(mrun, cm), al = __expf(mrun - mn);
            const float p = valid ? __expf(s - mn) : 0.f;
            lrun = lrun * al + wave_sum(p); o0 *= al; o1 *= al; mrun = mn;
            const int nk = (i - c0 + 1) < 64 ? (i - c0 + 1) : 64;
            const bf16* vp = PROJ + ((size_t)b * SEQ + c0) * PW + d.vcol + 2 * lane;
            for (int jj = 0; jj < nk; ++jj) { const float pj = __shfl(p, jj); const unsigned w = *(const unsigned*)(vp + (size_t)jj * PW); o0 += pj * bflo(w); o1 += pj * bfhi(w); }
        }
        const float rl = 1.0f / lrun;
        *(unsigned*)(d.obase + rowq * d.opitch + d.ocol + 2 * lane) = pk2(o0 * rl, o1 * rl);
    }
}
__device__ __forceinline__ void t5_phase(const float* const (&in)[20], unsigned char* ws, int l, int vcu, int NGW) {
    FRESH_IDS(vcu);
    float s1 = in[10][l * HD + lane] * in[11][l * HD + lane] + in[10][l * HD + 64 + lane] * in[11][l * HD + 64 + lane];
    float s2 = in[12][l * HD + lane] * in[13][l * HD + lane] + in[12][l * HD + 64 + lane] * in[13][l * HD + 64 + lane];
    const float lam_init = 0.8f - 0.6f * expf(-0.3f * (float)l);
    const float lam = expf(wave_sum(s1)) - expf(wave_sum(s2)) + lam_init;
    const f32x4 gn = *(const f32x4*)(in[14] + l * 256 + 4 * lane);
    const bf16* D0 = (const bf16*)(ws + WS_DIFF); const bf16* D1 = D0 + (size_t)M * 1024; bf16* MIX = (bf16*)(ws + WS_MIX);
    for (int it = gw; it < M * NH_D; it += NGW) {
        const int row = it >> 2, h = it & 3;
        const v2u a = *(const v2u*)(D0 + (size_t)row * 1024 + h * 256 + 4 * lane), b = *(const v2u*)(D1 + (size_t)row * 1024 + h * 256 + 4 * lane);
        const float v0 = bflo(a.x) - lam * bflo(b.x), v1 = bfhi(a.x) - lam * bfhi(b.x), v2 = bflo(a.y) - lam * bflo(b.y), v3 = bfhi(a.y) - lam * bfhi(b.y);
        const float ss = wave_sum((v0 * v0 + v1 * v1) + (v2 * v2 + v3 * v3));
        const float sc = (1.0f / sqrtf(ss * (1.0f / 256.0f) + NORM_EPS)) * (1.0f - lam_init);
        v2u o; o.x = pk2(v0 * sc * gn.x, v1 * sc * gn.y); o.y = pk2(v2 * sc * gn.z, v3 * sc * gn.w);
        *(v2u*)(MIX + (size_t)row * DM + 3072 + h * 256 + 4 * lane) = o;
    }
}

struct Args { const float* in[20]; float* out; unsigned char* ws; int ph_lo, ph_hi; };
__global__ void __launch_bounds__(NWAVES * 64, 2) mk_fwd(Args args) {
    extern __shared__ __attribute__((aligned(16))) unsigned char lds_raw[];
    LAS unsigned char* lds = (LAS unsigned char*)lds_raw;
    volatile LAS unsigned* MISC = (volatile LAS unsigned*)(lds + MISC_OFF);
    const int tid = threadIdx.x;
    const int G = gridDim.x; const int bx = blockIdx.x; const int vcu = (G % 8 == 0) ? (bx % 8) * (G / 8) + bx / 8 : bx;
    const int NGW = G * NWAVES;
    unsigned char* ws = args.ws;
    gu32* ctl = (gu32*)(ws + WS_CTL);
    for (int u = tid; u < (LDS_BYTES - LDSCTL_OFF) / 4; u += NWAVES * 64) ((LAS unsigned*)(lds + LDSCTL_OFF))[u] = 0u;
    __syncthreads();
    XcdBarrier bar; bar.bar = (unsigned*)(ctl + CW_BAR); bar.x = 0; bar.st = nullptr;
    if (MK_N_LAUNCHES == 1) bar = xcd_barrier_post((unsigned*)(ctl + CW_BAR), MISC + 8);
#define GRID_BAR() do { if (MK_N_LAUNCHES == 1) xcd_barrier(bar); } while (0)
    const int lo = args.ph_lo, hi = args.ph_hi;
#define IN(k) (lo <= (k) && (k) < hi)
#define BOTH(k) (IN(k) && IN((k) + 1))
    if (IN(0)) { p0_prologue(args.in, ws, lds, vcu, NGW); if (BOTH(0)) GRID_BAR(); }
    for (int l = 0; l < DEPTH; ++l) {
        const int pb = 1 + 10 * l;
        const float* xin = (l == 0) ? args.in[0] : (const float*)(ws + WS_XB);
        float* x1 = args.out;
        float* x2 = (l == DEPTH - 1) ? args.out : (float*)(ws + WS_XB);
        if (IN(pb + 0)) { rmsnorm_phase(xin, args.in[1] + l * DM, (bf16*)(ws + WS_XN), vcu, NGW); if (BOTH(pb + 0)) GRID_BAR(); }
        if (IN(pb + 1)) {
            pg8::Gemm g{(const bf16*)(ws + WS_XN), (const bf16*)(ws + WS_WIN) + (size_t)l * PW * DM, M, PW, DM}; pg8::StaticOrder S; S.init(M, PW, G, bx);
            pg8::EpiStoreBf16 E{(bf16*)(ws + WS_PROJ), PW};
            pg8::gemm_phase<pg8::EpiStoreBf16, pg8::StaticOrder, true, true>(lds + RING_OFF, g, S, E);
            if (BOTH(pb + 1)) GRID_BAR(); }
        if (IN(pb + 2)) { t3_phase(args.in, ws, l, vcu, NGW); if (BOTH(pb + 2)) GRID_BAR(); }
        if (IN(pb + 3)) { t4_phase(ws, lds, vcu, G); if (BOTH(pb + 3)) GRID_BAR(); }
        if (IN(pb + 4)) { attn_naive_phase(ws, vcu, NGW); if (BOTH(pb + 4)) GRID_BAR(); }
        if (IN(pb + 5)) { t5_phase(args.in, ws, l, vcu, NGW); if (BOTH(pb + 5)) GRID_BAR(); }
        if (IN(pb + 6)) {
            pg8::Gemm g{(const bf16*)(ws + WS_MIX), (const bf16*)(ws + WS_WOUT) + (size_t)l * DM * DM, M, DM, DM}; pg8::StaticOrder S; S.init(M, DM, G, bx);
            pg8::EpiResid E{xin, x1, DM};
            pg8::gemm_phase<pg8::EpiResid, pg8::StaticOrder, true, true>(lds + RING_OFF, g, S, E);
            if (BOTH(pb + 6)) GRID_BAR(); }
        if (IN(pb + 7)) { rmsnorm_phase(x1, args.in[16] + l * DM, (bf16*)(ws + WS_XN), vcu, NGW); if (BOTH(pb + 7)) GRID_BAR(); }
        if (IN(pb + 8)) {
            pg8::Gemm g{(const bf16*)(ws + WS_XN), (const bf16*)(ws + WS_WGU) + (size_t)l * NGU * DM, M, NGU, DM}; pg8::StaticOrder S; S.init(M, NGU, G, bx);
            pg8::EpiSwiGLU E{(bf16*)(ws + WS_HB), FF};
            pg8::gemm_phase<pg8::EpiSwiGLU, pg8::StaticOrder, true, true>(lds + RING_OFF, g, S, E);
            if (BOTH(pb + 8)) GRID_BAR(); }
        if (IN(pb + 9)) {
            pg8::Gemm g{(const bf16*)(ws + WS_HB), (const bf16*)(ws + WS_WD) + (size_t)l * DM * FF, M, DM, FF}; pg8::StaticOrder S; S.init(M, DM, G, bx);
            pg8::EpiResid E{x1, x2, DM};
            pg8::gemm_phase<pg8::EpiResid, pg8::StaticOrder, true, true>(lds + RING_OFF, g, S, E);
            if (BOTH(pb + 9)) GRID_BAR(); }
    }
#undef IN
#undef BOTH
}

extern "C" void kernel_launch(void* const* d_in, const int* in_sizes, int n_in, void* d_out, int out_size, void* d_ws, size_t ws_size, hipStream_t stream) {
    static int grid = 0;
    if (grid == 0) {
        if (n_in != 20 || in_sizes[0] != M * DM || out_size != M * DM || ws_size < WS_END) { fprintf(stderr, "kernel_launch: unexpected shapes (n_in %d, in0 %d, out %d, ws %zu < %zu); nothing launched\n", n_in, n_in > 0 ? in_sizes[0] : -1, out_size, ws_size, (size_t)WS_END); grid = -1; return; }
        int dev = 0, cus = 0, per_cu = 0;
        if (hipGetDevice(&dev) != hipSuccess || hipDeviceGetAttribute(&cus, hipDeviceAttributeMultiprocessorCount, dev) != hipSuccess) { grid = -1; return; }
        if (hipFuncSetAttribute((const void*)mk_fwd, hipFuncAttributeMaxDynamicSharedMemorySize, LDS_BYTES) != hipSuccess) { fprintf(stderr, "kernel_launch: hipFuncSetAttribute failed\n"); grid = -1; return; }
        if (hipOccupancyMaxActiveBlocksPerMultiprocessor(&per_cu, (const void*)mk_fwd, NWAVES * 64, LDS_BYTES) != hipSuccess || per_cu < 1) fprintf(stderr, "kernel_launch: occupancy query says %d\n", per_cu);
        (void)hipGetLastError();
        grid = cus;
    }
    if (grid < 0) return;
    if (hipMemsetAsync((char*)d_ws + WS_CTL, 0, CTL_ZERO_BYTES, stream) != hipSuccess) return;
    Args a{};
    for (int i = 0; i < 20; ++i) a.in[i] = (const float*)d_in[i];
    a.out = (float*)d_out; a.ws = (unsigned char*)d_ws;
    if (MK_N_LAUNCHES == 1) { a.ph_lo = 0; a.ph_hi = NPH; hipLaunchKernelGGL(mk_fwd, dim3(grid), dim3(NWAVES * 64), LDS_BYTES, stream, a); }
    else for (int p = 0; p < NPH; ++p) { a.ph_lo = p; a.ph_hi = p + 1; hipLaunchKernelGGL(mk_fwd, dim3(grid), dim3(NWAVES * 64), LDS_BYTES, stream, a); }
}
```

```cpp
#include <hip/hip_runtime.h>
#include <cstdio>
#include <cstdint>
#include <cmath>
namespace pg8 {
#define PG8_LAS __attribute__((address_space(3)))
typedef unsigned short bf16_t;
typedef short bf16x8 __attribute__((ext_vector_type(8)));
typedef float f32x4 __attribute__((ext_vector_type(4)));
typedef unsigned u32x4 __attribute__((ext_vector_type(4)));
constexpr int BM = 256, BK = 64, HALF = 128, HTB = HALF * BK * 2  , STAGE_BYTES = 8 * HTB, NXCD = 8, WGM = 8;

__host__ __device__ __forceinline__ int lds_byte(int r, int c) { const int st = (r >> 4) * 2 + (c >> 5), rr = r & 15, cc = c & 31, ob = rr * 64 + cc * 2; return st * 1024 + (ob ^ (((ob >> 9) & 1) << 5)); }
__host__ __device__ __forceinline__ void stage_rc(int b, int& R, int& C) { const int st = b / 1024, sb = b % 1024, swz = sb ^ (((sb >> 9) & 1) << 5); R = (st >> 1) * 16 + swz / 64; C = (st & 1) * 32 + (swz % 64) / 2; }
__host__ __device__ __forceinline__ int perm32(int rho) { const int n = rho >> 4, i = rho & 15; return 8 * (i >> 2) + 4 * n + (i & 3); }

struct Unit { int pm, pn; };
struct Gemm { const bf16_t* A; const bf16_t* Bt; int M, N, K; };

struct StaticOrder {
    int nM, nN, nwg, G, c;
    __host__ __device__ void init(int M, int N, int G_, int c_) { nM = M / BM; nN = N / BM; nwg = nM * nN; G = G_; c = c_; }
    __host__ __device__ bool next(int i, Unit& u) const {
        const long L = (long)i * G + c; if (L >= nwg) return false;
        int wgid = (int)L; { const int q = nwg / NXCD, r = nwg % NXCD, xcd = wgid % NXCD, off = wgid / NXCD; wgid = (xcd < r ? xcd * (q + 1) : r * (q + 1) + (xcd - r) * q) + off; }
        const int nig = WGM * nN, gid = wgid / nig, fm = gid * WGM, gsz = (nM - fm) < WGM ? (nM - fm) : WGM;
        u.pm = fm + ((wgid % nig) % gsz); u.pn = (wgid % nig) / gsz; return true;
    }
    __device__ __forceinline__ void a_ready(const Unit&) const {}
    __device__ __forceinline__ void done(const Unit&) const {}
};

__device__ __forceinline__ unsigned cvt_pk_bf16(float lo, float hi) { unsigned r; asm volatile("v_cvt_pk_bf16_f32 %0, %1, %2" : "=v"(r) : "v"(lo), "v"(hi)); return r; }
struct EpiStoreBf16 {
    static constexpr bool PERM = true, AFTER_DRAIN = false;
    bf16_t* O; int ldc;
    __device__ __forceinline__ void operator()(const f32x4 (&acc)[2][2][4][2], const Unit& u, int wr, int wc, int fr, int fq) const {
        const int row0 = u.pm * BM + wr * 64 + fr, col0 = u.pn * BM + wc * 32 + 8 * fq;
#pragma unroll
        for (int ai = 0; ai < 2; ++ai)
#pragma unroll
            for (int m = 0; m < 4; ++m) { bf16_t* rowp = O + (size_t)(row0 + ai * HALF + m * 16) * ldc + col0;
#pragma unroll
                for (int bj = 0; bj < 2; ++bj) { const f32x4 v0 = acc[ai][bj][m][0], v1 = acc[ai][bj][m][1];
                    u32x4 w; w.x = cvt_pk_bf16(v0[0], v0[1]); w.y = cvt_pk_bf16(v0[2], v0[3]); w.z = cvt_pk_bf16(v1[0], v1[1]); w.w = cvt_pk_bf16(v1[2], v1[3]);
                    *(u32x4*)(rowp + bj * HALF) = w; } }
    }
};
__device__ __forceinline__ float silu_mul(float g, float u) { const float e = __builtin_amdgcn_exp2f(-g * 1.4426950408889634f); return g * __builtin_amdgcn_rcpf(1.0f + e) * u; }
struct EpiSwiGLU {
    static constexpr bool PERM = true, AFTER_DRAIN = false;
    bf16_t* O; int ldc;
    __device__ __forceinline__ void operator()(const f32x4 (&acc)[2][2][4][2], const Unit& u, int wr, int wc, int fr, int fq) const {
        const int row0 = u.pm * BM + wr * 64 + fr, col0 = u.pn * HALF + wc * 32 + 8 * fq;
#pragma unroll
        for (int ai = 0; ai < 2; ++ai)
#pragma unroll
            for (int m = 0; m < 4; ++m) { bf16_t* rowp = O + (size_t)(row0 + ai * HALF + m * 16) * ldc + col0;
                const f32x4 g0 = acc[ai][0][m][0], g1 = acc[ai][0][m][1], u0 = acc[ai][1][m][0], u1 = acc[ai][1][m][1];
                u32x4 w; w.x = cvt_pk_bf16(silu_mul(g0[0], u0[0]), silu_mul(g0[1], u0[1])); w.y = cvt_pk_bf16(silu_mul(g0[2], u0[2]), silu_mul(g0[3], u0[3]));
                w.z = cvt_pk_bf16(silu_mul(g1[0], u1[0]), silu_mul(g1[1], u1[1])); w.w = cvt_pk_bf16(silu_mul(g1[2], u1[2]), silu_mul(g1[3], u1[3]));
                *(u32x4*)rowp = w; }
    }
};
struct EpiResid {
    static constexpr bool PERM = false, AFTER_DRAIN = false;
    const float* base; float* out; int ldc;
    __device__ __forceinline__ void operator()(const f32x4 (&acc)[2][2][4][2], const Unit& u, int wr, int wc, int fr, int fq) const {
        const int row0 = u.pm * BM + wr * 64 + fr, col0 = u.pn * BM + wc * 32 + 4 * fq;
#pragma unroll
        for (int ai = 0; ai < 2; ++ai)
#pragma unroll
            for (int m = 0; m < 4; ++m) { const size_t off = (size_t)(row0 + ai * HALF + m * 16) * ldc + col0;
#pragma unroll
                for (int bj = 0; bj < 2; ++bj)
#pragma unroll
                    for (int n = 0; n < 2; ++n) { const f32x4 b = *(const f32x4*)(base + off + bj * HALF + n * 16); *(f32x4*)(out + off + bj * HALF + n * 16) = b + acc[ai][bj][m][n]; } }
    }
};

template <class Epi, class Sched, bool ALIGN_EPI = false, bool SP2 = false>
__device__ __forceinline__ void gemm_phase(PG8_LAS unsigned char* lds, const Gemm g, const Sched& S, const Epi& E, int tid_) {
    asm volatile("" : "+v"(tid_));
    const int tid = tid_, wid = __builtin_amdgcn_readfirstlane(tid >> 6), lane = tid & 63, wr = wid >> 2, wc = wid & 3, fr = lane & 15, fq = lane >> 4;
    const int K = g.K, nt = K / BK;
    unsigned voffA[2], voffB[2];
#pragma unroll
    for (int i = 0; i < 2; ++i) { int R, C; stage_rc(tid * 16 + i * 8192, R, C); const int Rb = Epi::PERM ? ((R & ~31) + perm32(R & 31)) : R;
        voffA[i] = (unsigned)(R * K + C) * 2u; voffB[i] = (unsigned)(Rb * K + C) * 2u; }
    const size_t kstep = (size_t)(BK * 2);
    const size_t hstep = (size_t)HALF * K * 2;
    const size_t tstep = 2 * hstep;
    const unsigned ldsw = (unsigned)wid * 1024u;
    const int aoff = lds_byte(wr * 64 + fr, fq * 8), boff = lds_byte(wc * 32 + fr, fq * 8);
#define PG8_SA(b, h) (((b) * 2 + (h)) * HTB)
#define PG8_SB(b, h) ((4 + (b) * 2 + (h)) * HTB)
#define PG8_STAGE(bufoff, gbase, voff) do { _Pragma("unroll") for (int _i = 0; _i < 2; ++_i) \
        __builtin_amdgcn_global_load_lds((const unsigned*)((const char*)(gbase) + (voff)[_i]), (PG8_LAS unsigned*)(lds + (bufoff) + ldsw + _i * 8192), 16, 0, 0); } while (0)
#define PG8_LDA(dst, b, h) do { _Pragma("unroll") for (int m = 0; m < 4; ++m) _Pragma("unroll") for (int k = 0; k < 2; ++k) dst[m][k] = *(const PG8_LAS bf16x8*)(lds + PG8_SA(b, h) + aoff + m * 2048 + k * 1024); } while (0)
#define PG8_LDB(dst, b, h) do { _Pragma("unroll") for (int n = 0; n < 2; ++n) _Pragma("unroll") for (int k = 0; k < 2; ++k) dst[n][k] = *(const PG8_LAS bf16x8*)(lds + PG8_SB(b, h) + boff + n * 2048 + k * 1024); } while (0)
#define PG8_MMA(ai, bj, At, Bt) do { __builtin_amdgcn_s_setprio(1); _Pragma("unroll") for (int m = 0; m < 4; ++m) _Pragma("unroll") for (int n = 0; n < 2; ++n) _Pragma("unroll") for (int k = 0; k < 2; ++k) \
        acc[ai][bj][m][n] = __builtin_amdgcn_mfma_f32_16x16x32_bf16(Bt[n][k], At[m][k], acc[ai][bj][m][n], 0, 0, 0); __builtin_amdgcn_s_setprio(0); } while (0)
#define PG8_WAIT_V(n) asm volatile("s_waitcnt vmcnt(" #n ")" ::: "memory")
#define PG8_WAIT_L(n) asm volatile("s_waitcnt lgkmcnt(" #n ")" ::: "memory")
#define PG8_BAR __builtin_amdgcn_s_barrier()
#define PG8_SCHED __builtin_amdgcn_sched_barrier(0)
    Unit cur, nxt; int ui = 0;
    if (!S.next(0, cur)) return;
    f32x4 acc[2][2][4][2];
#pragma unroll
    for (int a = 0; a < 2; ++a)
#pragma unroll
        for (int b = 0; b < 2; ++b)
#pragma unroll
            for (int m = 0; m < 4; ++m)
#pragma unroll
                for (int n = 0; n < 2; ++n) acc[a][b][m][n] = (f32x4){0.f, 0.f, 0.f, 0.f};
    bf16x8 At[4][2], B0[2][2], B1[2][2];
    const char* cA = (const char*)g.A + (size_t)cur.pm * tstep; const char* cB = (const char*)g.Bt + (size_t)cur.pn * tstep;
    S.a_ready(cur);
    if constexpr (SP2) {
        PG8_STAGE(PG8_SB(0, 0), cB, voffB); PG8_STAGE(PG8_SB(0, 1), cB + hstep, voffB); PG8_STAGE(PG8_SA(0, 0), cA, voffA); PG8_STAGE(PG8_SA(0, 1), cA + hstep, voffA);
        if (wr == 1) PG8_BAR;
        PG8_WAIT_V(2); PG8_BAR;
        PG8_STAGE(PG8_SB(1, 0), cB + kstep, voffB); PG8_STAGE(PG8_SA(1, 0), cA + kstep, voffA); PG8_STAGE(PG8_SB(1, 1), cB + hstep + kstep, voffB);
        PG8_WAIT_V(6); PG8_BAR;
    } else {
        PG8_STAGE(PG8_SB(0, 0), cB, voffB); PG8_STAGE(PG8_SA(0, 0), cA, voffA); PG8_STAGE(PG8_SB(0, 1), cB + hstep, voffB); PG8_STAGE(PG8_SA(0, 1), cA + hstep, voffA);
        if (wr == 1) PG8_BAR;
        PG8_WAIT_V(4); PG8_BAR;
        PG8_STAGE(PG8_SB(1, 0), cB + kstep, voffB); PG8_STAGE(PG8_SA(1, 0), cA + kstep, voffA); PG8_STAGE(PG8_SB(1, 1), cB + hstep + kstep, voffB);
        PG8_WAIT_V(6); PG8_BAR;
    }
    for (;;) {
        const bool has_next = S.next(ui + 1, nxt);
        const char* nA = has_next ? (const char*)g.A + (size_t)nxt.pm * tstep : cA; const char* nB = has_next ? (const char*)g.Bt + (size_t)nxt.pn * tstep : cB;
        for (int t = 0; t < nt; t += 2) {
            const bool last = (t == nt - 2);
            const char* a1 = cA + (size_t)(t + 1) * kstep;
            const char* a2 = last ? nA : cA + (size_t)(t + 2) * kstep; const char* b2 = last ? nB : cB + (size_t)(t + 2) * kstep;
            const char* a3 = a2 + kstep; const char* b3 = b2 + kstep;
            if (last && has_next) S.a_ready(nxt);
            if constexpr (SP2) {
            PG8_LDB(B0, 0, 0); PG8_LDB(B1, 0, 1); PG8_SCHED; PG8_LDA(At, 0, 0); PG8_STAGE(PG8_SA(1, 1), a1 + hstep, voffA);
            PG8_WAIT_V(8); PG8_WAIT_L(0); PG8_BAR; PG8_MMA(0, 0, At, B0); PG8_MMA(0, 1, At, B1); PG8_BAR; PG8_SCHED;
            PG8_LDA(At, 0, 1); PG8_STAGE(PG8_SB(0, 0), b2, voffB); PG8_STAGE(PG8_SB(0, 1), b2 + hstep, voffB); PG8_STAGE(PG8_SA(0, 0), a2, voffA);
            PG8_WAIT_V(8); PG8_WAIT_L(0); PG8_BAR; PG8_MMA(1, 0, At, B0); PG8_MMA(1, 1, At, B1); PG8_BAR; PG8_SCHED;
            PG8_LDB(B0, 1, 0); PG8_LDB(B1, 1, 1); PG8_SCHED; PG8_LDA(At, 1, 0); PG8_STAGE(PG8_SA(0, 1), a2 + hstep, voffA);
            PG8_WAIT_V(8); PG8_WAIT_L(0); PG8_BAR; PG8_MMA(0, 0, At, B0); PG8_MMA(0, 1, At, B1); PG8_BAR; PG8_SCHED;
            PG8_LDA(At, 1, 1); PG8_STAGE(PG8_SB(1, 0), b3, voffB); PG8_STAGE(PG8_SB(1, 1), b3 + hstep, voffB); PG8_STAGE(PG8_SA(1, 0), a3, voffA);
            PG8_WAIT_V(8); PG8_WAIT_L(0); PG8_BAR; PG8_MMA(1, 0, At, B0); PG8_MMA(1, 1, At, B1); PG8_BAR; PG8_SCHED;
            } else {
            PG8_LDB(B0, 0, 0); PG8_SCHED; PG8_LDA(At, 0, 0); PG8_STAGE(PG8_SA(1, 1), a1 + hstep, voffA);
            PG8_WAIT_L(8); PG8_BAR; PG8_WAIT_L(0); PG8_MMA(0, 0, At, B0); PG8_BAR; PG8_SCHED;
            PG8_LDB(B1, 0, 1); PG8_STAGE(PG8_SB(0, 0), b2, voffB);
            PG8_BAR; PG8_WAIT_L(0); PG8_MMA(0, 1, At, B1); PG8_BAR;
            PG8_LDA(At, 0, 1); PG8_STAGE(PG8_SA(0, 0), a2, voffA);
            PG8_BAR; PG8_WAIT_L(0); PG8_MMA(1, 0, At, B0); PG8_BAR; PG8_SCHED;
            PG8_STAGE(PG8_SB(0, 1), b2 + hstep, voffB);
            PG8_WAIT_V(6); PG8_BAR; PG8_MMA(1, 1, At, B1); PG8_BAR;
            PG8_LDB(B0, 1, 0); PG8_SCHED; PG8_LDA(At, 1, 0); PG8_STAGE(PG8_SA(0, 1), a2 + hstep, voffA);
            PG8_WAIT_L(8); PG8_BAR; PG8_WAIT_L(0); PG8_MMA(0, 0, At, B0); PG8_BAR; PG8_SCHED;
            PG8_LDB(B1, 1, 1); PG8_STAGE(PG8_SB(1, 0), b3, voffB);
            PG8_BAR; PG8_WAIT_L(0); PG8_MMA(0, 1, At, B1); PG8_BAR;
            PG8_LDA(At, 1, 1); PG8_STAGE(PG8_SA(1, 0), a3, voffA);
            PG8_BAR; PG8_WAIT_L(0); PG8_MMA(1, 0, At, B0); PG8_BAR; PG8_SCHED;
            PG8_STAGE(PG8_SB(1, 1), b3 + hstep, voffB);
            PG8_WAIT_V(6); PG8_BAR; PG8_MMA(1, 1, At, B1); PG8_BAR;
            }
        }
        if constexpr (ALIGN_EPI) { if (wr == 0) PG8_BAR; }
        if constexpr (!Epi::AFTER_DRAIN) { E(acc, cur, wr, wc, fr, fq); S.done(cur); }
        if (!has_next) break;
#pragma unroll
        for (int a = 0; a < 2; ++a)
#pragma unroll
            for (int b = 0; b < 2; ++b)
#pragma unroll
                for (int m = 0; m < 4; ++m)
#pragma unroll
                    for (int n = 0; n < 2; ++n) acc[a][b][m][n] = (f32x4){0.f, 0.f, 0.f, 0.f};
        cur = nxt; cA = nA; cB = nB; ++ui;
        if constexpr (ALIGN_EPI) { if (wr == 1) PG8_BAR; }
    }
    PG8_WAIT_V(0);
    if constexpr (!ALIGN_EPI) { if (wr == 0) PG8_BAR; }
    PG8_BAR;
    if constexpr (Epi::AFTER_DRAIN) { E.fused(acc, cur, wr, wc, fr, fq, lds, wid, lane); S.done(cur); }
#undef PG8_SA
#undef PG8_SB
#undef PG8_STAGE
#undef PG8_LDA
#undef PG8_LDB
#undef PG8_MMA
#undef PG8_WAIT_V
#undef PG8_WAIT_L
#undef PG8_BAR
#undef PG8_SCHED
}
}
#ifndef MK_N_LAUNCHES
#define MK_N_LAUNCHES 1
#endif
constexpr int NWAVES = 8;
constexpr int BATCH = 2, SEQ = 4096, DM = 4096, M = BATCH * SEQ, DEPTH = 2;
constexpr int HD = 128, NH_M = 12, NH_F = 12, NH_D = 4;
constexpr int INW = 12300;
constexpr int PW = 12288;
constexpr int FF = 11008, NGU = 2 * FF;
constexpr int C_QM = 0, C_KM = 1536, C_VM = 3072, C_QF = 4608, C_KF = 6144, C_VF = 7680, C_QD = 9216, C_KD = 10240, C_VD = 11264;
constexpr int NBLK = SEQ / 256;
constexpr float NORM_EPS = 1e-6f;
constexpr int NATT = 40;
constexpr int NPH = 1 + 10 * DEPTH;
constexpr size_t MiB = 1u << 20;
constexpr size_t WS_CTL = 0, CTL_ZERO_BYTES = 1 * MiB;
constexpr size_t WS_ROPE = 1 * MiB;
constexpr size_t WS_WF = 3 * MiB;
constexpr size_t WS_LOGF = 4 * MiB;
constexpr size_t WS_BRAW = 5 * MiB;
constexpr size_t WS_SELM = 6 * MiB;
constexpr size_t WS_KPART = 7 * MiB;
constexpr size_t WS_WIN = 16 * MiB;
constexpr size_t WS_WOUT = 208 * MiB;
constexpr size_t WS_WGU = 272 * MiB;
constexpr size_t WS_WD = 616 * MiB;
constexpr size_t WS_XN = 788 * MiB;
constexpr size_t WS_PROJ = 852 * MiB;
constexpr size_t WS_HB = 852 * MiB;
constexpr size_t WS_MIX = 1044 * MiB;
constexpr size_t WS_DIFF = 1108 * MiB;
constexpr size_t WS_XB = 1140 * MiB;
constexpr size_t WS_END = 1268 * MiB;
static_assert(WS_WIN + (size_t)DEPTH * PW * DM * 2 <= WS_WOUT && WS_WOUT + (size_t)DEPTH * DM * DM * 2 <= WS_WGU && WS_WGU + (size_t)DEPTH * NGU * DM * 2 <= WS_WD && WS_WD + (size_t)DEPTH * DM * FF * 2 <= WS_XN, "ws map (weights)");
static_assert(WS_XN + (size_t)M * DM * 2 <= WS_PROJ && WS_PROJ + (size_t)M * PW * 2 <= WS_MIX && WS_HB + (size_t)M * FF * 2 <= WS_MIX && WS_MIX + (size_t)M * DM * 2 <= WS_DIFF && WS_DIFF + (size_t)2 * M * 1024 * 2 <= WS_XB && WS_XB + (size_t)M * DM * 4 <= WS_END, "ws map (activations)");
constexpr int CW_TMO = 0, CW_CODE = 1, CW_BAR = 4096;
constexpr int RING_OFF = 0, RING_BYTES = 131072;
constexpr int LDSCTL_OFF = RING_BYTES, MISC_OFF = LDSCTL_OFF + 320;
constexpr int LDS_BYTES = 147456;

#define GAS __attribute__((address_space(1)))
#define LAS __attribute__((address_space(3)))
typedef unsigned short bf16;
typedef unsigned v4u __attribute__((ext_vector_type(4)));
typedef unsigned v2u __attribute__((ext_vector_type(2)));
typedef float f32x4 __attribute__((ext_vector_type(4)));
typedef float f32x2 __attribute__((ext_vector_type(2)));
typedef short bf16x8 __attribute__((ext_vector_type(8)));
typedef GAS unsigned gu32;
#define RLX_AGENT __ATOMIC_RELAXED, __HIP_MEMORY_SCOPE_AGENT
#define LDS_WAIT() asm volatile("s_waitcnt lgkmcnt(0)" ::: "memory")
#define VM_WAIT() asm volatile("s_waitcnt vmcnt(0)" ::: "memory")
__device__ __forceinline__ unsigned f2bf(float f) { unsigned u = __builtin_bit_cast(unsigned, f); return (u + 0x7fffu + ((u >> 16) & 1u)) >> 16; }
__device__ __forceinline__ unsigned pk2(float lo, float hi) { return f2bf(lo) | (f2bf(hi) << 16); }
__device__ __forceinline__ float bflo(unsigned w) { return __uint_as_float(w << 16); }
__device__ __forceinline__ float bfhi(unsigned w) { return __uint_as_float(w & 0xffff0000u); }
__device__ __forceinline__ float bf2f(bf16 b) { return __uint_as_float((unsigned)b << 16); }
__device__ __forceinline__ float shx(float v, int o, int lane) { return __int_as_float(__builtin_amdgcn_ds_bpermute((lane ^ o) << 2, __float_as_int(v))); }
__device__ __forceinline__ float wave_sum(float v, int lane) {
#pragma unroll
    for (int o = 1; o < 64; o <<= 1) v += shx(v, o, lane);
    return v;
}
__device__ __forceinline__ float wave_max(float v, int lane) {
#pragma unroll
    for (int o = 1; o < 64; o <<= 1) v = fmaxf(v, shx(v, o, lane));
    return v;
}
__device__ __forceinline__ float dpp_xor1(float v) { return __int_as_float(__builtin_amdgcn_mov_dpp(__float_as_int(v), 0xB1, 0xf, 0xf, true)); }
__device__ __forceinline__ int fresh_tid(int wave0) { int lane = (int)__builtin_amdgcn_mbcnt_hi(~0u, __builtin_amdgcn_mbcnt_lo(~0u, 0u)); asm volatile("" : "+v"(lane)); return wave0 * 64 + lane; }
#define FRESH_IDS(vcu_) const int tid = fresh_tid(wave0); const int lane = tid & 63, wave = wave0; const int gw = (vcu_) * NWAVES + wave; (void)gw; (void)lane; (void)wave; (void)tid

#define XB_TMO      128
#define XB_XCNT(j)  (256  + 64 * (j))
#define XB_XSUB(j)  (1280 + 64 * (j))
#define XB_XGEN(j)  (2304 + 64 * (j))
#define XB_TOP      3328
#define XB_TOPGEN   3392
#define XCD_BAR_WORDS 3456
#define XB_SPIN_CAP (1u << 18)

__device__ __forceinline__ unsigned xb_ld(unsigned* p)              { return __hip_atomic_load(p, __ATOMIC_RELAXED, __HIP_MEMORY_SCOPE_AGENT); }
__device__ __forceinline__ unsigned xb_add(unsigned* p, unsigned v) { return __hip_atomic_fetch_add(p, v, __ATOMIC_RELAXED, __HIP_MEMORY_SCOPE_AGENT); }
__device__ __forceinline__ unsigned xb_xcc_id() { return (unsigned)__builtin_amdgcn_s_getreg((3 << 11) | 20) & 0xFu; }
#define XB_SPIN(cond, bar) do { unsigned _sp = 0; while (cond) { __builtin_amdgcn_s_sleep(1); \
    if ((++_sp & 255u) == 0u) { if (xb_ld(&(bar)[XB_TMO])) break; if (_sp > XB_SPIN_CAP) { atomicAdd(&(bar)[XB_TMO], 1u); break; } } } } while (0)

struct XcdBarrier {
    unsigned* bar; unsigned x;
    volatile LAS unsigned* st;
};

__device__ __forceinline__ XcdBarrier xcd_barrier_post(unsigned* bar, volatile LAS unsigned* st) {
    XcdBarrier b; b.bar = bar; b.x = xb_xcc_id(); b.st = st;
    if (threadIdx.x == 0) (void)xb_add(&bar[XB_XCNT(b.x)], 1u);
    return b;
}
__device__ __forceinline__ void xcd_barrier_complete(unsigned* bar, unsigned x, unsigned& nloc, unsigned& nx) {
    const unsigned G = gridDim.x * gridDim.y * gridDim.z;
    unsigned sum, cnt, mine, sp = 0u;
    for (;;) {
        sum = 0u; cnt = 0u; mine = 0u;
#pragma unroll
        for (unsigned j = 0; j < 16; ++j) { const unsigned c = xb_ld(&bar[XB_XCNT(j)]); sum += c; cnt += (c > 0u) ? 1u : 0u; mine = (j == x) ? c : mine; }
        if (sum == G) break;
        __builtin_amdgcn_s_sleep(1);
        if ((++sp & 255u) == 0u) { if (xb_ld(&bar[XB_TMO])) break; if (sp > XB_SPIN_CAP) { atomicAdd(&bar[XB_TMO], 1u); break; } }
    }
    nloc = mine > 0u ? mine : 1u; nx = cnt > 0u ? cnt : 1u;
}

__device__ __forceinline__ void xcd_barrier(const XcdBarrier& b) {
    asm volatile("s_waitcnt vmcnt(0)" ::: "memory");
    __syncthreads();
    if (threadIdx.x == 0) {
        unsigned* bar = b.bar;
        __builtin_amdgcn_s_waitcnt(0);
        unsigned nloc = b.st[0], nx = b.st[1];
        if (nloc == 0u) { xcd_barrier_complete(bar, b.x, nloc, nx); b.st[0] = nloc; b.st[1] = nx; }
        const unsigned old = xb_add(&bar[XB_XSUB(b.x)], 1u);
        const unsigned gen = old / nloc;
        if (old + 1u == (gen + 1u) * nloc) {
            __builtin_amdgcn_fence(__ATOMIC_RELEASE, "agent");
            asm volatile("s_waitcnt vmcnt(0)" ::: "memory");
            const unsigned og = xb_add(&bar[XB_TOP], 1u);
            const unsigned tg = og / nx;
            if (og + 1u == (tg + 1u) * nx) xb_add(&bar[XB_TOPGEN], 1u);
            else XB_SPIN(xb_ld(&bar[XB_TOPGEN]) == tg, bar);
            __builtin_amdgcn_fence(__ATOMIC_ACQUIRE, "agent");
            xb_add(&bar[XB_XGEN(b.x)], 1u);
            asm volatile("s_waitcnt vmcnt(0)" ::: "memory");
        } else {
            XB_SPIN(xb_ld(&bar[XB_XGEN(b.x)]) == gen, bar);
            __builtin_amdgcn_fence(__ATOMIC_ACQUIRE, "agent");
            asm volatile("s_waitcnt vmcnt(0)" ::: "memory");
        }
    }
    __syncthreads();
}


namespace att {
typedef short s16x4 __attribute__((ext_vector_type(4)));
typedef float f32x16 __attribute__((ext_vector_type(16)));
typedef unsigned u32x4 __attribute__((ext_vector_type(4)));
constexpr int NW = 8, QBLK = 32, KVBLK = 64, QB = NW * QBLK, D = 128;
constexpr int SHM_V = KVBLK * D * 2, SHM_K = KVBLK * D * 2;
constexpr int OFF_WS = 2 * SHM_V + 2 * SHM_K, OFF_BIAS = OFF_WS + NW * 64 * 4, LDS_BYTES = OFF_BIAS + SEQ * 4;
constexpr float SCALE = 0.08838834764831845f, THR = 8.f;
constexpr int PITCH = PW;
#define KSWZ(row, colB) ((row) * 256 + ((colB) ^ (((row) & 7) << 4)))
#define SBAR() __builtin_amdgcn_sched_barrier(0)
__device__ __forceinline__ int v_st(int k, int c) { const int kk = (k & ~0xC) | ((k & 4) << 1) | ((k & 8) >> 1); return ((kk >> 3) * 4 + (c >> 5)) * 512 + ((kk & 7) * 32 + (c & 31)) * 2; }
__device__ __forceinline__ int v_rd_base(int lane) { return ((lane & 3) << 3) | (((lane >> 2) & 3) << 6) | (((lane >> 4) & 1) << 5) | (((lane >> 5) & 1) << 8); }
constexpr int v_rd_off(int d0, int ks, int half) { return d0 * 512 + ks * 4096 + half * 2048; }
__device__ __forceinline__ int crow(int r, int hi) { return (r & 3) + 8 * (r >> 2) + 4 * hi; }
__device__ __forceinline__ unsigned cvtpk(float lo, float hi) { unsigned r; asm volatile("v_cvt_pk_bf16_f32 %0, %1, %2" : "=v"(r) : "v"(lo), "v"(hi)); return r; }
__device__ __forceinline__ bf16x8 load8(const bf16* p) { return *reinterpret_cast<const bf16x8*>(p); }
__device__ __forceinline__ void mask_tile(f32x16& p0, f32x16& p1, int dq) {
    const float NEG = -__builtin_inff();
#pragma unroll
    for (int r = 0; r < 16; ++r) { const int c = (r & 3) + 8 * (r >> 2); if (dq - c < 0) p0[r] = NEG; if (dq - c - 32 < 0) p1[r] = NEG; }
}
__device__ __forceinline__ void partialSM(f32x16& p0, f32x16& p1, float& m_reg, float& mn, float& alpha) {
    float pmax = p0[0];
#pragma unroll
    for (int r = 1; r < 16; ++r) pmax = fmaxf(pmax, p0[r]);
#pragma unroll
    for (int r = 0; r < 16; ++r) pmax = fmaxf(pmax, p1[r]);
    { auto rr = __builtin_amdgcn_permlane32_swap(__float_as_uint(pmax), __float_as_uint(pmax), false, false); pmax = fmaxf(__uint_as_float(rr[0]), __uint_as_float(rr[1])); }
    constexpr float C2 = 1.4426950408889634f * SCALE;
    if (__builtin_expect(__all((pmax - m_reg) * SCALE <= THR), 1)) { mn = m_reg; alpha = 1.f; }
    else { mn = fmaxf(m_reg, pmax); alpha = __builtin_amdgcn_exp2f((m_reg - mn) * C2); m_reg = mn; }
    const float mnL = -mn * C2;
#pragma unroll
    for (int r = 0; r < 16; ++r) p0[r] = fmaf(p0[r], C2, mnL);
#pragma unroll
    for (int r = 0; r < 16; ++r) p1[r] = fmaf(p1[r], C2, mnL);
#pragma unroll
    for (int r = 0; r < 16; ++r) p0[r] = __builtin_amdgcn_exp2f(p0[r]);
}
__device__ __forceinline__ void finishSM(f32x16& p0, f32x16& p1, float alpha, float& l_reg, bf16x8& pa0, bf16x8& pa1, bf16x8& pa2, bf16x8& pa3) {
#pragma unroll
    for (int r = 0; r < 16; ++r) p1[r] = __builtin_amdgcn_exp2f(p1[r]);
    float ps = 0;
#pragma unroll
    for (int r = 0; r < 16; ++r) ps += p0[r];
#pragma unroll
    for (int r = 0; r < 16; ++r) ps += p1[r];
    { auto rr = __builtin_amdgcn_permlane32_swap(__float_as_uint(ps), __float_as_uint(ps), false, false); ps = __uint_as_float(rr[0]) + __uint_as_float(rr[1]); }
    l_reg = l_reg * alpha + ps;
#define PK4(P, B_, OUT) do { unsigned a0 = cvtpk(P[B_+0], P[B_+1]), a1 = cvtpk(P[B_+2], P[B_+3]);                          \
        unsigned b0 = cvtpk(P[B_+4], P[B_+5]), b1 = cvtpk(P[B_+6], P[B_+7]);                                             \
        auto r0 = __builtin_amdgcn_permlane32_swap(a0, b0, false, false); auto r1 = __builtin_amdgcn_permlane32_swap(a1, b1, false, false); \
        u32x4 w = {r0[0], r1[0], r0[1], r1[1]}; OUT = *reinterpret_cast<bf16x8*>(&w); } while (0)
    PK4(p0, 0, pa0); PK4(p0, 8, pa1); PK4(p1, 0, pa2); PK4(p1, 8, pa3);
#undef PK4
}
template <int KB>
__device__ __forceinline__ void qkt(f32x16& p0, f32x16& p1, const char* K_lds, int r32, int hi, const bf16x8* qr, const float* bt, float rowinit) {
    if (bt) { const f32x4* bp = (const f32x4*)(bt + 4 * hi);
#pragma unroll
        for (int g = 0; g < 4; ++g) { const f32x4 a = bp[2 * g], b = bp[2 * g + 8];
            p0[4 * g] = a[0]; p0[4 * g + 1] = a[1]; p0[4 * g + 2] = a[2]; p0[4 * g + 3] = a[3]; p1[4 * g] = b[0]; p1[4 * g + 1] = b[1]; p1[4 * g + 2] = b[2]; p1[4 * g + 3] = b[3]; } }
    else {
#pragma unroll
        for (int r = 0; r < 16; ++r) { p0[r] = rowinit; p1[r] = rowinit; } }
    const char* kb[4];
#pragma unroll
    for (int dd = 0; dd < 4; ++dd) kb[dd] = K_lds + KB * SHM_K + KSWZ(r32, (dd * 16 + hi * 8) * 2);
#pragma unroll
    for (int d0 = 0; d0 < 8; ++d0) { const char* a = kb[d0 & 3] + (d0 >> 2) * 128;
        bf16x8 b0 = *reinterpret_cast<const bf16x8*>(a);
        bf16x8 b1 = *reinterpret_cast<const bf16x8*>(a + 32 * 256);
        p0 = __builtin_amdgcn_mfma_f32_32x32x16_bf16(b0, qr[d0], p0, 0, 0, 0);
        p1 = __builtin_amdgcn_mfma_f32_32x32x16_bf16(b1, qr[d0], p1, 0, 0, 0); }
}
template <int VB>
__device__ __forceinline__ void pv_tile(f32x16* o, int vb0, bf16x8 pa0, bf16x8 pa1, bf16x8 pa2, bf16x8 pa3) {
#define TRRD(dst, off) asm volatile("ds_read_b64_tr_b16 %0, %1 offset:%2" : "=&v"(dst) : "v"(vb0), "i"(off) : "memory")
#define PV_D0(d0) do { s16x4 l0, l1, l2, l3, h0, h1, h2, h3; constexpr int b_ = VB * SHM_V + v_rd_off(d0, 0, 0); \
        TRRD(l0, b_); TRRD(h0, b_ + 2048); TRRD(l1, b_ + 4096); TRRD(h1, b_ + 6144); TRRD(l2, b_ + 8192); TRRD(h2, b_ + 10240); TRRD(l3, b_ + 12288); TRRD(h3, b_ + 14336); \
        asm volatile("s_waitcnt lgkmcnt(0)" ::: "memory"); SBAR();   \
        o[d0] = __builtin_amdgcn_mfma_f32_32x32x16_bf16(pa0, (bf16x8){l0[0], l0[1], l0[2], l0[3], h0[0], h0[1], h0[2], h0[3]}, o[d0], 0, 0, 0);   \
        o[d0] = __builtin_amdgcn_mfma_f32_32x32x16_bf16(pa1, (bf16x8){l1[0], l1[1], l1[2], l1[3], h1[0], h1[1], h1[2], h1[3]}, o[d0], 0, 0, 0);   \
        o[d0] = __builtin_amdgcn_mfma_f32_32x32x16_bf16(pa2, (bf16x8){l2[0], l2[1], l2[2], l2[3], h2[0], h2[1], h2[2], h2[3]}, o[d0], 0, 0, 0);   \
        o[d0] = __builtin_amdgcn_mfma_f32_32x32x16_bf16(pa3, (bf16x8){l3[0], l3[1], l3[2], l3[3], h3[0], h3[1], h3[2], h3[3]}, o[d0], 0, 0, 0); } while (0)
    PV_D0(0); PV_D0(1); PV_D0(2); PV_D0(3);
#undef PV_D0
#undef TRRD
}
struct BlockRef { int bh, qb; };
struct HeadCols { int qcol, kcol, vcol, type, ocol, opitch; size_t obase_off; };
__device__ __forceinline__ HeadCols head_cols(int hidx) {
    HeadCols d;
    if (hidx < 12) { d.type = 0; d.qcol = C_QM + hidx * HD; d.kcol = C_KM + hidx * HD; d.vcol = C_VM + hidx * HD; d.obase_off = WS_MIX; d.opitch = DM; d.ocol = hidx * HD; }
    else if (hidx < 24) { const int h = hidx - 12; d.type = 1; d.qcol = C_QF + h * HD; d.kcol = C_KF + h * HD; d.vcol = C_VF + h * HD; d.obase_off = WS_MIX; d.opitch = DM; d.ocol = 1536 + h * HD; }
    else { const int x = hidx - 24, h = x >> 2, mp = (x >> 1) & 1, e = x & 1; d.type = 2; d.qcol = C_QD + h * 256 + mp * HD; d.kcol = C_KD + h * 256 + mp * HD; d.vcol = C_VD + h * 256 + e * HD;
        d.obase_off = WS_DIFF + (size_t)mp * M * 1024 * 2; d.opitch = 1024; d.ocol = h * 256 + e * HD; }
    return d;
}
#define LAUNDER_S(x) asm volatile("" : "+s"(x))
struct Seam { bf16x8 qr[8]; bf16x8 st_v0, st_v1, st_k0, st_k1; };
#define ROW(p, k0, rr) ((p) + (size_t)((k0) + (rr)) * PITCH + sc)
#define VMW() asm volatile("s_waitcnt vmcnt(0)" ::: "memory")
#define VMWN(n) asm volatile("s_waitcnt vmcnt(%0)" :: "i"(n) : "memory")
#define SLOAD_H(Kp, Vp, k0) do { S.st_v0 = load8(ROW(Vp, k0, sr)); S.st_v1 = load8(ROW(Vp, k0, 32 + sr)); S.st_k0 = load8(ROW(Kp, k0, sr)); S.st_k1 = load8(ROW(Kp, k0, 32 + sr)); } while (0)
#define SWRITE_HK(bf) do { *(bf16x8*)(K_lds + (bf) * SHM_K + kws) = S.st_k0; *(bf16x8*)(K_lds + (bf) * SHM_K + kws + 32 * 256) = S.st_k1; } while (0)
#define SWRITE_HV(bf) do { *(bf16x8*)(V_lds + (bf) * SHM_V + vst0) = S.st_v0; *(bf16x8*)(V_lds + (bf) * SHM_V + vst1) = S.st_v1; } while (0)
#define SWRITE_H(bf) do { SWRITE_HV(bf); SWRITE_HK(bf); } while (0)
__device__ __forceinline__ void prime(BlockRef cur, unsigned char* wsb, char* lds, Seam& S, int tid) {
    const int wid = __builtin_amdgcn_readfirstlane(tid >> 6), lane = tid & 63, r32 = lane & 31, hi = lane >> 5;
    const int sr = tid >> 4, sc = (tid & 15) * 8, kws = KSWZ(sr, sc * 2); char* K_lds = lds + 2 * SHM_V;
    const int b = cur.bh / NATT; const HeadCols hc = head_cols(cur.bh - b * NATT);
    const bf16* PROJ = (const bf16*)(wsb + WS_PROJ); const size_t rowb = (size_t)b * SEQ;
    const bf16* Qp = PROJ + (rowb + (size_t)cur.qb * QB) * PITCH + hc.qcol; const bf16* Kp = PROJ + rowb * PITCH + hc.kcol; const bf16* Vp = PROJ + rowb * PITCH + hc.vcol;
#pragma unroll
    for (int d0 = 0; d0 < 8; ++d0) S.qr[d0] = load8(Qp + (size_t)(wid * QBLK + r32) * PITCH + d0 * 16 + hi * 8);
    SLOAD_H(Kp, Vp, 0); VMW(); SWRITE_HK(0);
    __syncthreads();
}
__device__ __forceinline__ void block(BlockRef cur, BlockRef nxt, unsigned char* wsb, char* lds, Seam& S, int tid) {
    const int wid = __builtin_amdgcn_readfirstlane(tid >> 6), lane = tid & 63, r32 = lane & 31, hi = lane >> 5;
    const int P0 = cur.qb * QB;
    const int NT = (P0 + QB) / KVBLK;
    const int qlo = P0 + wid * QBLK, qm = qlo + r32 - 4 * hi;
    char* V_lds = lds; char* K_lds = lds + 2 * SHM_V;
    float* ws = (float*)(lds + OFF_WS) + wid * 64; float* li_l = ws, * al_l = ws + 32;
    float* blds = (float*)(lds + OFF_BIAS);
    float m_reg = -1e30f, l_reg = 0; f32x16 o[4] = {};
    const int sr = tid >> 4, sc = (tid & 15) * 8, vst0 = v_st(sr, sc), vst1 = v_st(32 + sr, sc), kws = KSWZ(sr, sc * 2);
    const int vb0 = (int)(uintptr_t)V_lds + v_rd_base(lane);
    const int cb = cur.bh / NATT, chx = cur.bh - cb * NATT; const HeadCols hc = head_cols(chx);
    const bf16* Kh = (const bf16*)(wsb + WS_PROJ) + (size_t)cb * SEQ * PITCH + hc.kcol; const bf16* Vh = (const bf16*)(wsb + WS_PROJ) + (size_t)cb * SEQ * PITCH + hc.vcol;
    const bool hb = hc.type == 1;
    unsigned selm = 0xffffffffu; if (hc.type == 0) selm = ((const unsigned*)(wsb + WS_SELM))[(size_t)(cb * 12 + chx) * SEQ + P0 + wid * QBLK + r32];
    if (hb) { const float* bias = (const float*)(wsb + WS_BRAW) + (size_t)(cb * 12 + (chx - 12)) * SEQ; const float ref = bias[P0]; const int n4 = (P0 + QB) / 4;
        for (int i = tid; i < n4; i += NW * 64) { f32x4 v = ((const f32x4*)bias)[i]; v = v - ref; ((f32x4*)blds)[i] = v; }
        __syncthreads(); }
#define RESC(a) do { if (__any((a) < 1.f)) { if (hi == 0) al_l[r32] = (a); asm volatile("s_waitcnt lgkmcnt(0)" ::: "memory");              \
                     for (int d_ = 0; d_ < 4; ++d_) for (int r = 0; r < 16; ++r) o[d_][r] *= al_l[crow(r, hi)]; } } while (0)
#define KBASE(t) ((t) * KVBLK)
#define BT(t) (hb ? blds + KBASE(t) : (const float*)nullptr)
#define RI(t) ((((selm >> ((t) >> 2)) & 1u) != 0u) ? 0.f : -__builtin_inff())
#define MASKT(P0_, P1_, t) do { const int kb_ = KBASE(t); if (kb_ + KVBLK - 1 > qlo) mask_tile(P0_, P1_, qm - kb_); } while (0)
#define SEAM_K0() do { VMWN(8); SWRITE_HK(0); SBAR(); } while (0)
    f32x16 pA0, pA1, pB0, pB1; float mnA, mnB, alA, alB; bf16x8 pa0, pa1, pa2, pa3;
    SWRITE_HV(0); SBAR();
    SLOAD_H(Kh, Vh, KBASE(1));
    SBAR(); qkt<0>(pA0, pA1, K_lds, r32, hi, S.qr, BT(0), RI(0));
    MASKT(pA0, pA1, 0); partialSM(pA0, pA1, m_reg, mnA, alA);
    VMW(); SWRITE_H(1);
    __syncthreads();
#define HALF_STEP(PX0, PX1, mnX, alX, PY0, PY1, alY, t, KB, VB, SB) do {                                                      \
        SBAR(); qkt<KB>(PX0, PX1, K_lds, r32, hi, S.qr, BT(t), RI(t));                                                        \
        finishSM(PY0, PY1, alY, l_reg, pa0, pa1, pa2, pa3); SBAR();                                                           \
        if ((t) + 1 < NT) { SLOAD_H(Kh, Vh, KBASE((t) + 1)); SBAR(); }                                                        \
        pv_tile<VB>(o, vb0, pa0, pa1, pa2, pa3); MASKT(PX0, PX1, (t)); partialSM(PX0, PX1, m_reg, mnX, alX);                  \
        __syncthreads();                                                                                                      \
        if ((t) + 1 < NT) { VMW(); SWRITE_H(SB); }                                                                            \
        RESC(alX); __syncthreads(); } while (0)
    for (int t = 1; t + 1 < NT; t += 2) {
        HALF_STEP(pB0, pB1, mnB, alB, pA0, pA1, alA, t, 1, 0, 0);
        HALF_STEP(pA0, pA1, mnA, alA, pB0, pB1, alB, t + 1, 0, 1, 1);
    }
    SBAR(); qkt<1>(pB0, pB1, K_lds, r32, hi, S.qr, BT(NT - 1), RI(NT - 1)); SBAR();
    { int nbh = nxt.bh, nqb = nxt.qb; LAUNDER_S(nbh); LAUNDER_S(nqb);
      const int nb = nbh / NATT; const HeadCols nh = head_cols(nbh - nb * NATT); const bf16* PROJ = (const bf16*)(wsb + WS_PROJ); const size_t rowb = (size_t)nb * SEQ;
      const bf16* nK = PROJ + rowb * PITCH + nh.kcol; const bf16* nV = PROJ + rowb * PITCH + nh.vcol; const bf16* nQ = PROJ + (rowb + (size_t)nqb * QB) * PITCH + nh.qcol;
      SLOAD_H(nK, nV, 0); SBAR();
#pragma unroll
      for (int d0 = 0; d0 < 8; ++d0) S.qr[d0] = load8(nQ + (size_t)(wid * QBLK + r32) * PITCH + d0 * 16 + hi * 8); }
    SBAR();
    finishSM(pA0, pA1, alA, l_reg, pa0, pa1, pa2, pa3); SBAR();
    pv_tile<0>(o, vb0, pa0, pa1, pa2, pa3);
    MASKT(pB0, pB1, NT - 1); partialSM(pB0, pB1, m_reg, mnB, alB); __syncthreads(); RESC(alB);
    finishSM(pB0, pB1, alB, l_reg, pa0, pa1, pa2, pa3); SBAR(); pv_tile<1>(o, vb0, pa0, pa1, pa2, pa3);
    SBAR(); SEAM_K0();
    if (hi == 0) li_l[r32] = l_reg; asm volatile("s_waitcnt lgkmcnt(0)" ::: "memory");
    float rli[16];
#pragma unroll
    for (int r = 0; r < 16; ++r) rli[r] = __builtin_amdgcn_rcpf(li_l[crow(r, hi)]);
    { int obh = cur.bh, oqb = cur.qb; LAUNDER_S(obh); LAUNDER_S(oqb);
      const int ob = obh / NATT; const HeadCols oh = head_cols(obh - ob * NATT); const int opitch = oh.opitch;
      bf16* Ow = (bf16*)(wsb + oh.obase_off) + ((size_t)ob * SEQ + (size_t)oqb * QB + wid * QBLK) * opitch + oh.ocol;
      int hi_e = hi; asm volatile("" : "+v"(hi_e));
      bf16* Ol = Ow + (size_t)(4 * hi_e) * opitch + r32;
#pragma unroll
      for (int r = 0; r < 16; ++r) { const int orow = (r & 3) + 8 * (r >> 2);
#pragma unroll
        for (int d0 = 0; d0 < 4; ++d0) { const float v = o[d0][r] * rli[r]; const float vn = __int_as_float(__builtin_amdgcn_mov_dpp(__float_as_int(v), 0xB1, 0xf, 0xf, true));
            if ((r32 & 1) == 0) *(unsigned*)(Ol + (size_t)orow * opitch + d0 * 32) = cvtpk(v, vn); } } }
    __syncthreads();
#undef RESC
#undef KBASE
#undef BT
#undef RI
#undef MASKT
#undef SEAM_K0
#undef HALF_STEP
}
#undef ROW
#undef VMW
#undef VMWN
#undef SLOAD_H
#undef SWRITE_HK
#undef SWRITE_HV
#undef SWRITE_H
#undef KSWZ
#undef SBAR
}

struct Args { const float* in[20]; float* out; unsigned char* ws; int ph_lo, ph_hi; };
typedef const __attribute__((address_space(4))) Args* KArgs;
__device__ __forceinline__ KArgs kargs() { KArgs k = (KArgs)__builtin_amdgcn_kernarg_segment_ptr(); asm volatile("" : "+s"(k)); return k; }

__device__ __forceinline__ void p0_transpose_item(const float* W, int srcStride, int srcCol0, int k0, bf16* WT, int K, int dstRow0, LAS float* scr, int lane) {
#pragma unroll 8
    for (int i = 0; i < 32; ++i) { const int kk = 2 * i + (lane >> 5); scr[kk * 33 + (lane & 31)] = W[(size_t)(k0 + kk) * srcStride + srcCol0 + (lane & 31)]; }
    LDS_WAIT(); asm volatile("" ::: "memory");
    const int c = lane & 7;
#pragma unroll
    for (int j = 0; j < 4; ++j) { const int n = (lane >> 3) + 8 * j; const LAS float* s = scr + (8 * c) * 33 + n;
        v4u o; o.x = pk2(s[0 * 33], s[1 * 33]); o.y = pk2(s[2 * 33], s[3 * 33]); o.z = pk2(s[4 * 33], s[5 * 33]); o.w = pk2(s[6 * 33], s[7 * 33]);
        *(GAS v4u*)(WT + (size_t)(dstRow0 + n) * K + k0 + 8 * c) = o; }
    LDS_WAIT(); asm volatile("" ::: "memory");
}
constexpr int I_IN = (DM / 64) * (PW / 32), I_OUT = (DM / 64) * (DM / 32), I_G = (DM / 64) * (FF / 32), I_D = (FF / 64) * (DM / 32);
constexpr int I_LAYER = I_IN + I_OUT + 2 * I_G + I_D;
__device__ __forceinline__ void p0_prologue(unsigned char* ws, LAS unsigned char* lds, int vcu, int NGW, int wave0) {
    FRESH_IDS(vcu);
    KArgs ka = kargs(); const float* in2 = ka->in[2]; const float* in15 = ka->in[15]; const float* in17 = ka->in[17]; const float* in18 = ka->in[18]; const float* in19 = ka->in[19];
    LAS float* scr = (LAS float*)(lds + RING_OFF + wave * 16384);
    for (int it0 = gw; it0 < DEPTH * I_LAYER; it0 += NGW) {
        const int l = it0 / I_LAYER; int r = it0 - l * I_LAYER;
        if (r < I_IN) { const int nblk = PW / 32, kb = r / nblk, nb = r - kb * nblk, n0 = nb * 32;
            p0_transpose_item(in2 + (size_t)l * DM * INW, INW, n0 + (n0 >= C_QD ? 12 : 0), 64 * kb, (bf16*)(ws + WS_WIN) + (size_t)l * PW * DM, DM, n0, scr, lane); continue; }
        r -= I_IN;
        if (r < I_OUT) { const int nblk = DM / 32, kb = r / nblk, nb = r - kb * nblk;
            p0_transpose_item(in15 + (size_t)l * DM * DM, DM, nb * 32, 64 * kb, (bf16*)(ws + WS_WOUT) + (size_t)l * DM * DM, DM, nb * 32, scr, lane); continue; }
        r -= I_OUT;
        if (r < 2 * I_G) { const int which = r >= I_G; if (which) r -= I_G; const int nblk = FF / 32, kb = r / nblk, nb = r - kb * nblk, n0 = nb * 32;
            p0_transpose_item((which ? in18 : in17) + (size_t)l * DM * FF, FF, n0, 64 * kb, (bf16*)(ws + WS_WGU) + (size_t)l * NGU * DM, DM, (n0 >> 7) * 256 + which * 128 + (n0 & 127), scr, lane); continue; }
        r -= 2 * I_G;
        { const int nblk = DM / 32, kb = r / nblk, nb = r - kb * nblk;
            p0_transpose_item(in19 + (size_t)l * FF * DM, DM, nb * 32, 64 * kb, (bf16*)(ws + WS_WD) + (size_t)l * DM * FF, FF, nb * 32, scr, lane); }
    }
    const int gt = gw * 64 + lane, NGT = NGW * 64;
    for (int i = gt; i < DEPTH * 16 * DM; i += NGT) { const int l = i / (16 * DM), c = (i / DM) & 15, k = i % DM;
        ((bf16*)(ws + WS_WF))[i] = (c < 12) ? (bf16)f2bf(in2[((size_t)l * DM + k) * INW + 9216 + c]) : (bf16)0; }
    for (int i = gt; i < SEQ * 64; i += NGT) { const int pos = i >> 6, fi = i & 63;
        const float invf = 1.0f / powf(10000.0f, (float)fi * (1.0f / 64.0f)); const float ang = (float)pos * invf;
        const double rev = (double)ang * 0.15915494309189533576888; const float fr = (float)(rev - rint(rev));
        ((f32x2*)(ws + WS_ROPE))[i] = (f32x2){__builtin_amdgcn_cosf(fr), __builtin_amdgcn_sinf(fr)}; }
}

__device__ __forceinline__ void rmsnorm_phase(const float* x, const float* g, bf16* XN, int vcu, int NGW, int wave0) {
    FRESH_IDS(vcu);
    const GAS f32x4* gr = (const GAS f32x4*)g + lane;
    for (int m = gw; m < M; m += NGW) {
        const GAS f32x4* xr = (const GAS f32x4*)(x + (size_t)m * DM) + lane;
        f32x4 v[16]; float s = 0.f;
#pragma unroll
        for (int j = 0; j < 16; ++j) { v[j] = xr[64 * j]; s += (v[j].x * v[j].x + v[j].y * v[j].y) + (v[j].z * v[j].z + v[j].w * v[j].w); }
        const float rstd = 1.0f / sqrtf(wave_sum(s, lane) * (1.0f / DM) + NORM_EPS);
        GAS v2u* o8 = (GAS v2u*)(XN + (size_t)m * DM) + lane;
#pragma unroll
        for (int j = 0; j < 16; ++j) { const f32x4 gg = gr[64 * j]; v2u o; o.x = pk2(v[j].x * rstd * gg.x, v[j].y * rstd * gg.y); o.y = pk2(v[j].z * rstd * gg.z, v[j].w * rstd * gg.w); o8[64 * j] = o; }
    }
}
constexpr int T3A_ITEMS = (M / 32) * 16, T3B_ITEMS = M / 16;
__device__ __forceinline__ void t3_phase(unsigned char* ws, int l, int vcu, int NGW, int wave0) {
    FRESH_IDS(vcu);
    KArgs ka = kargs();
    bf16* PROJ = (bf16*)(ws + WS_PROJ);
    for (int it = gw; it < T3A_ITEMS + T3B_ITEMS; it += NGW) {
        if (it < T3A_ITEMS) {
            const int chunk = it >> 4, g = it & 15;
            int col0; const float* gsel; bool rot, km = false;
            if (g < 3) { col0 = C_QM + 512 * g; gsel = ka->in[3]; rot = true; }
            else if (g < 6) { col0 = C_KM + 512 * (g - 3); gsel = ka->in[4]; rot = true; km = true; }
            else if (g < 9) { col0 = C_QF + 512 * (g - 6); gsel = ka->in[5]; rot = false; }
            else if (g < 12) { col0 = C_KF + 512 * (g - 9); gsel = ka->in[6]; rot = false; }
            else if (g < 14) { col0 = C_QD + 512 * (g - 12); gsel = ka->in[8]; rot = true; }
            else { col0 = C_KD + 512 * (g - 14); gsel = ka->in[9]; rot = true; }
            const int hv = lane >> 4, c8 = (lane & 15) * 8;
            const float* gp = gsel + l * HD + c8; float gn[8];
#pragma unroll
            for (int e = 0; e < 8; ++e) gn[e] = gp[e];
            float ks[8];
#pragma unroll
            for (int e = 0; e < 8; ++e) ks[e] = 0.f;
            for (int rr = 0; rr < 32; ++rr) {
                const int row = chunk * 32 + rr, pos = row & (SEQ - 1);
                GAS v4u* p = (GAS v4u*)(PROJ + (size_t)row * PW + col0 + hv * 128 + c8);
                const v4u w = *p; float y[8];
                y[0] = bflo(w.x); y[1] = bfhi(w.x); y[2] = bflo(w.y); y[3] = bfhi(w.y); y[4] = bflo(w.z); y[5] = bfhi(w.z); y[6] = bflo(w.w); y[7] = bfhi(w.w);
                float ss = 0.f;
#pragma unroll
                for (int e = 0; e < 8; ++e) ss += y[e] * y[e];
                ss += shx(ss, 1, lane); ss += shx(ss, 2, lane); ss += shx(ss, 4, lane); ss += shx(ss, 8, lane);
                const float sc = 1.0f / sqrtf(ss * (1.0f / HD) + NORM_EPS);
#pragma unroll
                for (int e = 0; e < 8; ++e) y[e] = y[e] * sc * gn[e];
                if (rot) {
                    const GAS f32x4* rp = (const GAS f32x4*)((const float*)(ws + WS_ROPE) + ((size_t)pos * 64 + (c8 & 63)) * 2);
                    const f32x4 r0 = rp[0], r1 = rp[1], r2 = rp[2], r3 = rp[3];
                    const float cs[8] = {r0.x, r0.z, r1.x, r1.z, r2.x, r2.z, r3.x, r3.z}, sn[8] = {r0.y, r0.w, r1.y, r1.w, r2.y, r2.w, r3.y, r3.w};
                    const bool up = (lane & 8) != 0;
#pragma unroll
                    for (int e = 0; e < 8; ++e) { const float o = shx(y[e], 8, lane); y[e] = up ? (y[e] * cs[e] + o * sn[e]) : (y[e] * cs[e] - o * sn[e]); }
                }
                v4u o; o.x = pk2(y[0], y[1]); o.y = pk2(y[2], y[3]); o.z = pk2(y[4], y[5]); o.w = pk2(y[6], y[7]);
                *p = o;
                if (km) {
#pragma unroll
                    for (int e = 0; e < 8; ++e) ks[e] += y[e];
                }
            }
            if (km) {
                const int b = chunk >> 7, blk = (chunk & 127) >> 3, sub = chunk & 7, h = 4 * (g - 3) + hv;
                float* kp = (float*)(ws + WS_KPART) + ((((size_t)(b * 12 + h) * NBLK + blk) * 8 + sub) * HD) + c8;
                *(f32x4*)kp = (f32x4){ks[0], ks[1], ks[2], ks[3]}; *(f32x4*)(kp + 4) = (f32x4){ks[4], ks[5], ks[6], ks[7]};
            }
        } else {
            const int t = it - T3A_ITEMS;
            const bf16* A = (const bf16*)(ws + WS_XN) + (size_t)(16 * t + (lane & 15)) * DM + 8 * (lane >> 4);
            const bf16* B = (const bf16*)(ws + WS_WF) + (size_t)l * 16 * DM + (size_t)(lane & 15) * DM + 8 * (lane >> 4);
            f32x4 acc = {0.f, 0.f, 0.f, 0.f};
#pragma unroll 8
            for (int i = 0; i < DM / 32; ++i) { const bf16x8 a = *(const bf16x8*)(A + 32 * i), b = *(const bf16x8*)(B + 32 * i); acc = __builtin_amdgcn_mfma_f32_16x16x32_bf16(a, b, acc, 0, 0, 0); }
            const int c = lane & 15;
            if (c < 12) { const float fb = ka->in[7][l * 12 + c];
#pragma unroll
                for (int r = 0; r < 4; ++r) { const float z = acc[r] + fb; const float ls = fminf(z, 0.f) - log1pf(expf(-fabsf(z)));
                    ((float*)(ws + WS_LOGF))[(size_t)(16 * t + 4 * (lane >> 4) + r) * 16 + c] = ls; } }
        }
    }
}
__device__ __forceinline__ void t4_phase(unsigned char* ws, LAS unsigned char* lds, int vcu, int G, int wave0) {
    FRESH_IDS(vcu);
    LAS float* kmean = (LAS float*)(lds + RING_OFF);
    const bf16* PROJ = (const bf16*)(ws + WS_PROJ);
    for (int it = vcu; it < BATCH * 12 * NBLK + BATCH * 12; it += G) {
        if (it < BATCH * 12 * NBLK) {
            const int bh = it / NBLK, j = it % NBLK, b = bh / 12, h = bh % 12;
            for (int idx = tid; idx < j * HD; idx += NWAVES * 64) { const int n = idx >> 7, d = idx & 127;
                const float* kp = (const float*)(ws + WS_KPART) + (((size_t)bh * NBLK + n) * 8) * HD + d; float s = 0.f;
#pragma unroll
                for (int sub = 0; sub < 8; ++sub) s += kp[sub * HD];
                kmean[idx] = s * (1.0f / 256.0f); }
            __syncthreads();
            if (tid < 256) {
                const int s_ = 256 * j + tid; const size_t row = (size_t)b * SEQ + s_;
                const GAS v4u* qp = (const GAS v4u*)(PROJ + row * PW + C_QM + h * HD);
                float best[3] = {-INFINITY, -INFINITY, -INFINITY}; int bi[3] = {-1, -1, -1};
                for (int n = 0; n < j; ++n) { float gsum = 0.f;
#pragma unroll
                    for (int c = 0; c < 16; ++c) { const v4u w = qp[c]; const LAS f32x4* km = (const LAS f32x4*)(kmean + n * HD + 8 * c); const f32x4 k0 = km[0], k1 = km[1];
                        gsum += bflo(w.x) * k0.x + bfhi(w.x) * k0.y + bflo(w.y) * k0.z + bfhi(w.y) * k0.w + bflo(w.z) * k1.x + bfhi(w.z) * k1.y + bflo(w.w) * k1.z + bfhi(w.w) * k1.w; }
                    if (gsum > best[0]) { best[2] = best[1]; bi[2] = bi[1]; best[1] = best[0]; bi[1] = bi[0]; best[0] = gsum; bi[0] = n; }
                    else if (gsum > best[1]) { best[2] = best[1]; bi[2] = bi[1]; best[1] = gsum; bi[1] = n; }
                    else if (gsum > best[2]) { best[2] = gsum; bi[2] = n; } }
                unsigned mask = 1u << j;
#pragma unroll
                for (int q = 0; q < 3; ++q) if (bi[q] >= 0) mask |= 1u << bi[q];
                ((unsigned*)(ws + WS_SELM))[(size_t)bh * SEQ + s_] = mask;
            }
            __syncthreads();
        } else if (wave == 0) {
            const int bh = it - BATCH * 12 * NBLK, b = bh / 12, h = bh % 12;
            const float* lf = (const float*)(ws + WS_LOGF) + ((size_t)b * SEQ + 64 * lane) * 16 + h;
            double loc = 0.0;
            for (int i = 0; i < 64; ++i) loc += (double)lf[i * 16];
            double inc = loc;
#pragma unroll
            for (int o = 1; o < 64; o <<= 1) { const long long bits = __builtin_bit_cast(long long, inc); const int src = (lane >= o ? lane - o : lane) << 2;
                const unsigned lo_ = (unsigned)__builtin_amdgcn_ds_bpermute(src, (int)(unsigned)bits), hi_ = (unsigned)__builtin_amdgcn_ds_bpermute(src, (int)(unsigned)(bits >> 32));
                const double t = __builtin_bit_cast(double, ((unsigned long long)hi_ << 32) | lo_); if (lane >= o) inc += t; }
            double run = inc - loc;
            float* br = (float*)(ws + WS_BRAW) + (size_t)bh * SEQ + 64 * lane;
            for (int i = 0; i < 64; ++i) { run += (double)lf[i * 16]; br[i] = (float)(-run * 11.313708498984761); }
        }
    }
}
struct AttnDesc { int qcol, kcol, vcol, type; bf16* obase; int opitch, ocol; };
__device__ __forceinline__ AttnDesc attn_desc(int hidx, unsigned char* ws) {
    AttnDesc d;
    if (hidx < 12) { d.type = 0; d.qcol = C_QM + hidx * HD; d.kcol = C_KM + hidx * HD; d.vcol = C_VM + hidx * HD; d.obase = (bf16*)(ws + WS_MIX); d.opitch = DM; d.ocol = hidx * HD; }
    else if (hidx < 24) { const int h = hidx - 12; d.type = 1; d.qcol = C_QF + h * HD; d.kcol = C_KF + h * HD; d.vcol = C_VF + h * HD; d.obase = (bf16*)(ws + WS_MIX); d.opitch = DM; d.ocol = 1536 + h * HD; }
    else { const int x = hidx - 24, h = x >> 2, mp = (x >> 1) & 1, e = x & 1; d.type = 2; d.qcol = C_QD + h * 256 + mp * HD; d.kcol = C_KD + h * 256 + mp * HD; d.vcol = C_VD + h * 256 + e * HD;
        d.obase = (bf16*)(ws + WS_DIFF) + (size_t)mp * M * 1024; d.opitch = 1024; d.ocol = h * 256 + e * HD; }
    return d;
}
__device__ __forceinline__ void attn_naive_phase(unsigned char* ws, int vcu, int NGW, int wave0) {
    FRESH_IDS(vcu);
    const bf16* PROJ = (const bf16*)(ws + WS_PROJ);
    for (int it = gw; it < BATCH * NATT * SEQ; it += NGW) {
        const int k_ = it / SEQ; int i = it % SEQ; if (k_ & 1) i = SEQ - 1 - i;
        const int b = k_ / NATT, hidx = k_ % NATT;
        const AttnDesc d = attn_desc(hidx, ws);
        const size_t rowq = (size_t)b * SEQ + i;
        float q[128];
        { const GAS v4u* qp = (const GAS v4u*)(PROJ + rowq * PW + d.qcol);
#pragma unroll
          for (int c = 0; c < 16; ++c) { const v4u w = qp[c]; q[8 * c] = bflo(w.x); q[8 * c + 1] = bfhi(w.x); q[8 * c + 2] = bflo(w.y); q[8 * c + 3] = bfhi(w.y); q[8 * c + 4] = bflo(w.z); q[8 * c + 5] = bfhi(w.z); q[8 * c + 6] = bflo(w.w); q[8 * c + 7] = bfhi(w.w); } }
        unsigned selm = 0xffffffffu; const float* br = nullptr;
        if (d.type == 0) selm = ((const unsigned*)(ws + WS_SELM))[(size_t)(b * 12 + hidx) * SEQ + i];
        if (d.type == 1) br = (const float*)(ws + WS_BRAW) + (size_t)(b * 12 + (hidx - 12)) * SEQ;
        float mrun = -1e30f, lrun = 0.f, o0 = 0.f, o1 = 0.f;
        for (int c0 = 0; c0 <= i; c0 += 64) {
            if (!((selm >> (c0 >> 8)) & 1u)) continue;
            const int j = c0 + lane; const bool valid = j <= i;
            float s = -INFINITY;
            if (valid) { const GAS v4u* kp = (const GAS v4u*)(PROJ + ((size_t)b * SEQ + j) * PW + d.kcol); float a = 0.f;
#pragma unroll
                for (int c = 0; c < 16; ++c) { const v4u w = kp[c];
                    a += q[8 * c] * bflo(w.x) + q[8 * c + 1] * bfhi(w.x) + q[8 * c + 2] * bflo(w.y) + q[8 * c + 3] * bfhi(w.y) + q[8 * c + 4] * bflo(w.z) + q[8 * c + 5] * bfhi(w.z) + q[8 * c + 6] * bflo(w.w) + q[8 * c + 7] * bfhi(w.w); }
                if (br) a += br[j] - br[i];
                s = a * 0.08838834764831845f; }
            const float cm = wave_max(s, lane), mn = fmaxf(mrun, cm), al = __expf(mrun - mn);
            const float p = valid ? __expf(s - mn) : 0.f;
            lrun = lrun * al + wave_sum(p, lane); o0 *= al; o1 *= al; mrun = mn;
            const int nk = (i - c0 + 1) < 64 ? (i - c0 + 1) : 64;
            const bf16* vp = PROJ + ((size_t)b * SEQ + c0) * PW + d.vcol + 2 * lane;
            for (int jj = 0; jj < nk; ++jj) { const float pj = __int_as_float(__builtin_amdgcn_readlane(__float_as_int(p), jj)); const unsigned w = *(const unsigned*)(vp + (size_t)jj * PW); o0 += pj * bflo(w); o1 += pj * bfhi(w); }
        }
        const float rl = 1.0f / lrun;
        *(unsigned*)(d.obase + rowq * d.opitch + d.ocol + 2 * lane) = pk2(o0 * rl, o1 * rl);
    }
}
__device__ __forceinline__ void attn_phase(unsigned char* ws, char* lds, int vcu, int G, int wave0) {
    const int tid = fresh_tid(wave0);
    constexpr int total = BATCH * NATT * 8;
    int L = vcu; if (L >= total) return;
    int pass = 0;
    att::BlockRef cur{L >> 3, L & 7};
    att::Seam S;
    att::prime(cur, ws, lds, S, tid);
    for (;;) {
        const bool more_pass = pass == 0, more_item = L + G < total, last = !more_pass && !more_item;
        int passn = pass + 1, Ln = L;
        if (!more_pass) { passn = 0; Ln = more_item ? L + G : L; }
        const att::BlockRef nxt = last ? cur : att::BlockRef{Ln >> 3, passn ? 15 - (Ln & 7) : (Ln & 7)};
        att::block(cur, nxt, ws, lds, S, tid);
        if (last) break;
        cur = nxt; pass = passn; L = Ln;
    }
}
__device__ __forceinline__ void t5_phase(unsigned char* ws, int l, int vcu, int NGW, int wave0) {
    FRESH_IDS(vcu);
    KArgs ka = kargs(); const float* q1 = ka->in[10]; const float* k1 = ka->in[11]; const float* q2 = ka->in[12]; const float* k2 = ka->in[13];
    float s1 = q1[l * HD + lane] * k1[l * HD + lane] + q1[l * HD + 64 + lane] * k1[l * HD + 64 + lane];
    float s2 = q2[l * HD + lane] * k2[l * HD + lane] + q2[l * HD + 64 + lane] * k2[l * HD + 64 + lane];
    const float lam_init = 0.8f - 0.6f * expf(-0.3f * (float)l);
    const float lam = expf(wave_sum(s1, lane)) - expf(wave_sum(s2, lane)) + lam_init;
    const f32x4 gn = *(const f32x4*)(ka->in[14] + l * 256 + 4 * lane);
    const bf16* D0 = (const bf16*)(ws + WS_DIFF); const bf16* D1 = D0 + (size_t)M * 1024; bf16* MIX = (bf16*)(ws + WS_MIX);
    for (int it = gw; it < M * NH_D; it += NGW) {
        const int row = it >> 2, h = it & 3;
        const v2u a = *(const v2u*)(D0 + (size_t)row * 1024 + h * 256 + 4 * lane), b = *(const v2u*)(D1 + (size_t)row * 1024 + h * 256 + 4 * lane);
        const float v0 = bflo(a.x) - lam * bflo(b.x), v1 = bfhi(a.x) - lam * bfhi(b.x), v2 = bflo(a.y) - lam * bflo(b.y), v3 = bfhi(a.y) - lam * bfhi(b.y);
        const float ss = wave_sum((v0 * v0 + v1 * v1) + (v2 * v2 + v3 * v3), lane);
        const float sc = (1.0f / sqrtf(ss * (1.0f / 256.0f) + NORM_EPS)) * (1.0f - lam_init);
        v2u o; o.x = pk2(v0 * sc * gn.x, v1 * sc * gn.y); o.y = pk2(v2 * sc * gn.z, v3 * sc * gn.w);
        *(v2u*)(MIX + (size_t)row * DM + 3072 + h * 256 + 4 * lane) = o;
    }
}

__global__ void __launch_bounds__(NWAVES * 64, 2) mk_fwd(Args args_unused) {
    extern __shared__ __attribute__((aligned(16))) unsigned char lds_raw[];
    LAS unsigned char* lds = (LAS unsigned char*)lds_raw;
    volatile LAS unsigned* MISC = (volatile LAS unsigned*)(lds + MISC_OFF);
    const int wave0 = __builtin_amdgcn_readfirstlane((int)threadIdx.x >> 6);
    const int tid = fresh_tid(wave0);
    const int G = gridDim.x; const int bx = blockIdx.x; const int vcu = (G % 8 == 0) ? (bx % 8) * (G / 8) + bx / 8 : bx;
    const int NGW = G * NWAVES;
    for (int u = tid; u < (LDS_BYTES - LDSCTL_OFF) / 4; u += NWAVES * 64) ((LAS unsigned*)(lds + LDSCTL_OFF))[u] = 0u;
    __syncthreads();
    XcdBarrier bar; { unsigned char* ws0 = kargs()->ws; bar.bar = (unsigned*)(ws0 + WS_CTL) + CW_BAR; bar.x = 0; bar.st = nullptr;
        if (MK_N_LAUNCHES == 1) bar = xcd_barrier_post((unsigned*)(ws0 + WS_CTL) + CW_BAR, MISC + 8); }
#define GRID_BAR() do { if (MK_N_LAUNCHES == 1) xcd_barrier(bar); } while (0)
    const int lo = kargs()->ph_lo, hi = kargs()->ph_hi;
#define IN(k) (lo <= (k) && (k) < hi)
#define BOTH(k) (IN(k) && IN((k) + 1))
    if (IN(0)) { p0_prologue(kargs()->ws, lds, vcu, NGW, wave0); if (BOTH(0)) GRID_BAR(); }
    for (int l = 0; l < DEPTH; ++l) {
        const int pb = 1 + 10 * l;
        if (IN(pb + 0)) { KArgs ka = kargs(); unsigned char* ws = ka->ws; const float* xin = (l == 0) ? ka->in[0] : (const float*)(ws + WS_XB);
            rmsnorm_phase(xin, ka->in[1] + l * DM, (bf16*)(ws + WS_XN), vcu, NGW, wave0); if (BOTH(pb + 0)) GRID_BAR(); }
        if (IN(pb + 1)) { unsigned char* ws = kargs()->ws;
            pg8::Gemm g{(const bf16*)(ws + WS_XN), (const bf16*)(ws + WS_WIN) + (size_t)l * PW * DM, M, PW, DM}; pg8::StaticOrder S; S.init(M, PW, G, bx);
            pg8::EpiStoreBf16 E{(bf16*)(ws + WS_PROJ), PW};
            pg8::gemm_phase<pg8::EpiStoreBf16, pg8::StaticOrder, true, true>(lds + RING_OFF, g, S, E, fresh_tid(wave0));
            if (BOTH(pb + 1)) GRID_BAR(); }
        if (IN(pb + 2)) { t3_phase(kargs()->ws, l, vcu, NGW, wave0); if (BOTH(pb + 2)) GRID_BAR(); }
        if (IN(pb + 3)) { t4_phase(kargs()->ws, lds, vcu, G, wave0); if (BOTH(pb + 3)) GRID_BAR(); }
        if (IN(pb + 4)) {
#if defined(MK_NAIVE_ATTN)
            attn_naive_phase(kargs()->ws, vcu, NGW, wave0);
#else
            attn_phase(kargs()->ws, (char*)lds_raw + RING_OFF, vcu, G, wave0);
#endif
            if (BOTH(pb + 4)) GRID_BAR(); }
        if (IN(pb + 5)) { t5_phase(kargs()->ws, l, vcu, NGW, wave0); if (BOTH(pb + 5)) GRID_BAR(); }
        if (IN(pb + 6)) { KArgs ka = kargs(); unsigned char* ws = ka->ws; const float* xin = (l == 0) ? ka->in[0] : (const float*)(ws + WS_XB);
            pg8::Gemm g{(const bf16*)(ws + WS_MIX), (const bf16*)(ws + WS_WOUT) + (size_t)l * DM * DM, M, DM, DM}; pg8::StaticOrder S; S.init(M, DM, G, bx);
            pg8::EpiResid E{xin, ka->out, DM};
            pg8::gemm_phase<pg8::EpiResid, pg8::StaticOrder, true, true>(lds + RING_OFF, g, S, E, fresh_tid(wave0));
            if (BOTH(pb + 6)) GRID_BAR(); }
        if (IN(pb + 7)) { KArgs ka = kargs(); unsigned char* ws = ka->ws;
            rmsnorm_phase(ka->out, ka->in[16] + l * DM, (bf16*)(ws + WS_XN), vcu, NGW, wave0); if (BOTH(pb + 7)) GRID_BAR(); }
        if (IN(pb + 8)) { unsigned char* ws = kargs()->ws;
            pg8::Gemm g{(const bf16*)(ws + WS_XN), (const bf16*)(ws + WS_WGU) + (size_t)l * NGU * DM, M, NGU, DM}; pg8::StaticOrder S; S.init(M, NGU, G, bx);
            pg8::EpiSwiGLU E{(bf16*)(ws + WS_HB), FF};
            pg8::gemm_phase<pg8::EpiSwiGLU, pg8::StaticOrder, true, true>(lds + RING_OFF, g, S, E, fresh_tid(wave0));
            if (BOTH(pb + 8)) GRID_BAR(); }
        if (IN(pb + 9)) { KArgs ka = kargs(); unsigned char* ws = ka->ws; float* x2 = (l == DEPTH - 1) ? ka->out : (float*)(ws + WS_XB);
            pg8::Gemm g{(const bf16*)(ws + WS_HB), (const bf16*)(ws + WS_WD) + (size_t)l * DM * FF, M, DM, FF}; pg8::StaticOrder S; S.init(M, DM, G, bx);
            pg8::EpiResid E{ka->out, x2, DM};
            pg8::gemm_phase<pg8::EpiResid, pg8::StaticOrder, true, true>(lds + RING_OFF, g, S, E, fresh_tid(wave0));
            if (BOTH(pb + 9)) GRID_BAR(); }
    }
#undef IN
#undef BOTH
}

extern "C" void kernel_launch(void* const* d_in, const int* in_sizes, int n_in, void* d_out, int out_size, void* d_ws, size_t ws_size, hipStream_t stream) {
    static int grid = 0;
    if (grid == 0) {
        if (n_in != 20 || in_sizes[0] != M * DM || out_size != M * DM || ws_size < WS_END) { fprintf(stderr, "kernel_launch: unexpected shapes (n_in %d, in0 %d, out %d, ws %zu < %zu); nothing launched\n", n_in, n_in > 0 ? in_sizes[0] : -1, out_size, ws_size, (size_t)WS_END); grid = -1; return; }
        int dev = 0, cus = 0, per_cu = 0;
        if (hipGetDevice(&dev) != hipSuccess || hipDeviceGetAttribute(&cus, hipDeviceAttributeMultiprocessorCount, dev) != hipSuccess) { grid = -1; return; }
        if (hipFuncSetAttribute((const void*)mk_fwd, hipFuncAttributeMaxDynamicSharedMemorySize, LDS_BYTES) != hipSuccess) { fprintf(stderr, "kernel_launch: hipFuncSetAttribute failed\n"); grid = -1; return; }
        if (hipOccupancyMaxActiveBlocksPerMultiprocessor(&per_cu, (const void*)mk_fwd, NWAVES * 64, LDS_BYTES) != hipSuccess || per_cu < 1) fprintf(stderr, "kernel_launch: occupancy query says %d\n", per_cu);
        (void)hipGetLastError();
        grid = cus;
    }
    if (grid < 0) return;
    if (hipMemsetAsync((char*)d_ws + WS_CTL, 0, CTL_ZERO_BYTES, stream) != hipSuccess) return;
    Args a{};
    for (int i = 0; i < 20; ++i) a.in[i] = (const float*)d_in[i];
    a.out = (float*)d_out; a.ws = (unsigned char*)d_ws;
    if (MK_N_LAUNCHES == 1) { a.ph_lo = 0; a.ph_hi = NPH; hipLaunchKernelGGL(mk_fwd, dim3(grid), dim3(NWAVES * 64), LDS_BYTES, stream, a); }
    else for (int p = 0; p < NPH; ++p) { a.ph_lo = p; a.ph_hi = p + 1; hipLaunchKernelGGL(mk_fwd, dim3(grid), dim3(NWAVES * 64), LDS_BYTES, stream, a); }
}
```

```cpp
#include <hip/hip_runtime.h>
#include <cstdio>
#include <cstdint>
#include <cmath>
namespace pg8 {
#define PG8_LAS __attribute__((address_space(3)))
typedef unsigned short bf16_t;
typedef short bf16x8 __attribute__((ext_vector_type(8)));
typedef float f32x4 __attribute__((ext_vector_type(4)));
typedef unsigned u32x4 __attribute__((ext_vector_type(4)));
constexpr int BM = 256, BK = 64, HALF = 128, HTB = HALF * BK * 2  , STAGE_BYTES = 8 * HTB, NXCD = 8, WGM = 8;

__host__ __device__ __forceinline__ int lds_byte(int r, int c) { const int st = (r >> 4) * 2 + (c >> 5), rr = r & 15, cc = c & 31, ob = rr * 64 + cc * 2; return st * 1024 + (ob ^ (((ob >> 9) & 1) << 5)); }
__host__ __device__ __forceinline__ void stage_rc(int b, int& R, int& C) { const int st = b / 1024, sb = b % 1024, swz = sb ^ (((sb >> 9) & 1) << 5); R = (st >> 1) * 16 + swz / 64; C = (st & 1) * 32 + (swz % 64) / 2; }
__host__ __device__ __forceinline__ int perm32(int rho) { const int n = rho >> 4, i = rho & 15; return 8 * (i >> 2) + 4 * n + (i & 3); }

struct Unit { int pm, pn; };
struct Gemm { const bf16_t* A; const bf16_t* Bt; int M, N, K; };

struct StaticOrder {
    int nM, nN, nwg, G, c, wgm;
    __host__ __device__ void init(int M, int N, int G_, int c_, int wgm_ = WGM) { nM = M / BM; nN = N / BM; nwg = nM * nN; G = G_; c = c_; wgm = wgm_; }
    __host__ __device__ bool next(int i, Unit& u) const {
        const long L = (long)i * G + c; if (L >= nwg) return false;
        int wgid = (int)L; { const int q = nwg / NXCD, r = nwg % NXCD, xcd = wgid % NXCD, off = wgid / NXCD; wgid = (xcd < r ? xcd * (q + 1) : r * (q + 1) + (xcd - r) * q) + off; }
        const int nig = wgm * nN, gid = wgid / nig, fm = gid * wgm, gsz = (nM - fm) < wgm ? (nM - fm) : wgm;
        u.pm = fm + ((wgid % nig) % gsz); u.pn = (wgid % nig) / gsz; return true;
    }
    __device__ __forceinline__ void a_ready(const Unit&) const {}
    __device__ __forceinline__ void done(const Unit&) const {}
};

__device__ __forceinline__ unsigned cvt_pk_bf16(float lo, float hi) { unsigned r; asm volatile("v_cvt_pk_bf16_f32 %0, %1, %2" : "=v"(r) : "v"(lo), "v"(hi)); return r; }
__device__ __forceinline__ float rs_of(const float* ssq, int row, float inv_k, float eps) { return 1.0f / sqrtf(ssq[row] * inv_k + eps); }
struct EpiStoreBf16 {
    static constexpr bool PERM = true, AFTER_DRAIN = false;
    bf16_t* O; int ldc; const float* ssq; float inv_k, eps;
    __device__ __forceinline__ void operator()(const f32x4 (&acc)[2][2][4][2], const Unit& u, int wr, int wc, int fr, int fq) const {
        const int row0 = u.pm * BM + wr * 64 + fr, col0 = u.pn * BM + wc * 32 + 8 * fq;
#pragma unroll
        for (int ai = 0; ai < 2; ++ai)
#pragma unroll
            for (int m = 0; m < 4; ++m) { const int row = row0 + ai * HALF + m * 16; bf16_t* rowp = O + (size_t)row * ldc + col0; const float r = rs_of(ssq, row, inv_k, eps);
#pragma unroll
                for (int bj = 0; bj < 2; ++bj) { const f32x4 v0 = acc[ai][bj][m][0] * r, v1 = acc[ai][bj][m][1] * r;
                    u32x4 w; w.x = cvt_pk_bf16(v0[0], v0[1]); w.y = cvt_pk_bf16(v0[2], v0[3]); w.z = cvt_pk_bf16(v1[0], v1[1]); w.w = cvt_pk_bf16(v1[2], v1[3]);
                    *(u32x4*)(rowp + bj * HALF) = w; } }
    }
};
__device__ __forceinline__ float silu_mul(float g, float u) { const float e = __builtin_amdgcn_exp2f(-g * 1.4426950408889634f); return g * __builtin_amdgcn_rcpf(1.0f + e) * u; }
struct EpiSwiGLU {
    static constexpr bool PERM = true, AFTER_DRAIN = false;
    bf16_t* O; int ldc; const float* ssq; float inv_k, eps; int tiledM;
    __device__ __forceinline__ void operator()(const f32x4 (&acc)[2][2][4][2], const Unit& u, int wr, int wc, int fr, int fq) const {
        const int row0 = u.pm * BM + wr * 64 + fr, col0 = u.pn * HALF + wc * 32 + 8 * fq;
#pragma unroll
        for (int ai = 0; ai < 2; ++ai)
#pragma unroll
            for (int m = 0; m < 4; ++m) { const int row = row0 + ai * HALF + m * 16; const float r = rs_of(ssq, row, inv_k, eps);
                bf16_t* rowp = tiledM ? O + ((size_t)(col0 >> 6) * tiledM + row) * 64 + (col0 & 63) : O + (size_t)row * ldc + col0;
                const f32x4 g0 = acc[ai][0][m][0] * r, g1 = acc[ai][0][m][1] * r, u0 = acc[ai][1][m][0] * r, u1 = acc[ai][1][m][1] * r;
                u32x4 w; w.x = cvt_pk_bf16(silu_mul(g0[0], u0[0]), silu_mul(g0[1], u0[1])); w.y = cvt_pk_bf16(silu_mul(g0[2], u0[2]), silu_mul(g0[3], u0[3]));
                w.z = cvt_pk_bf16(silu_mul(g1[0], u1[0]), silu_mul(g1[1], u1[1])); w.w = cvt_pk_bf16(silu_mul(g1[2], u1[2]), silu_mul(g1[3], u1[3]));
                *(u32x4*)rowp = w; }
    }
};
struct EpiResid {
    static constexpr bool PERM = false, AFTER_DRAIN = false;
    const float* base; float* out; int ldc; bf16_t* xb; float* ssq; float* ssp; unsigned* pcnt; PG8_LAS float* xl; int ntn; int xbM;
    __device__ __forceinline__ void operator()(const f32x4 (&acc)[2][2][4][2], const Unit& u, int wr, int wc, int fr, int fq) const {
        const int row0 = u.pm * BM + wr * 64 + fr, col0 = u.pn * BM + wc * 32 + 4 * fq; const int lane = fr + 16 * fq, tid = (wr * 4 + wc) * 64 + lane;
        typedef unsigned u32x2 __attribute__((ext_vector_type(2)));
#pragma unroll
        for (int ai = 0; ai < 2; ++ai)
#pragma unroll
            for (int m = 0; m < 4; ++m) { const int row = row0 + ai * HALF + m * 16; const size_t off = (size_t)row * ldc + col0; float ss = 0.f;
#pragma unroll
                for (int bj = 0; bj < 2; ++bj)
#pragma unroll
                    for (int n = 0; n < 2; ++n) { const f32x4 b = *(const f32x4*)(base + off + bj * HALF + n * 16); const f32x4 o = b + acc[ai][bj][m][n]; *(f32x4*)(out + off + bj * HALF + n * 16) = o;
                        if (xb) { u32x2 w; w.x = cvt_pk_bf16(o[0], o[1]); w.y = cvt_pk_bf16(o[2], o[3]); const int col = col0 + bj * HALF + n * 16; *(u32x2*)(xb + ((size_t)(col >> 6) * xbM + row) * 64 + (col & 63)) = w; }
                        ss += (o[0] * o[0] + o[1] * o[1]) + (o[2] * o[2] + o[3] * o[3]); }
                if (xb) { ss += __int_as_float(__builtin_amdgcn_ds_bpermute((lane ^ 16) << 2, __float_as_int(ss))); ss += __int_as_float(__builtin_amdgcn_ds_bpermute((lane ^ 32) << 2, __float_as_int(ss)));
                    if (fq == 0) xl[(ai * HALF + wr * 64 + m * 16 + fr) * 4 + wc] = ss; } }
        if (xb) {
            asm volatile("s_waitcnt lgkmcnt(0)" ::: "memory"); __builtin_amdgcn_s_barrier(); asm volatile("" ::: "memory");
            if (tid < BM) { const f32x4 p4 = *(const PG8_LAS f32x4*)(xl + tid * 4); const float t = (p4[0] + p4[1]) + (p4[2] + p4[3]);
                __hip_atomic_store(ssp + (size_t)(u.pm * BM + tid) * 16 + u.pn, t, __ATOMIC_RELAXED, __HIP_MEMORY_SCOPE_AGENT); }
            asm volatile("s_waitcnt vmcnt(0)" ::: "memory");
            __builtin_amdgcn_s_barrier(); asm volatile("" ::: "memory");
            if (tid == 0) { const unsigned old = __hip_atomic_fetch_add(pcnt + 64 * u.pm, 1u, __ATOMIC_RELAXED, __HIP_MEMORY_SCOPE_AGENT); ((PG8_LAS unsigned*)xl)[1024] = (old == (unsigned)(ntn - 1)) ? 1u : 0u; }
            asm volatile("s_waitcnt vmcnt(0) lgkmcnt(0)" ::: "memory"); __builtin_amdgcn_s_barrier(); asm volatile("" ::: "memory");
            if (((volatile PG8_LAS unsigned*)xl)[1024] != 0u && tid < BM) {
                __builtin_amdgcn_fence(__ATOMIC_ACQUIRE, "agent");
                const float* pp = ssp + (size_t)(u.pm * BM + tid) * 16; float t = 0.f;
                for (int j = 0; j < ntn; ++j) t += __hip_atomic_load(pp + j, __ATOMIC_RELAXED, __HIP_MEMORY_SCOPE_AGENT);
                ssq[u.pm * BM + tid] = t; }
        }
    }
};

template <class Epi, class Sched, bool ALIGN_EPI = false, bool SP2 = false, bool TILED = false>
__device__ __forceinline__ void gemm_phase(PG8_LAS unsigned char* lds, const Gemm g, const Sched& S, const Epi& E, int tid_) {
    asm volatile("" : "+v"(tid_));
    const int tid = tid_, wid = __builtin_amdgcn_readfirstlane(tid >> 6), lane = tid & 63, wr = wid >> 2, wc = wid & 3, fr = lane & 15, fq = lane >> 4;
    const int K = g.K, nt = K / BK; const int RP = TILED ? BK : K;
    unsigned voffA[2], voffB[2];
#pragma unroll
    for (int i = 0; i < 2; ++i) { int R, C; stage_rc(tid * 16 + i * 8192, R, C); const int Rb = Epi::PERM ? ((R & ~31) + perm32(R & 31)) : R;
        voffA[i] = (unsigned)(R * RP + C) * 2u; voffB[i] = (unsigned)(Rb * RP + C) * 2u; }
    const size_t kstepA = TILED ? (size_t)g.M * BK * 2 : (size_t)(BK * 2), kstepB = TILED ? (size_t)g.N * BK * 2 : (size_t)(BK * 2);
    const size_t hstep = (size_t)HALF * RP * 2;
    const size_t tstep = 2 * hstep;
    const unsigned ldsw = (unsigned)wid * 1024u;
    const int aoff = lds_byte(wr * 64 + fr, fq * 8), boff = lds_byte(wc * 32 + fr, fq * 8);
#define PG8_SA(b, h) (((b) * 2 + (h)) * HTB)
#define PG8_SB(b, h) ((4 + (b) * 2 + (h)) * HTB)
#define PG8_STAGE(bufoff, gbase, voff) do { _Pragma("unroll") for (int _i = 0; _i < 2; ++_i) \
        __builtin_amdgcn_global_load_lds((const unsigned*)((const char*)(gbase) + (voff)[_i]), (PG8_LAS unsigned*)(lds + (bufoff) + ldsw + _i * 8192), 16, 0, 0); } while (0)
#define PG8_LDA(dst, b, h) do { _Pragma("unroll") for (int m = 0; m < 4; ++m) _Pragma("unroll") for (int k = 0; k < 2; ++k) dst[m][k] = *(const PG8_LAS bf16x8*)(lds + PG8_SA(b, h) + aoff + m * 2048 + k * 1024); } while (0)
#define PG8_LDB(dst, b, h) do { _Pragma("unroll") for (int n = 0; n < 2; ++n) _Pragma("unroll") for (int k = 0; k < 2; ++k) dst[n][k] = *(const PG8_LAS bf16x8*)(lds + PG8_SB(b, h) + boff + n * 2048 + k * 1024); } while (0)
#define PG8_MMA(ai, bj, At, Bt) do { __builtin_amdgcn_s_setprio(1); _Pragma("unroll") for (int m = 0; m < 4; ++m) _Pragma("unroll") for (int n = 0; n < 2; ++n) _Pragma("unroll") for (int k = 0; k < 2; ++k) \
        acc[ai][bj][m][n] = __builtin_amdgcn_mfma_f32_16x16x32_bf16(Bt[n][k], At[m][k], acc[ai][bj][m][n], 0, 0, 0); __builtin_amdgcn_s_setprio(0); } while (0)
#define PG8_WAIT_V(n) asm volatile("s_waitcnt vmcnt(" #n ")" ::: "memory")
#define PG8_WAIT_L(n) asm volatile("s_waitcnt lgkmcnt(" #n ")" ::: "memory")
#define PG8_BAR __builtin_amdgcn_s_barrier()
#define PG8_SCHED __builtin_amdgcn_sched_barrier(0)
    Unit cur, nxt; int ui = 0;
    if (!S.next(0, cur)) return;
    f32x4 acc[2][2][4][2];
#pragma unroll
    for (int a = 0; a < 2; ++a)
#pragma unroll
        for (int b = 0; b < 2; ++b)
#pragma unroll
            for (int m = 0; m < 4; ++m)
#pragma unroll
                for (int n = 0; n < 2; ++n) acc[a][b][m][n] = (f32x4){0.f, 0.f, 0.f, 0.f};
    bf16x8 At[4][2], B0[2][2], B1[2][2];
    const char* cA = (const char*)g.A + (size_t)cur.pm * tstep; const char* cB = (const char*)g.Bt + (size_t)cur.pn * tstep;
    S.a_ready(cur);
    if constexpr (SP2) {
        PG8_STAGE(PG8_SB(0, 0), cB, voffB); PG8_STAGE(PG8_SB(0, 1), cB + hstep, voffB); PG8_STAGE(PG8_SA(0, 0), cA, voffA); PG8_STAGE(PG8_SA(0, 1), cA + hstep, voffA);
        if (wr == 1) PG8_BAR;
        PG8_WAIT_V(2); PG8_BAR;
        PG8_STAGE(PG8_SB(1, 0), cB + kstepB, voffB); PG8_STAGE(PG8_SA(1, 0), cA + kstepA, voffA); PG8_STAGE(PG8_SB(1, 1), cB + hstep + kstepB, voffB);
        PG8_WAIT_V(6); PG8_BAR;
    } else {
        PG8_STAGE(PG8_SB(0, 0), cB, voffB); PG8_STAGE(PG8_SA(0, 0), cA, voffA); PG8_STAGE(PG8_SB(0, 1), cB + hstep, voffB); PG8_STAGE(PG8_SA(0, 1), cA + hstep, voffA);
        if (wr == 1) PG8_BAR;
        PG8_WAIT_V(4); PG8_BAR;
        PG8_STAGE(PG8_SB(1, 0), cB + kstepB, voffB); PG8_STAGE(PG8_SA(1, 0), cA + kstepA, voffA); PG8_STAGE(PG8_SB(1, 1), cB + hstep + kstepB, voffB);
        PG8_WAIT_V(6); PG8_BAR;
    }
    for (;;) {
        const bool has_next = S.next(ui + 1, nxt);
        const char* nA = has_next ? (const char*)g.A + (size_t)nxt.pm * tstep : cA; const char* nB = has_next ? (const char*)g.Bt + (size_t)nxt.pn * tstep : cB;
        for (int t = 0; t < nt; t += 2) {
            const bool last = (t == nt - 2);
            const char* a1 = cA + (size_t)(t + 1) * kstepA;
            const char* a2 = last ? nA : cA + (size_t)(t + 2) * kstepA; const char* b2 = last ? nB : cB + (size_t)(t + 2) * kstepB;
            const char* a3 = a2 + kstepA; const char* b3 = b2 + kstepB;
            if (last && has_next) S.a_ready(nxt);
            if constexpr (SP2) {
            PG8_LDB(B0, 0, 0); PG8_LDB(B1, 0, 1); PG8_SCHED; PG8_LDA(At, 0, 0); PG8_STAGE(PG8_SA(1, 1), a1 + hstep, voffA);
            PG8_WAIT_V(8); PG8_WAIT_L(0); PG8_BAR; PG8_MMA(0, 0, At, B0); PG8_MMA(0, 1, At, B1); PG8_BAR; PG8_SCHED;
            PG8_LDA(At, 0, 1); PG8_STAGE(PG8_SB(0, 0), b2, voffB); PG8_STAGE(PG8_SB(0, 1), b2 + hstep, voffB); PG8_STAGE(PG8_SA(0, 0), a2, voffA);
            PG8_WAIT_V(8); PG8_WAIT_L(0); PG8_BAR; PG8_MMA(1, 0, At, B0); PG8_MMA(1, 1, At, B1); PG8_BAR; PG8_SCHED;
            PG8_LDB(B0, 1, 0); PG8_LDB(B1, 1, 1); PG8_SCHED; PG8_LDA(At, 1, 0); PG8_STAGE(PG8_SA(0, 1), a2 + hstep, voffA);
            PG8_WAIT_V(8); PG8_WAIT_L(0); PG8_BAR; PG8_MMA(0, 0, At, B0); PG8_MMA(0, 1, At, B1); PG8_BAR; PG8_SCHED;
            PG8_LDA(At, 1, 1); PG8_STAGE(PG8_SB(1, 0), b3, voffB); PG8_STAGE(PG8_SB(1, 1), b3 + hstep, voffB); PG8_STAGE(PG8_SA(1, 0), a3, voffA);
            PG8_WAIT_V(8); PG8_WAIT_L(0); PG8_BAR; PG8_MMA(1, 0, At, B0); PG8_MMA(1, 1, At, B1); PG8_BAR; PG8_SCHED;
            } else {
            PG8_LDB(B0, 0, 0); PG8_SCHED; PG8_LDA(At, 0, 0); PG8_STAGE(PG8_SA(1, 1), a1 + hstep, voffA);
            PG8_WAIT_L(8); PG8_BAR; PG8_WAIT_L(0); PG8_MMA(0, 0, At, B0); PG8_BAR; PG8_SCHED;
            PG8_LDB(B1, 0, 1); PG8_STAGE(PG8_SB(0, 0), b2, voffB);
            PG8_BAR; PG8_WAIT_L(0); PG8_MMA(0, 1, At, B1); PG8_BAR;
            PG8_LDA(At, 0, 1); PG8_STAGE(PG8_SA(0, 0), a2, voffA);
            PG8_BAR; PG8_WAIT_L(0); PG8_MMA(1, 0, At, B0); PG8_BAR; PG8_SCHED;
            PG8_STAGE(PG8_SB(0, 1), b2 + hstep, voffB);
            PG8_WAIT_V(6); PG8_BAR; PG8_MMA(1, 1, At, B1); PG8_BAR;
            PG8_LDB(B0, 1, 0); PG8_SCHED; PG8_LDA(At, 1, 0); PG8_STAGE(PG8_SA(0, 1), a2 + hstep, voffA);
            PG8_WAIT_L(8); PG8_BAR; PG8_WAIT_L(0); PG8_MMA(0, 0, At, B0); PG8_BAR; PG8_SCHED;
            PG8_LDB(B1, 1, 1); PG8_STAGE(PG8_SB(1, 0), b3, voffB);
            PG8_BAR; PG8_WAIT_L(0); PG8_MMA(0, 1, At, B1); PG8_BAR;
            PG8_LDA(At, 1, 1); PG8_STAGE(PG8_SA(1, 0), a3, voffA);
            PG8_BAR; PG8_WAIT_L(0); PG8_MMA(1, 0, At, B0); PG8_BAR; PG8_SCHED;
            PG8_STAGE(PG8_SB(1, 1), b3 + hstep, voffB);
            PG8_WAIT_V(6); PG8_BAR; PG8_MMA(1, 1, At, B1); PG8_BAR;
            }
        }
        if constexpr (ALIGN_EPI) { if (wr == 0) PG8_BAR; }
        if constexpr (!Epi::AFTER_DRAIN) { E(acc, cur, wr, wc, fr, fq); S.done(cur); }
        if (!has_next) break;
#pragma unroll
        for (int a = 0; a < 2; ++a)
#pragma unroll
            for (int b = 0; b < 2; ++b)
#pragma unroll
                for (int m = 0; m < 4; ++m)
#pragma unroll
                    for (int n = 0; n < 2; ++n) acc[a][b][m][n] = (f32x4){0.f, 0.f, 0.f, 0.f};
        cur = nxt; cA = nA; cB = nB; ++ui;
        if constexpr (ALIGN_EPI) { if (wr == 1) PG8_BAR; }
    }
    PG8_WAIT_V(0);
    if constexpr (!ALIGN_EPI) { if (wr == 0) PG8_BAR; }
    PG8_BAR;
    if constexpr (Epi::AFTER_DRAIN) { E.fused(acc, cur, wr, wc, fr, fq, lds, wid, lane); S.done(cur); }
#undef PG8_SA
#undef PG8_SB
#undef PG8_STAGE
#undef PG8_LDA
#undef PG8_LDB
#undef PG8_MMA
#undef PG8_WAIT_V
#undef PG8_WAIT_L
#undef PG8_BAR
#undef PG8_SCHED
}
}
#ifndef MK_N_LAUNCHES
#define MK_N_LAUNCHES 1
#endif
constexpr int NWAVES = 8;
#ifndef MK_REP_PHASE
#define MK_REP_PHASE -1
#endif
#define REPS(k) (((k) == MK_REP_PHASE) ? 2 : 1)
#ifndef MK_TIME_PHASE
#define MK_TIME_PHASE -1
#endif
constexpr int BATCH = 2, SEQ = 4096, DM = 4096, M = BATCH * SEQ, DEPTH = 2;
constexpr int HD = 128, NH_M = 12, NH_F = 12, NH_D = 4;
constexpr int INW = 12300;
constexpr int PW = 12288;
constexpr int FF = 11008, NGU = 2 * FF;
constexpr int C_QM = 0, C_KM = 1536, C_VM = 3072, C_QF = 4608, C_KF = 6144, C_VF = 7680, C_QD = 9216, C_KD = 10240, C_VD = 11264;
constexpr int NBLK = SEQ / 256;
constexpr int T3A_ROWS = 16, KSUB = 256 / T3A_ROWS;
constexpr float NORM_EPS = 1e-6f;
constexpr int NATT = 40;
constexpr int NPH = 1 + 8 * DEPTH;
constexpr size_t MiB = 1u << 20;
constexpr size_t WS_CTL = 0, CTL_ZERO_BYTES = 1 * MiB;
constexpr size_t WS_ROPE = 1 * MiB;
constexpr size_t WS_WF = 3 * MiB;
constexpr size_t WS_LOGF = 4 * MiB;
constexpr size_t WS_BRAW = 5 * MiB;
constexpr size_t WS_SELM = 6 * MiB;
constexpr size_t WS_SSP = 9 * MiB;
constexpr size_t WS_KPART = 10 * MiB + 512 * 1024;
constexpr size_t WS_WIN = 16 * MiB;
constexpr size_t WS_WOUT = 208 * MiB;
constexpr size_t WS_WGU = 272 * MiB;
constexpr size_t WS_WD = 616 * MiB;
constexpr size_t WS_XN = 788 * MiB;
constexpr size_t WS_PROJ = 852 * MiB;
constexpr size_t WS_HB = 852 * MiB;
constexpr size_t WS_MIX = 1044 * MiB;
constexpr size_t WS_DIFF = 1108 * MiB;
constexpr size_t WS_XB = 1140 * MiB;
constexpr size_t WS_END = 1268 * MiB;
static_assert(WS_WIN + (size_t)DEPTH * PW * DM * 2 <= WS_WOUT && WS_WOUT + (size_t)DEPTH * DM * DM * 2 <= WS_WGU && WS_WGU + (size_t)DEPTH * NGU * DM * 2 <= WS_WD && WS_WD + (size_t)DEPTH * DM * FF * 2 <= WS_XN, "ws map (weights)");
static_assert(WS_XN + (size_t)M * DM * 2 <= WS_PROJ && WS_PROJ + (size_t)M * PW * 2 <= WS_MIX && WS_HB + (size_t)M * FF * 2 <= WS_MIX && WS_MIX + (size_t)M * DM * 2 <= WS_DIFF && WS_DIFF + (size_t)2 * M * 1024 * 2 <= WS_XB && WS_XB + (size_t)M * DM * 4 <= WS_END, "ws map (activations)");
constexpr int CW_TMO = 0, CW_CODE = 1, CW_BAR = 4096;
constexpr int CW_SSQ = 16384;
constexpr int CW_PCNT = 65536;
constexpr int CW_CONV = 98304;
constexpr int CW_ATTQ = 8192;
constexpr int RING_OFF = 0, RING_BYTES = 131072;
constexpr int LDSCTL_OFF = RING_BYTES, MISC_OFF = LDSCTL_OFF + 320;
constexpr int XL_OFF = RING_BYTES + 4096;
constexpr int LDS_BYTES = 147456;

#define GAS __attribute__((address_space(1)))
#define LAS __attribute__((address_space(3)))
typedef unsigned short bf16;
typedef unsigned v4u __attribute__((ext_vector_type(4)));
typedef unsigned v2u __attribute__((ext_vector_type(2)));
typedef float f32x4 __attribute__((ext_vector_type(4)));
typedef float f32x2 __attribute__((ext_vector_type(2)));
typedef short bf16x8 __attribute__((ext_vector_type(8)));
typedef GAS unsigned gu32;
#define RLX_AGENT __ATOMIC_RELAXED, __HIP_MEMORY_SCOPE_AGENT
#define LDS_WAIT() asm volatile("s_waitcnt lgkmcnt(0)" ::: "memory")
#define VM_WAIT() asm volatile("s_waitcnt vmcnt(0)" ::: "memory")
__device__ __forceinline__ unsigned f2bf(float f) { unsigned u = __builtin_bit_cast(unsigned, f); return (u + 0x7fffu + ((u >> 16) & 1u)) >> 16; }
__device__ __forceinline__ unsigned pk2(float lo, float hi) { return f2bf(lo) | (f2bf(hi) << 16); }
__device__ __forceinline__ float bflo(unsigned w) { return __uint_as_float(w << 16); }
__device__ __forceinline__ float bfhi(unsigned w) { return __uint_as_float(w & 0xffff0000u); }
__device__ __forceinline__ float bf2f(bf16 b) { return __uint_as_float((unsigned)b << 16); }
__device__ __forceinline__ float shx(float v, int o, int lane) { return __int_as_float(__builtin_amdgcn_ds_bpermute((lane ^ o) << 2, __float_as_int(v))); }
__device__ __forceinline__ float wave_sum(float v, int lane) {
#pragma unroll
    for (int o = 1; o < 64; o <<= 1) v += shx(v, o, lane);
    return v;
}
__device__ __forceinline__ float wave_max(float v, int lane) {
#pragma unroll
    for (int o = 1; o < 64; o <<= 1) v = fmaxf(v, shx(v, o, lane));
    return v;
}
__device__ __forceinline__ float dpp_xor1(float v) { return __int_as_float(__builtin_amdgcn_mov_dpp(__float_as_int(v), 0xB1, 0xf, 0xf, true)); }
__device__ __forceinline__ int fresh_tid(int wave0) { int lane; asm volatile("v_mbcnt_lo_u32_b32 %0, -1, 0\n\tv_mbcnt_hi_u32_b32 %0, -1, %0" : "=v"(lane)); return wave0 * 64 + lane; }
#define FRESH_IDS(vcu_) const int tid = fresh_tid(wave0); const int lane = tid & 63, wave = wave0; const int gw = (vcu_) * NWAVES + wave; (void)gw; (void)lane; (void)wave; (void)tid

#define XB_TMO      128
#define XB_XCNT(j)  (256  + 64 * (j))
#define XB_XSUB(j)  (1280 + 64 * (j))
#define XB_XGEN(j)  (2304 + 64 * (j))
#define XB_TOP      3328
#define XB_TOPGEN   3392
#define XCD_BAR_WORDS 3456
#define XB_SPIN_CAP (1u << 18)

__device__ __forceinline__ unsigned xb_ld(unsigned* p)              { return __hip_atomic_load(p, __ATOMIC_RELAXED, __HIP_MEMORY_SCOPE_AGENT); }
__device__ __forceinline__ unsigned xb_add(unsigned* p, unsigned v) { return __hip_atomic_fetch_add(p, v, __ATOMIC_RELAXED, __HIP_MEMORY_SCOPE_AGENT); }
__device__ __forceinline__ unsigned xb_xcc_id() { return (unsigned)__builtin_amdgcn_s_getreg((3 << 11) | 20) & 0xFu; }
#define XB_SPIN(cond, bar) do { unsigned _sp = 0; while (cond) { __builtin_amdgcn_s_sleep(1); \
    if ((++_sp & 255u) == 0u) { if (xb_ld(&(bar)[XB_TMO])) break; if (_sp > XB_SPIN_CAP) { atomicAdd(&(bar)[XB_TMO], 1u); break; } } } } while (0)

struct XcdBarrier {
    unsigned* bar; unsigned x;
    volatile LAS unsigned* st;
};

__device__ __forceinline__ XcdBarrier xcd_barrier_post(unsigned* bar, volatile LAS unsigned* st) {
    XcdBarrier b; b.bar = bar; b.x = xb_xcc_id(); b.st = st;
    if (threadIdx.x == 0) (void)xb_add(&bar[XB_XCNT(b.x)], 1u);
    return b;
}
__device__ __forceinline__ void xcd_barrier_complete(unsigned* bar, unsigned x, unsigned& nloc, unsigned& nx) {
    const unsigned G = gridDim.x * gridDim.y * gridDim.z;
    unsigned sum, cnt, mine, sp = 0u;
    for (;;) {
        sum = 0u; cnt = 0u; mine = 0u;
#pragma unroll
        for (unsigned j = 0; j < 16; ++j) { const unsigned c = xb_ld(&bar[XB_XCNT(j)]); sum += c; cnt += (c > 0u) ? 1u : 0u; mine = (j == x) ? c : mine; }
        if (sum == G) break;
        __builtin_amdgcn_s_sleep(1);
        if ((++sp & 255u) == 0u) { if (xb_ld(&bar[XB_TMO])) break; if (sp > XB_SPIN_CAP) { atomicAdd(&bar[XB_TMO], 1u); break; } }
    }
    nloc = mine > 0u ? mine : 1u; nx = cnt > 0u ? cnt : 1u;
}

__device__ __forceinline__ void xcd_barrier(const XcdBarrier& b) {
    asm volatile("s_waitcnt vmcnt(0)" ::: "memory");
    __syncthreads();
    if (threadIdx.x == 0) {
        unsigned* bar = b.bar;
        __builtin_amdgcn_s_waitcnt(0);
        unsigned nloc = b.st[0], nx = b.st[1];
        if (nloc == 0u) { xcd_barrier_complete(bar, b.x, nloc, nx); b.st[0] = nloc; b.st[1] = nx; }
        const unsigned old = xb_add(&bar[XB_XSUB(b.x)], 1u);
        const unsigned gen = old / nloc;
        if (old + 1u == (gen + 1u) * nloc) {
            __builtin_amdgcn_fence(__ATOMIC_RELEASE, "agent");
            asm volatile("s_waitcnt vmcnt(0)" ::: "memory");
            const unsigned og = xb_add(&bar[XB_TOP], 1u);
            const unsigned tg = og / nx;
            if (og + 1u == (tg + 1u) * nx) xb_add(&bar[XB_TOPGEN], 1u);
            else XB_SPIN(xb_ld(&bar[XB_TOPGEN]) == tg, bar);
            __builtin_amdgcn_fence(__ATOMIC_ACQUIRE, "agent");
            xb_add(&bar[XB_XGEN(b.x)], 1u);
            asm volatile("s_waitcnt vmcnt(0)" ::: "memory");
        } else {
            XB_SPIN(xb_ld(&bar[XB_XGEN(b.x)]) == gen, bar);
            __builtin_amdgcn_fence(__ATOMIC_ACQUIRE, "agent");
            asm volatile("s_waitcnt vmcnt(0)" ::: "memory");
        }
    }
    __syncthreads();
}


namespace att {
typedef short s16x4 __attribute__((ext_vector_type(4)));
typedef float f32x16 __attribute__((ext_vector_type(16)));
typedef unsigned u32x4 __attribute__((ext_vector_type(4)));
constexpr int NW = 8, QBLK = 32, KVBLK = 64, QB = NW * QBLK, D = 128;
constexpr int SHM_V = KVBLK * D * 2, SHM_K = KVBLK * D * 2;
constexpr int OFF_WS = 2 * SHM_V + 2 * SHM_K, OFF_BIAS = OFF_WS + NW * 64 * 4, OFF_NXT = OFF_BIAS + SEQ * 4, OFF_WT = OFF_NXT + 16, LDS_BYTES = OFF_WT + 64;
constexpr int QITEMS = (BATCH * NATT / 8) * (SEQ / QB);
constexpr float SCALE = 0.08838834764831845f, THR = 8.f;
constexpr int PITCH = PW;
#define KSWZ(row, colB) ((row) * 256 + ((colB) ^ (((row) & 7) << 4)))
#define SBAR() __builtin_amdgcn_sched_barrier(0)
__device__ __forceinline__ int v_st(int k, int c) { const int kk = (k & ~0xC) | ((k & 4) << 1) | ((k & 8) >> 1); return ((kk >> 3) * 4 + (c >> 5)) * 512 + ((kk & 7) * 32 + (c & 31)) * 2; }
__device__ __forceinline__ int v_rd_base(int lane) { return ((lane & 3) << 3) | (((lane >> 2) & 3) << 6) | (((lane >> 4) & 1) << 5) | (((lane >> 5) & 1) << 8); }
constexpr int v_rd_off(int d0, int ks, int half) { return d0 * 512 + ks * 4096 + half * 2048; }
__device__ __forceinline__ int crow(int r, int hi) { return (r & 3) + 8 * (r >> 2) + 4 * hi; }
__device__ __forceinline__ unsigned cvtpk(float lo, float hi) { unsigned r; asm volatile("v_cvt_pk_bf16_f32 %0, %1, %2" : "=v"(r) : "v"(lo), "v"(hi)); return r; }
__device__ __forceinline__ bf16x8 load8(const bf16* p) { return *reinterpret_cast<const bf16x8*>(p); }
__device__ __forceinline__ void mask_tile(f32x16& p0, f32x16& p1, int dq) {
    const float NEG = -__builtin_inff();
#pragma unroll
    for (int r = 0; r < 16; ++r) { const int c = (r & 3) + 8 * (r >> 2); if (dq - c < 0) p0[r] = NEG; if (dq - c - 32 < 0) p1[r] = NEG; }
}
__device__ __forceinline__ void partialSM(f32x16& p0, f32x16& p1, float& m_reg, float& mn, float& alpha) {
    float pmax = p0[0];
#pragma unroll
    for (int r = 1; r < 16; ++r) pmax = fmaxf(pmax, p0[r]);
#pragma unroll
    for (int r = 0; r < 16; ++r) pmax = fmaxf(pmax, p1[r]);
    { auto rr = __builtin_amdgcn_permlane32_swap(__float_as_uint(pmax), __float_as_uint(pmax), false, false); pmax = fmaxf(__uint_as_float(rr[0]), __uint_as_float(rr[1])); }
    constexpr float C2 = 1.4426950408889634f * SCALE;
    if (__builtin_expect(__all((pmax - m_reg) * SCALE <= THR), 1)) { mn = m_reg; alpha = 1.f; }
    else { mn = fmaxf(m_reg, pmax); alpha = __builtin_amdgcn_exp2f((m_reg - mn) * C2); m_reg = mn; }
    const float mnL = -mn * C2;
#pragma unroll
    for (int r = 0; r < 16; ++r) p0[r] = fmaf(p0[r], C2, mnL);
#pragma unroll
    for (int r = 0; r < 16; ++r) p1[r] = fmaf(p1[r], C2, mnL);
#pragma unroll
    for (int r = 0; r < 16; ++r) p0[r] = __builtin_amdgcn_exp2f(p0[r]);
}
__device__ __forceinline__ void finishSM(f32x16& p0, f32x16& p1, float alpha, float& l_reg, bf16x8& pa0, bf16x8& pa1, bf16x8& pa2, bf16x8& pa3) {
#pragma unroll
    for (int r = 0; r < 16; ++r) p1[r] = __builtin_amdgcn_exp2f(p1[r]);
    float ps = 0;
#pragma unroll
    for (int r = 0; r < 16; ++r) ps += p0[r];
#pragma unroll
    for (int r = 0; r < 16; ++r) ps += p1[r];
    { auto rr = __builtin_amdgcn_permlane32_swap(__float_as_uint(ps), __float_as_uint(ps), false, false); ps = __uint_as_float(rr[0]) + __uint_as_float(rr[1]); }
    l_reg = l_reg * alpha + ps;
#define PK4(P, B_, OUT) do { unsigned a0 = cvtpk(P[B_+0], P[B_+1]), a1 = cvtpk(P[B_+2], P[B_+3]);                          \
        unsigned b0 = cvtpk(P[B_+4], P[B_+5]), b1 = cvtpk(P[B_+6], P[B_+7]);                                             \
        auto r0 = __builtin_amdgcn_permlane32_swap(a0, b0, false, false); auto r1 = __builtin_amdgcn_permlane32_swap(a1, b1, false, false); \
        u32x4 w = {r0[0], r1[0], r0[1], r1[1]}; OUT = *reinterpret_cast<bf16x8*>(&w); } while (0)
    PK4(p0, 0, pa0); PK4(p0, 8, pa1); PK4(p1, 0, pa2); PK4(p1, 8, pa3);
#undef PK4
}
template <int KB>
__device__ __forceinline__ void qkt(f32x16& p0, f32x16& p1, const char* K_lds, int r32, int hi, const bf16x8* qr, const float* bt, float rowinit) {
    if (bt) { const f32x4* bp = (const f32x4*)(bt + 4 * hi);
#pragma unroll
        for (int g = 0; g < 4; ++g) { const f32x4 a = bp[2 * g], b = bp[2 * g + 8];
            p0[4 * g] = a[0]; p0[4 * g + 1] = a[1]; p0[4 * g + 2] = a[2]; p0[4 * g + 3] = a[3]; p1[4 * g] = b[0]; p1[4 * g + 1] = b[1]; p1[4 * g + 2] = b[2]; p1[4 * g + 3] = b[3]; } }
    else {
#pragma unroll
        for (int r = 0; r < 16; ++r) { p0[r] = rowinit; p1[r] = rowinit; } }
    const char* kb[4];
#pragma unroll
    for (int dd = 0; dd < 4; ++dd) kb[dd] = K_lds + KB * SHM_K + KSWZ(r32, (dd * 16 + hi * 8) * 2);
#pragma unroll
    for (int d0 = 0; d0 < 8; ++d0) { const char* a = kb[d0 & 3] + (d0 >> 2) * 128;
        bf16x8 b0 = *reinterpret_cast<const bf16x8*>(a);
        bf16x8 b1 = *reinterpret_cast<const bf16x8*>(a + 32 * 256);
        p0 = __builtin_amdgcn_mfma_f32_32x32x16_bf16(b0, qr[d0], p0, 0, 0, 0);
        p1 = __builtin_amdgcn_mfma_f32_32x32x16_bf16(b1, qr[d0], p1, 0, 0, 0); }
}
template <int VB>
__device__ __forceinline__ void pv_tile(f32x16* o, int vb0, bf16x8 pa0, bf16x8 pa1, bf16x8 pa2, bf16x8 pa3) {
#define TRRD(dst, off) asm volatile("ds_read_b64_tr_b16 %0, %1 offset:%2" : "=&v"(dst) : "v"(vb0), "i"(off) : "memory")
#define PV_D0(d0) do { s16x4 l0, l1, l2, l3, h0, h1, h2, h3; constexpr int b_ = VB * SHM_V + v_rd_off(d0, 0, 0); \
        TRRD(l0, b_); TRRD(h0, b_ + 2048); TRRD(l1, b_ + 4096); TRRD(h1, b_ + 6144); TRRD(l2, b_ + 8192); TRRD(h2, b_ + 10240); TRRD(l3, b_ + 12288); TRRD(h3, b_ + 14336); \
        asm volatile("s_waitcnt lgkmcnt(0)" ::: "memory"); SBAR();   \
        o[d0] = __builtin_amdgcn_mfma_f32_32x32x16_bf16(pa0, (bf16x8){l0[0], l0[1], l0[2], l0[3], h0[0], h0[1], h0[2], h0[3]}, o[d0], 0, 0, 0);   \
        o[d0] = __builtin_amdgcn_mfma_f32_32x32x16_bf16(pa1, (bf16x8){l1[0], l1[1], l1[2], l1[3], h1[0], h1[1], h1[2], h1[3]}, o[d0], 0, 0, 0);   \
        o[d0] = __builtin_amdgcn_mfma_f32_32x32x16_bf16(pa2, (bf16x8){l2[0], l2[1], l2[2], l2[3], h2[0], h2[1], h2[2], h2[3]}, o[d0], 0, 0, 0);   \
        o[d0] = __builtin_amdgcn_mfma_f32_32x32x16_bf16(pa3, (bf16x8){l3[0], l3[1], l3[2], l3[3], h3[0], h3[1], h3[2], h3[3]}, o[d0], 0, 0, 0); } while (0)
    PV_D0(0); PV_D0(1); PV_D0(2); PV_D0(3);
#undef PV_D0
#undef TRRD
}
struct BlockRef { int bh, qb; };
struct HeadCols { int qcol, kcol, vcol, type, ocol, opitch, ohstep; size_t obase_off; };
__device__ __forceinline__ HeadCols head_cols(int hidx) {
    HeadCols d;
    if (hidx < 12) { d.type = 0; d.qcol = C_QM + hidx * HD; d.kcol = C_KM + hidx * HD; d.vcol = C_VM + hidx * HD; d.obase_off = WS_MIX + (size_t)((hidx * HD) >> 6) * M * 64 * 2; d.opitch = 64; d.ohstep = M * 64; d.ocol = 0; }
    else if (hidx < 24) { const int h = hidx - 12; d.type = 1; d.qcol = C_QF + h * HD; d.kcol = C_KF + h * HD; d.vcol = C_VF + h * HD; d.obase_off = WS_MIX + (size_t)((1536 + h * HD) >> 6) * M * 64 * 2; d.opitch = 64; d.ohstep = M * 64; d.ocol = 0; }
    else { const int x = hidx - 24, h = x >> 2, mp = (x >> 1) & 1, e = x & 1; d.type = 2; d.qcol = C_QD + h * 256 + mp * HD; d.kcol = C_KD + h * 256 + mp * HD; d.vcol = C_VD + h * 256 + e * HD;
        d.obase_off = WS_DIFF + (size_t)mp * M * 1024 * 2; d.opitch = 1024; d.ohstep = 64; d.ocol = h * 256 + e * HD; }
    return d;
}
#define LAUNDER_S(x) asm volatile("" : "+s"(x))
__device__ __forceinline__ BlockRef q_item(int qx, int k) { const int kk = k / 10, ui = k - kk * 10, q4 = qx & 3; BlockRef r;
    const int hidx = ui < 3 ? 3 * q4 + ui : (ui < 6 ? 12 + 3 * q4 + (ui - 3) : 24 + 4 * q4 + (ui - 6));
    r.bh = (qx >> 2) * NATT + hidx; r.qb = 15 - kk; return r; }
struct Seam { bf16x8 qr[8]; bf16x8 st_v0, st_v1, st_k0, st_k1; };
#define ROW(p, k0, rr) ((p) + (size_t)((k0) + (rr)) * PITCH + sc)
#define VMW() asm volatile("s_waitcnt vmcnt(0)" ::: "memory")
#define VMWN(n) asm volatile("s_waitcnt vmcnt(%0)" :: "i"(n) : "memory")
#define SLOAD_H(Kp, Vp, k0) do { S.st_v0 = load8(ROW(Vp, k0, sr)); S.st_v1 = load8(ROW(Vp, k0, 32 + sr)); S.st_k0 = load8(ROW(Kp, k0, sr)); S.st_k1 = load8(ROW(Kp, k0, 32 + sr)); } while (0)
#define SWRITE_HK(bf) do { *(bf16x8*)(K_lds + (bf) * SHM_K + kws) = S.st_k0; *(bf16x8*)(K_lds + (bf) * SHM_K + kws + 32 * 256) = S.st_k1; } while (0)
#define SWRITE_HV(bf) do { *(bf16x8*)(V_lds + (bf) * SHM_V + vst0) = S.st_v0; *(bf16x8*)(V_lds + (bf) * SHM_V + vst1) = S.st_v1; } while (0)
#define SWRITE_H(bf) do { SWRITE_HV(bf); SWRITE_HK(bf); } while (0)
__device__ __forceinline__ void prime(BlockRef cur, unsigned char* wsb, char* lds, Seam& S, int tid) {
    const int wid = __builtin_amdgcn_readfirstlane(tid >> 6), lane = tid & 63, r32 = lane & 31, hi = lane >> 5;
    const int sr = tid >> 4, sc = (tid & 15) * 8, kws = KSWZ(sr, sc * 2); char* K_lds = lds + 2 * SHM_V;
    const int b = cur.bh / NATT; const HeadCols hc = head_cols(cur.bh - b * NATT);
    const bf16* PROJ = (const bf16*)(wsb + WS_PROJ); const size_t rowb = (size_t)b * SEQ;
    const bf16* Qp = PROJ + (rowb + (size_t)cur.qb * QB) * PITCH + hc.qcol; const bf16* Kp = PROJ + rowb * PITCH + hc.kcol; const bf16* Vp = PROJ + rowb * PITCH + hc.vcol;
#pragma unroll
    for (int d0 = 0; d0 < 8; ++d0) S.qr[d0] = load8(Qp + (size_t)(wid * QBLK + r32) * PITCH + d0 * 16 + hi * 8);
    SLOAD_H(Kp, Vp, cur.qb * QB + QB - KVBLK); VMW(); SWRITE_HK(0);
    __syncthreads();
}
__device__ __forceinline__ int block(BlockRef cur, unsigned* qctr, int qx, unsigned char* wsb, char* lds, Seam& S, int tid, float fox_thr) {
    const int wid = __builtin_amdgcn_readfirstlane(tid >> 6), lane = tid & 63, r32 = lane & 31, hi = lane >> 5;
    const int P0 = cur.qb * QB;
    const int NT = (P0 + QB) / KVBLK;
    int NS = NT;
    const int qlo = P0 + wid * QBLK, qm = qlo + r32 - 4 * hi;
    char* V_lds = lds; char* K_lds = lds + 2 * SHM_V;
    float* ws = (float*)(lds + OFF_WS) + wid * 64; float* li_l = ws, * al_l = ws + 32;
    float* blds = (float*)(lds + OFF_BIAS);
    float m_reg = -1e30f, l_reg = 0; f32x16 o[4] = {};
    const int sr = tid >> 4, sc = (tid & 15) * 8, vst0 = v_st(sr, sc), vst1 = v_st(32 + sr, sc), kws = KSWZ(sr, sc * 2);
    const int vb0 = (int)(uintptr_t)V_lds + v_rd_base(lane);
    const int cb = cur.bh / NATT, chx = cur.bh - cb * NATT; const HeadCols hc = head_cols(chx);
    const bf16* Kh = (const bf16*)(wsb + WS_PROJ) + (size_t)cb * SEQ * PITCH + hc.kcol; const bf16* Vh = (const bf16*)(wsb + WS_PROJ) + (size_t)cb * SEQ * PITCH + hc.vcol;
    const bool hb = hc.type == 1;
    unsigned nfetch = 0u; if (tid == 0) nfetch = __hip_atomic_fetch_add(qctr, 1u, __ATOMIC_RELAXED, __HIP_MEMORY_SCOPE_AGENT);
    unsigned selm = 0xffffffffu;
    int tid_h = tid; asm volatile("" : "+v"(tid_h)); const int lane_h = tid_h & 63;
    unsigned char* wsh = wsb; asm volatile("" : "+s"(wsh));
    if (hc.type == 0) {
        const int j = cur.qb; selm = 1u << j;
        if (j > 0) {
            const float* kp = (const float*)(wsh + WS_KPART) + (size_t)(cb * 12 + chx) * NBLK * KSUB * HD;
            for (int idx = tid_h; idx < j * HD; idx += NW * 64) { const int n = idx >> 7, d = idx & 127; const float* q_ = kp + (size_t)n * KSUB * HD + d; float a = 0.f;
#pragma unroll
                for (int sub = 0; sub < KSUB; ++sub) a += q_[sub * HD];
                blds[idx] = a * (1.0f / 256.0f); }
            __syncthreads();
            float b0 = -__builtin_inff(), b1 = b0, b2 = b0; int i0 = -1, i1 = -1, i2 = -1;
            for (int n = 0; n < j; ++n) { const float* km = blds + n * HD + 8 * (lane_h >> 5); float a = 0.f;
#pragma unroll
                for (int d0 = 0; d0 < 8; ++d0) { const f32x4 k0 = *(const f32x4*)(km + 16 * d0), k1 = *(const f32x4*)(km + 16 * d0 + 4); const bf16x8 qv = S.qr[d0];
                    a += bf2f((bf16)qv[0]) * k0[0] + bf2f((bf16)qv[1]) * k0[1] + bf2f((bf16)qv[2]) * k0[2] + bf2f((bf16)qv[3]) * k0[3] + bf2f((bf16)qv[4]) * k1[0] + bf2f((bf16)qv[5]) * k1[1] + bf2f((bf16)qv[6]) * k1[2] + bf2f((bf16)qv[7]) * k1[3]; }
                { auto rr = __builtin_amdgcn_permlane32_swap(__float_as_uint(a), __float_as_uint(a), false, false); a = __uint_as_float(rr[0]) + __uint_as_float(rr[1]); }
                if (a > b0) { b2 = b1; i2 = i1; b1 = b0; i1 = i0; b0 = a; i0 = n; } else if (a > b1) { b2 = b1; i2 = i1; b1 = a; i1 = n; } else if (a > b2) { b2 = a; i2 = n; } }
            if (i0 >= 0) selm |= 1u << i0; if (i1 >= 0) selm |= 1u << i1; if (i2 >= 0) selm |= 1u << i2;
        }
    }
    if (hb) { const float* lf = (const float*)(wsh + WS_LOGF) + (size_t)(cb * 12 + (chx - 12)) * SEQ; const int nk = P0 + QB;
        float v[8]; float tot = 0.f; const bool act = tid_h * 8 < nk;
        if (act) { const f32x4 a = *(const f32x4*)(lf + 8 * tid_h), b = *(const f32x4*)(lf + 8 * tid_h + 4);
            v[0] = a[0]; v[1] = v[0] + a[1]; v[2] = v[1] + a[2]; v[3] = v[2] + a[3]; v[4] = v[3] + b[0]; v[5] = v[4] + b[1]; v[6] = v[5] + b[2]; v[7] = v[6] + b[3]; tot = v[7]; }
        else {
#pragma unroll
            for (int i = 0; i < 8; ++i) v[i] = 0.f; }
        float inc = tot;
#pragma unroll
        for (int o_ = 1; o_ < 64; o_ <<= 1) { const float t_ = __int_as_float(__builtin_amdgcn_ds_bpermute((lane_h >= o_ ? lane_h - o_ : lane_h) << 2, __float_as_int(inc))); if (lane_h >= o_) inc += t_; }
        float* wt = (float*)(lds + OFF_WT);
        if (lane_h == 63) wt[wid] = inc;
        __syncthreads();
        float off = inc - tot;
        for (int w_ = 0; w_ < wid; ++w_) off += wt[w_];
        if (act) { f32x4 a, b; a[0] = (off + v[0]) * -11.313708498984761f; a[1] = (off + v[1]) * -11.313708498984761f; a[2] = (off + v[2]) * -11.313708498984761f; a[3] = (off + v[3]) * -11.313708498984761f;
            b[0] = (off + v[4]) * -11.313708498984761f; b[1] = (off + v[5]) * -11.313708498984761f; b[2] = (off + v[6]) * -11.313708498984761f; b[3] = (off + v[7]) * -11.313708498984761f;
            *(f32x4*)(blds + 8 * tid_h) = a; *(f32x4*)(blds + 8 * tid_h + 4) = b; }
        __syncthreads();
        if (wid == 0) { const float thr = fox_thr;
            const int ti = NT - 1 - lane_h; bool dead = false;
            if (lane_h >= 4 && ti >= 0) dead = (blds[P0] - blds[64 * ti + 63]) > thr;
            const unsigned long long bm = __ballot(dead);
            int ns = NT; if (bm != 0ull) { ns = __builtin_ctzll(bm); ns = (ns + 1) & ~1; if (ns > NT) ns = NT; }
            if (lane_h == 0) *(volatile int*)(lds + OFF_WT + 32) = ns; }
        __syncthreads();
        NS = __builtin_amdgcn_readfirstlane(*(volatile int*)(lds + OFF_WT + 32)); }
#define RESC(a) do { if (__any((a) < 1.f)) { if (hi == 0) al_l[r32] = (a); asm volatile("s_waitcnt lgkmcnt(0)" ::: "memory");              \
                     for (int d_ = 0; d_ < 4; ++d_) for (int r = 0; r < 16; ++r) o[d_][r] *= al_l[crow(r, hi)]; } } while (0)
#define KBASE(i) ((NT - 1 - (i)) * KVBLK)
#define BT(i) (hb ? blds + KBASE(i) : (const float*)nullptr)
#define RI(i) ((((selm >> ((NT - 1 - (i)) >> 2)) & 1u) != 0u) ? 0.f : -__builtin_inff())
#define MASKT(P0_, P1_, t) do { const int kb_ = KBASE(t); if (kb_ + KVBLK - 1 > qlo) mask_tile(P0_, P1_, qm - kb_); } while (0)
#define SEAM_K0() do { VMWN(8); SWRITE_HK(0); SBAR(); } while (0)
    f32x16 pA0, pA1, pB0, pB1; float mnA, mnB, alA, alB; bf16x8 pa0, pa1, pa2, pa3;
    SWRITE_HV(0); SBAR();
    SLOAD_H(Kh, Vh, KBASE(1));
    SBAR(); qkt<0>(pA0, pA1, K_lds, r32, hi, S.qr, BT(0), RI(0));
    MASKT(pA0, pA1, 0); partialSM(pA0, pA1, m_reg, mnA, alA);
    VMW(); SWRITE_H(1);
    if (tid == 0) *(volatile unsigned*)(lds + OFF_NXT) = nfetch;
    __syncthreads();
    const int nk = __builtin_amdgcn_readfirstlane((int)*(volatile unsigned*)(lds + OFF_NXT));
#define HALF_STEP(PX0, PX1, mnX, alX, PY0, PY1, alY, t, KB, VB, SB) do {                                                      \
        SBAR(); qkt<KB>(PX0, PX1, K_lds, r32, hi, S.qr, BT(t), RI(t));                                                        \
        finishSM(PY0, PY1, alY, l_reg, pa0, pa1, pa2, pa3); SBAR();                                                           \
        if ((t) + 1 < NS) { SLOAD_H(Kh, Vh, KBASE((t) + 1)); SBAR(); }                                                        \
        pv_tile<VB>(o, vb0, pa0, pa1, pa2, pa3); MASKT(PX0, PX1, (t)); partialSM(PX0, PX1, m_reg, mnX, alX);                  \
        __syncthreads();                                                                                                      \
        if ((t) + 1 < NS) { VMW(); SWRITE_H(SB); }                                                                            \
        RESC(alX); __syncthreads(); } while (0)
    for (int t = 1; t + 1 < NS; t += 2) {
        HALF_STEP(pB0, pB1, mnB, alB, pA0, pA1, alA, t, 1, 0, 0);
        HALF_STEP(pA0, pA1, mnA, alA, pB0, pB1, alB, t + 1, 0, 1, 1);
    }
    SBAR(); qkt<1>(pB0, pB1, K_lds, r32, hi, S.qr, BT(NS - 1), RI(NS - 1)); SBAR();
    { const BlockRef nxt = (nk < QITEMS) ? q_item(qx, nk) : cur; int nbh = nxt.bh, nqb = nxt.qb; LAUNDER_S(nbh); LAUNDER_S(nqb);
      const int nb = nbh / NATT; const HeadCols nh = head_cols(nbh - nb * NATT); const bf16* PROJ = (const bf16*)(wsb + WS_PROJ); const size_t rowb = (size_t)nb * SEQ;
      const bf16* nK = PROJ + rowb * PITCH + nh.kcol; const bf16* nV = PROJ + rowb * PITCH + nh.vcol; const bf16* nQ = PROJ + (rowb + (size_t)nqb * QB) * PITCH + nh.qcol;
      SLOAD_H(nK, nV, nqb * QB + QB - KVBLK); SBAR();
#pragma unroll
      for (int d0 = 0; d0 < 8; ++d0) S.qr[d0] = load8(nQ + (size_t)(wid * QBLK + r32) * PITCH + d0 * 16 + hi * 8); }
    SBAR();
    finishSM(pA0, pA1, alA, l_reg, pa0, pa1, pa2, pa3); SBAR();
    pv_tile<0>(o, vb0, pa0, pa1, pa2, pa3);
    MASKT(pB0, pB1, NS - 1); partialSM(pB0, pB1, m_reg, mnB, alB); __syncthreads(); RESC(alB);
    finishSM(pB0, pB1, alB, l_reg, pa0, pa1, pa2, pa3); SBAR(); pv_tile<1>(o, vb0, pa0, pa1, pa2, pa3);
    SBAR(); SEAM_K0();
    if (hi == 0) li_l[r32] = l_reg; asm volatile("s_waitcnt lgkmcnt(0)" ::: "memory");
    float rli[16];
#pragma unroll
    for (int r = 0; r < 16; ++r) rli[r] = __builtin_amdgcn_rcpf(li_l[crow(r, hi)]);
    { int obh = cur.bh, oqb = cur.qb; LAUNDER_S(obh); LAUNDER_S(oqb);
      const int ob = obh / NATT; const HeadCols oh = head_cols(obh - ob * NATT); const int opitch = oh.opitch, ohstep = oh.ohstep;
      bf16* Ow = (bf16*)(wsb + oh.obase_off) + ((size_t)ob * SEQ + (size_t)oqb * QB + wid * QBLK) * opitch + oh.ocol;
      int hi_e = hi; asm volatile("" : "+v"(hi_e));
      bf16* Ol = Ow + (size_t)(4 * hi_e) * opitch + r32;
#pragma unroll
      for (int r = 0; r < 16; ++r) { const int orow = (r & 3) + 8 * (r >> 2);
#pragma unroll
        for (int d0 = 0; d0 < 4; ++d0) { const float v = o[d0][r] * rli[r]; const float vn = __int_as_float(__builtin_amdgcn_mov_dpp(__float_as_int(v), 0xB1, 0xf, 0xf, true));
            if ((r32 & 1) == 0) *(unsigned*)(Ol + (size_t)orow * opitch + (size_t)(d0 >> 1) * ohstep + (d0 & 1) * 32) = cvtpk(v, vn); } } }
    __syncthreads();
    return nk;
#undef RESC
#undef KBASE
#undef BT
#undef RI
#undef MASKT
#undef SEAM_K0
#undef HALF_STEP
}
#undef ROW
#undef VMW
#undef VMWN
#undef SLOAD_H
#undef SWRITE_HK
#undef SWRITE_HV
#undef SWRITE_H
#undef KSWZ
#undef SBAR
}

struct Args { const float* in[20]; float* out; unsigned char* ws; int ph_lo, ph_hi; };
typedef const __attribute__((address_space(4))) Args* KArgs;
__device__ __forceinline__ KArgs kargs() { KArgs k = (KArgs)__builtin_amdgcn_kernarg_segment_ptr(); asm volatile("" : "+s"(k)); return k; }

__device__ __forceinline__ void p0_prologue(unsigned char* ws, LAS unsigned char* lds, int vcu, int NGW, int wave0, int lsel, int part) {
    FRESH_IDS(vcu);
    KArgs ka = kargs(); const float* in2 = ka->in[2]; const float* in15 = ka->in[15]; const float* in17 = ka->in[17]; const float* in18 = ka->in[18]; const float* in19 = ka->in[19]; const float* gA = ka->in[1]; const float* gF = ka->in[16];
    { constexpr int T_IN = (DM / 64) * (PW / 256), T_OUT = (DM / 64) * (DM / 256), T_G = (DM / 64) * (FF / 256), T_D = (FF / 64) * (DM / 256), T_LAYER = T_IN + T_OUT + 2 * T_G + T_D;
      const int G_ = NGW / NWAVES;
      LAS unsigned char* img = lds + RING_OFF;
      f32x4 ld[8];
      const float* W = nullptr; int sstride = 0, scol = 0, k0 = 0, K_ = 0, n0d = 0, mode = 0, nrows = 0; bf16* WT = nullptr; const float* gk = nullptr;
#define P0_DECODE(tl_) do { const int l_ = (tl_) / T_LAYER; int r_ = (tl_) - l_ * T_LAYER; gk = nullptr; mode = 0; \
        if (r_ < T_IN) { const int nb_ = PW / 256, kb_ = r_ / nb_, n0_ = (r_ - kb_ * nb_) * 256; W = in2 + (size_t)l_ * DM * INW; sstride = INW; scol = n0_ + (n0_ >= C_QD ? 12 : 0); k0 = 64 * kb_; WT = (bf16*)(ws + WS_WIN) + (size_t)l_ * PW * DM; K_ = DM; n0d = n0_; nrows = PW; gk = gA + l_ * DM; } \
        else if ((r_ -= T_IN) < T_OUT) { const int nb_ = DM / 256, kb_ = r_ / nb_, n0_ = (r_ - kb_ * nb_) * 256; W = in15 + (size_t)l_ * DM * DM; sstride = DM; scol = n0_; k0 = 64 * kb_; WT = (bf16*)(ws + WS_WOUT) + (size_t)l_ * DM * DM; K_ = DM; n0d = n0_; nrows = DM; } \
        else if ((r_ -= T_OUT) < 2 * T_G) { const int wh_ = r_ >= T_G; if (wh_) r_ -= T_G; const int nb_ = FF / 256, kb_ = r_ / nb_, n0_ = (r_ - kb_ * nb_) * 256; W = (wh_ ? in18 : in17) + (size_t)l_ * DM * FF; sstride = FF; scol = n0_; k0 = 64 * kb_; \
            WT = (bf16*)(ws + WS_WGU) + (size_t)l_ * NGU * DM; K_ = DM; n0d = n0_; nrows = NGU; gk = gF + l_ * DM; mode = 1 + wh_; } \
        else { r_ -= 2 * T_G; const int nb_ = DM / 256, kb_ = r_ / nb_, n0_ = (r_ - kb_ * nb_) * 256; W = in19 + (size_t)l_ * FF * DM; sstride = DM; scol = n0_; k0 = 64 * kb_; WT = (bf16*)(ws + WS_WD) + (size_t)l_ * DM * FF; K_ = FF; n0d = n0_; nrows = DM; } } while (0)
#define P0_LOADS() do { const float* wp_ = W + (size_t)(k0 + 8 * wave) * sstride + scol + 4 * lane; \
        _Pragma("unroll") for (int i_ = 0; i_ < 8; ++i_) ld[i_] = __builtin_nontemporal_load((const f32x4*)(wp_ + (size_t)i_ * sstride)); } while (0)
      const int p_lo = part == 0 ? 0 : (part == 1 ? T_IN : (part == 2 ? T_IN + T_OUT : T_IN + T_OUT + 2 * T_G)), p_hi = part == 0 ? T_IN : (part == 1 ? T_IN + T_OUT : (part == 2 ? T_IN + T_OUT + 2 * T_G : T_LAYER));
      unsigned* cq = (unsigned*)(ws + WS_CTL) + CW_CONV + (lsel * 8 + part) * 64; LAS unsigned* cw = (LAS unsigned*)(lds + RING_OFF + 65536);
      const int tbase = lsel * T_LAYER + p_lo, ntile = p_hi - p_lo;
      if (tid == 0) { const unsigned a0 = __hip_atomic_fetch_add(cq, 2u, __ATOMIC_RELAXED, __HIP_MEMORY_SCOPE_AGENT); cw[0] = a0; }
      __syncthreads();
      int ta = (int)cw[0], tb = ta + 1;
      __syncthreads();
      if (ta < ntile) { P0_DECODE(tbase + ta); P0_LOADS(); }
      while (ta < ntile) {
        unsigned fc = 0u; if (tid == 0) fc = __hip_atomic_fetch_add(cq, 1u, __ATOMIC_RELAXED, __HIP_MEMORY_SCOPE_AGENT);
#pragma unroll
        for (int i_ = 0; i_ < 8; ++i_) *(LAS f32x4*)(img + (8 * wave + i_) * 1024 + ((lane ^ wave) << 4)) = ld[i_];
        bf16* WTc = WT; const int k0c = k0, n0c = n0d, modec = mode, nrc = nrows; const float* gkc = gk; (void)K_;
        __syncthreads();
        if (tb < ntile) { P0_DECODE(tbase + tb); P0_LOADS(); }
        { const int c = tid & 7; f32x4 ga = {1.f, 1.f, 1.f, 1.f}, gb = {1.f, 1.f, 1.f, 1.f};
          if (gkc) { ga = *(const f32x4*)(gkc + k0c + 8 * c); gb = *(const f32x4*)(gkc + k0c + 8 * c + 4); }
#pragma unroll
          for (int j_ = 0; j_ < 4; ++j_) { const int n = (tid >> 3) + 64 * j_;
            const LAS unsigned char* sp = img + (8 * c) * 1024 + ((((n >> 2) ^ c) & 63) << 4) + ((n & 3) << 2);
            float v[8];
#pragma unroll
            for (int i_ = 0; i_ < 8; ++i_) v[i_] = *(const LAS float*)(sp + i_ * 1024);
            v4u o; o.x = pk2(v[0] * ga.x, v[1] * ga.y); o.y = pk2(v[2] * ga.z, v[3] * ga.w); o.z = pk2(v[4] * gb.x, v[5] * gb.y); o.w = pk2(v[6] * gb.z, v[7] * gb.w);
            const int na = n0c + n; const int drow = (modec == 0) ? na : ((na >> 7) * 256 + (modec - 1) * 128 + (na & 127));
            bf16* dp = WTc + ((size_t)(k0c >> 6) * nrc + drow) * 64 + 8 * c;
            *(GAS v4u*)dp = o; } }
        if (tid == 0) cw[0] = fc;
        __syncthreads();
        ta = tb; tb = (int)cw[0];
      }
      __syncthreads();
#undef P0_DECODE
#undef P0_LOADS
    }
    if (lsel != 0 || part != 0) return;
    const int gt = gw * 64 + lane, NGT = NGW * 64;
    for (int i = gt; i < DEPTH * 16 * DM; i += NGT) { const int l = i / (16 * DM), c = (i / DM) & 15, k = i % DM;
        ((bf16*)(ws + WS_WF))[i] = (c < 12) ? (bf16)f2bf(in2[((size_t)l * DM + k) * INW + 9216 + c] * gA[l * DM + k]) : (bf16)0; }
    { const float* x = ka->in[0]; float* ssq0 = (float*)(ws + WS_CTL) + CW_SSQ;
      for (int m = gw; m < M; m += NGW) { const GAS f32x4* xr = (const GAS f32x4*)(x + (size_t)m * DM) + lane; bf16* xa = (bf16*)(ws + WS_XN); float sq = 0.f;
#pragma unroll
        for (int j = 0; j < 16; ++j) { const f32x4 v = xr[64 * j]; sq += (v.x * v.x + v.y * v.y) + (v.z * v.z + v.w * v.w); v2u o; o.x = pk2(v.x, v.y); o.y = pk2(v.z, v.w); const int col = 4 * lane + 256 * j; *(GAS v2u*)(xa + ((size_t)(col >> 6) * M + m) * 64 + (col & 63)) = o; }
        sq = wave_sum(sq, lane); if (lane == 0) ssq0[m] = sq; } }
    for (int i = gt; i < SEQ * 64; i += NGT) { const int pos = i >> 6, fi = i & 63;
        const float invf = 1.0f / powf(10000.0f, (float)fi * (1.0f / 64.0f)); const float ang = (float)pos * invf;
        const double rev = (double)ang * 0.15915494309189533576888; const float fr = (float)(rev - rint(rev));
        ((f32x2*)(ws + WS_ROPE))[i] = (f32x2){__builtin_amdgcn_cosf(fr), __builtin_amdgcn_sinf(fr)}; }
}

constexpr int T3B_TILES = M / 16;
#define DPPF(v, ctrl) __int_as_float(__builtin_amdgcn_mov_dpp(__float_as_int(v), (ctrl), 0xf, 0xf, true))
__device__ __forceinline__ void t3_phase(unsigned char* ws, LAS unsigned char* lds, int l, int vcu, int G, int wave0) {
    FRESH_IDS(vcu);
    KArgs ka = kargs();
    { LAS f32x4* red = (LAS f32x4*)(lds + RING_OFF);
      const int tsel = wave >> 2, kq = wave & 3;
      for (int tb0 = vcu * 2; tb0 < T3B_TILES; tb0 += 2 * G) {
        const int t = tb0 + tsel;
        const bf16* A = (const bf16*)(ws + WS_XN) + ((size_t)(kq * 16) * M + (16 * t + (lane & 15))) * 64 + 8 * (lane >> 4);
        const bf16* B = (const bf16*)(ws + WS_WF) + (size_t)l * 16 * DM + (size_t)(lane & 15) * DM + kq * 1024 + 8 * (lane >> 4);
        f32x4 acc = {0.f, 0.f, 0.f, 0.f};
#pragma unroll 16
        for (int i = 0; i < 32; ++i) { const bf16x8 a = *(const bf16x8*)(A + (size_t)(i >> 1) * M * 64 + 32 * (i & 1)), b = *(const bf16x8*)(B + 32 * i); acc = __builtin_amdgcn_mfma_f32_16x16x32_bf16(a, b, acc, 0, 0, 0); }
        red[(tsel * 4 + kq) * 64 + lane] = acc;
        __syncthreads();
        if (kq == 0) {
            const f32x4 s4 = (red[(tsel * 4 + 0) * 64 + lane] + red[(tsel * 4 + 1) * 64 + lane]) + (red[(tsel * 4 + 2) * 64 + lane] + red[(tsel * 4 + 3) * 64 + lane]);
            const int c = lane & 15;
            if (c < 12) { const float fb = ka->in[7][l * 12 + c]; const float* ssq = (const float*)(ws + WS_CTL) + CW_SSQ + 2 * l * M;
                const int row0 = 16 * t + 4 * (lane >> 4), b = row0 / SEQ, s0 = row0 & (SEQ - 1); f32x4 ls;
#pragma unroll
                for (int r = 0; r < 4; ++r) { const float z = s4[r] * pg8::rs_of(ssq, row0 + r, 1.0f / DM, NORM_EPS) + fb; ls[r] = fminf(z, 0.f) - log1pf(expf(-fabsf(z))); }
                *(f32x4*)((float*)(ws + WS_LOGF) + (size_t)(b * 12 + c) * SEQ + s0) = ls; } }
        __syncthreads();
      } }
    bf16* PROJ = (bf16*)(ws + WS_PROJ);
    const int g = gw & 15; constexpr int NCH = M / T3A_ROWS;
    int col0; const float* gsel; bool rot, km = false;
    if (g < 3) { col0 = C_QM + 512 * g; gsel = ka->in[3]; rot = true; }
    else if (g < 6) { col0 = C_KM + 512 * (g - 3); gsel = ka->in[4]; rot = true; km = true; }
    else if (g < 9) { col0 = C_QF + 512 * (g - 6); gsel = ka->in[5]; rot = false; }
    else if (g < 12) { col0 = C_KF + 512 * (g - 9); gsel = ka->in[6]; rot = false; }
    else if (g < 14) { col0 = C_QD + 512 * (g - 12); gsel = ka->in[8]; rot = true; }
    else { col0 = C_KD + 512 * (g - 14); gsel = ka->in[9]; rot = true; }
    const int hv = lane >> 4, c8 = (lane & 15) * 8, cstep = (G * NWAVES) >> 4;
    float gn[8], dc[8], dsn[8];
    { const float* gp = gsel + l * HD + c8;
#pragma unroll
      for (int e = 0; e < 8; ++e) gn[e] = gp[e];
      const GAS f32x4* r1 = (const GAS f32x4*)((const float*)(ws + WS_ROPE) + ((size_t)1 * 64 + (c8 & 63)) * 2);
#pragma unroll
      for (int q = 0; q < 4; ++q) { const f32x4 b = r1[q]; dc[2 * q] = b.x; dsn[2 * q] = b.y; dc[2 * q + 1] = b.z; dsn[2 * q + 1] = b.w; } }
    const bool up = (lane & 8) != 0;
    const unsigned voff = (unsigned)(col0 + hv * 128 + c8) * 2u;
    for (int chunk = gw >> 4; chunk < NCH; chunk += cstep) {
        v4u w[T3A_ROWS]; float cs[8], sn[8];
        { const int row0_ = chunk * T3A_ROWS; GAS char* ub_ = (GAS char*)PROJ + (size_t)row0_ * PW * 2;
#pragma unroll
          for (int rr = 0; rr < T3A_ROWS; ++rr) w[rr] = *(GAS v4u*)(ub_ + (size_t)rr * PW * 2 + voff);
          const GAS f32x4* rp_ = (const GAS f32x4*)((const float*)(ws + WS_ROPE) + ((size_t)(row0_ & (SEQ - 1)) * 64 + (c8 & 63)) * 2);
#pragma unroll
          for (int q = 0; q < 4; ++q) { const f32x4 a = rp_[q]; cs[2 * q] = a.x; sn[2 * q] = a.y; cs[2 * q + 1] = a.z; sn[2 * q + 1] = a.w; } }
        const int row0 = chunk * T3A_ROWS, pos0 = row0 & (SEQ - 1);
        GAS char* ub0 = (GAS char*)PROJ + (size_t)row0 * PW * 2;
        float ks[8];
#pragma unroll
        for (int e = 0; e < 8; ++e) ks[e] = 0.f;
#pragma unroll
        for (int rr = 0; rr < T3A_ROWS; ++rr) {
            float y[8];
            y[0] = bflo(w[rr].x); y[1] = bfhi(w[rr].x); y[2] = bflo(w[rr].y); y[3] = bfhi(w[rr].y); y[4] = bflo(w[rr].z); y[5] = bfhi(w[rr].z); y[6] = bflo(w[rr].w); y[7] = bfhi(w[rr].w);
            float ss = 0.f;
#pragma unroll
            for (int e = 0; e < 8; ++e) ss += y[e] * y[e];
            ss += DPPF(ss, 0xB1); ss += DPPF(ss, 0x4E); ss += DPPF(ss, 0x141); ss += DPPF(ss, 0x140);
            const float sc = 1.0f / sqrtf(ss * (1.0f / HD) + NORM_EPS);
#pragma unroll
            for (int e = 0; e < 8; ++e) y[e] = y[e] * sc * gn[e];
            if (rot) {
#pragma unroll
                for (int e = 0; e < 8; ++e) { const float o = DPPF(y[e], 0x128);
                    y[e] = up ? (y[e] * cs[e] + o * sn[e]) : (y[e] * cs[e] - o * sn[e]);
                    const float cn = cs[e] * dc[e] - sn[e] * dsn[e]; sn[e] = sn[e] * dc[e] + cs[e] * dsn[e]; cs[e] = cn; }
            }
            v4u o; o.x = pk2(y[0], y[1]); o.y = pk2(y[2], y[3]); o.z = pk2(y[4], y[5]); o.w = pk2(y[6], y[7]);
            *(GAS v4u*)(ub0 + (size_t)rr * PW * 2 + voff) = o;
            if (km) {
#pragma unroll
                for (int e = 0; e < 8; ++e) ks[e] += y[e];
            }
        }
        if (km) {
            const int b = row0 / SEQ, blk = pos0 >> 8, sub = (pos0 & 255) / T3A_ROWS, h = 4 * (g - 3) + hv;
            float* kp = (float*)(ws + WS_KPART) + ((((size_t)(b * 12 + h) * NBLK + blk) * KSUB + sub) * HD) + c8;
            *(f32x4*)kp = (f32x4){ks[0], ks[1], ks[2], ks[3]}; *(f32x4*)(kp + 4) = (f32x4){ks[4], ks[5], ks[6], ks[7]};
        }
    }
}
__device__ __forceinline__ void attn_phase(unsigned char* ws, char* lds, int vcu, int G, int wave0, int layer) {
    const int tid = fresh_tid(wave0);
    int qx = (vcu * 8) / G; if (qx > 7) qx = 7;
    unsigned* qctr = (unsigned*)(ws + WS_CTL) + CW_ATTQ + (layer * 8 + qx) * 64;
    if (tid == 0) *(volatile unsigned*)(lds + att::OFF_NXT) = __hip_atomic_fetch_add(qctr, 1u, __ATOMIC_RELAXED, __HIP_MEMORY_SCOPE_AGENT);
    __syncthreads();
    int k = __builtin_amdgcn_readfirstlane((int)*(volatile unsigned*)(lds + att::OFF_NXT));
    __syncthreads();
    if (k >= att::QITEMS) return;
    float fox_thr;
    { const float* gq = kargs()->in[5] + layer * HD; const float* gk_ = kargs()->in[6] + layer * HD; const int lane = tid & 63;
      float mq = fmaxf(fabsf(gq[lane]), fabsf(gq[lane + 64])), mk = fmaxf(fabsf(gk_[lane]), fabsf(gk_[lane + 64]));
      mq = wave_max(mq, lane); mk = wave_max(mk, lane);
      fox_thr = __int_as_float(__builtin_amdgcn_readfirstlane(__float_as_int(106.0f * 11.313708498984761f + 2.0f * (128.0f * 1.02f) * mq * mk))); }
    att::Seam S;
    att::prime(att::q_item(qx, k), ws, lds, S, tid);
    for (;;) {
        const int nk = att::block(att::q_item(qx, k), qctr, qx, ws, lds, S, tid, fox_thr);
        if (nk >= att::QITEMS) break;
        k = nk;
    }
}
__device__ __forceinline__ void t5_phase(unsigned char* ws, int l, int vcu, int NGW, int wave0) {
    FRESH_IDS(vcu);
    KArgs ka = kargs(); const float* q1 = ka->in[10]; const float* k1 = ka->in[11]; const float* q2 = ka->in[12]; const float* k2 = ka->in[13];
    float s1 = q1[l * HD + lane] * k1[l * HD + lane] + q1[l * HD + 64 + lane] * k1[l * HD + 64 + lane];
    float s2 = q2[l * HD + lane] * k2[l * HD + lane] + q2[l * HD + 64 + lane] * k2[l * HD + 64 + lane];
    const float lam_init = 0.8f - 0.6f * expf(-0.3f * (float)l);
    const float lam = expf(wave_sum(s1, lane)) - expf(wave_sum(s2, lane)) + lam_init;
    const f32x4 gn = *(const f32x4*)(ka->in[14] + l * 256 + 4 * lane);
    const bf16* D0 = (const bf16*)(ws + WS_DIFF); const bf16* D1 = D0 + (size_t)M * 1024; bf16* MIX = (bf16*)(ws + WS_MIX);
    for (int it = gw; it < M * NH_D; it += NGW) {
        const int row = it >> 2, h = it & 3;
        const v2u a = *(const v2u*)(D0 + (size_t)row * 1024 + h * 256 + 4 * lane), b = *(const v2u*)(D1 + (size_t)row * 1024 + h * 256 + 4 * lane);
        const float v0 = bflo(a.x) - lam * bflo(b.x), v1 = bfhi(a.x) - lam * bfhi(b.x), v2 = bflo(a.y) - lam * bflo(b.y), v3 = bfhi(a.y) - lam * bfhi(b.y);
        const float ss = wave_sum((v0 * v0 + v1 * v1) + (v2 * v2 + v3 * v3), lane);
        const float sc = (1.0f / sqrtf(ss * (1.0f / 256.0f) + NORM_EPS)) * (1.0f - lam_init);
        v2u o; o.x = pk2(v0 * sc * gn.x, v1 * sc * gn.y); o.y = pk2(v2 * sc * gn.z, v3 * sc * gn.w);
        { const int col = 3072 + h * 256 + 4 * lane; *(v2u*)(MIX + ((size_t)(col >> 6) * M + row) * 64 + (col & 63)) = o; }
    }
}

__global__ void __launch_bounds__(NWAVES * 64, 2) mk_fwd(Args args_unused) {
    extern __shared__ __attribute__((aligned(16))) unsigned char lds_raw[];
    LAS unsigned char* lds = (LAS unsigned char*)lds_raw;
    volatile LAS unsigned* MISC = (volatile LAS unsigned*)(lds + MISC_OFF);
    const int wave0 = __builtin_amdgcn_readfirstlane((int)threadIdx.x >> 6);
    const int tid = fresh_tid(wave0);
    const int G = gridDim.x; const int bx = blockIdx.x; const int vcu = (G % 8 == 0) ? (bx % 8) * (G / 8) + bx / 8 : bx;
    const int NGW = G * NWAVES;
    for (int u = tid; u < (LDS_BYTES - LDSCTL_OFF) / 4; u += NWAVES * 64) ((LAS unsigned*)(lds + LDSCTL_OFF))[u] = 0u;
    __syncthreads();
    XcdBarrier bar; { unsigned char* ws0 = kargs()->ws; bar.bar = (unsigned*)(ws0 + WS_CTL) + CW_BAR; bar.x = 0; bar.st = nullptr;
        if (MK_N_LAUNCHES == 1) bar = xcd_barrier_post((unsigned*)(ws0 + WS_CTL) + CW_BAR, MISC + 8); }
#define GRID_BAR() do { if (MK_N_LAUNCHES == 1) xcd_barrier(bar); } while (0)
    const int lo = kargs()->ph_lo, hi = kargs()->ph_hi;
#define IN(k) (lo <= (k) && (k) < hi)
    unsigned long long tpA = 0ull, tpD = 0ull;
#define TP_BEGIN(k) do { if (MK_TIME_PHASE >= 0 && (k) == MK_TIME_PHASE) tpA = __builtin_amdgcn_s_memrealtime(); } while (0)
#define TP_END(k) do { if (MK_TIME_PHASE >= 0 && (k) == MK_TIME_PHASE) tpD = __builtin_amdgcn_s_memrealtime() - tpA; } while (0)
#define BOTH(k) (IN(k) && IN((k) + 1))
    if (IN(0)) { TP_BEGIN(0); for (int rep = 0; rep < REPS(100); ++rep) p0_prologue(kargs()->ws, lds, vcu, NGW, wave0, 0, 0); if (BOTH(0)) GRID_BAR(); TP_END(0); }
    for (int l = 0; l < DEPTH; ++l) {
        const int pb = 2 + 8 * l;
        if (l > 0 && IN(pb - 1)) { TP_BEGIN(pb - 1); p0_prologue(kargs()->ws, lds, vcu, NGW, wave0, l, 0); if (BOTH(pb - 1)) GRID_BAR(); TP_END(pb - 1); }
        if (IN(pb + 0)) { TP_BEGIN(pb + 0); unsigned char* ws = kargs()->ws;
            pg8::Gemm g{(const bf16*)(ws + WS_XN), (const bf16*)(ws + WS_WIN) + (size_t)l * PW * DM, M, PW, DM}; pg8::StaticOrder S; S.init(M, PW, G, bx);
            pg8::EpiStoreBf16 E{(bf16*)(ws + WS_PROJ), PW, (const float*)(ws + WS_CTL) + CW_SSQ + 2 * l * M, 1.0f / DM, NORM_EPS};
            for (int rep = 0; rep < REPS(0); ++rep) pg8::gemm_phase<pg8::EpiStoreBf16, pg8::StaticOrder, true, true, true>(lds + RING_OFF, g, S, E, fresh_tid(wave0));
            if (BOTH(pb + 0)) GRID_BAR(); TP_END(pb + 0); }
        if (IN(pb + 1)) { TP_BEGIN(pb + 1); t3_phase(kargs()->ws, lds, l, vcu, G, wave0); p0_prologue(kargs()->ws, lds, vcu, NGW, wave0, l, 1);     if (BOTH(pb + 1)) GRID_BAR(); TP_END(pb + 1); }
        if (IN(pb + 2)) { TP_BEGIN(pb + 2);
            attn_phase(kargs()->ws, (char*)lds_raw + RING_OFF, vcu, G, wave0, l);
            if (BOTH(pb + 2)) GRID_BAR(); TP_END(pb + 2); }
        if (IN(pb + 3)) { TP_BEGIN(pb + 3); for (int rep = 0; rep < REPS(4); ++rep) t5_phase(kargs()->ws, l, vcu, NGW, wave0); if (BOTH(pb + 3)) GRID_BAR(); TP_END(pb + 3); }
        if (IN(pb + 4)) { TP_BEGIN(pb + 4); KArgs ka = kargs(); unsigned char* ws = ka->ws; const float* xin = (l == 0) ? ka->in[0] : (const float*)(ws + WS_XB);
            pg8::Gemm g{(const bf16*)(ws + WS_MIX), (const bf16*)(ws + WS_WOUT) + (size_t)l * DM * DM, M, DM, DM}; pg8::StaticOrder S; S.init(M, DM, G, bx);
            pg8::EpiResid E{xin, ka->out, DM, (bf16*)(ws + WS_XN), (float*)(ws + WS_CTL) + CW_SSQ + (2 * l + 1) * M, (float*)(ws + WS_SSP) + (size_t)(2 * l) * M * 16, (unsigned*)(ws + WS_CTL) + CW_PCNT + (2 * l) * 32 * 64, (LAS float*)(lds + XL_OFF), DM / 256, M};
            pg8::gemm_phase<pg8::EpiResid, pg8::StaticOrder, true, true, true>(lds + RING_OFF, g, S, E, fresh_tid(wave0));
            p0_prologue(ws, lds, vcu, NGW, wave0, l, 2);
            if (BOTH(pb + 4)) GRID_BAR(); TP_END(pb + 4); }
        if (IN(pb + 5)) { TP_BEGIN(pb + 5); unsigned char* ws = kargs()->ws;
            pg8::Gemm g{(const bf16*)(ws + WS_XN), (const bf16*)(ws + WS_WGU) + (size_t)l * NGU * DM, M, NGU, DM}; pg8::StaticOrder S; S.init(M, NGU, G, bx);
            pg8::EpiSwiGLU E{(bf16*)(ws + WS_HB), FF, (const float*)(ws + WS_CTL) + CW_SSQ + (2 * l + 1) * M, 1.0f / DM, NORM_EPS, M};
            for (int rep = 0; rep < REPS(6); ++rep) pg8::gemm_phase<pg8::EpiSwiGLU, pg8::StaticOrder, true, true, true>(lds + RING_OFF, g, S, E, fresh_tid(wave0));
            p0_prologue(ws, lds, vcu, NGW, wave0, l, 3);
            if (BOTH(pb + 5)) GRID_BAR(); TP_END(pb + 5); }
        if (IN(pb + 6)) { TP_BEGIN(pb + 6); KArgs ka = kargs(); unsigned char* ws = ka->ws; const bool lastl = (l == DEPTH - 1); float* x2 = lastl ? ka->out : (float*)(ws + WS_XB);
            pg8::Gemm g{(const bf16*)(ws + WS_HB), (const bf16*)(ws + WS_WD) + (size_t)l * DM * FF, M, DM, FF}; pg8::StaticOrder S; S.init(M, DM, G, bx, 4);
            pg8::EpiResid E{ka->out, x2, DM, lastl ? (bf16*)nullptr : (bf16*)(ws + WS_XN), (float*)(ws + WS_CTL) + CW_SSQ + (2 * l + 2) * M, (float*)(ws + WS_SSP) + (size_t)(2 * l + 1) * M * 16, (unsigned*)(ws + WS_CTL) + CW_PCNT + (2 * l + 1) * 32 * 64, (LAS float*)(lds + XL_OFF), DM / 256, M};
            pg8::gemm_phase<pg8::EpiResid, pg8::StaticOrder, true, true, true>(lds + RING_OFF, g, S, E, fresh_tid(wave0));
              TP_END(pb + 6); }
    }
    if (MK_TIME_PHASE >= 0 && blockIdx.x == 0) { const unsigned long long t0 = __builtin_amdgcn_s_memrealtime(); while (__builtin_amdgcn_s_memrealtime() - t0 < tpD) __builtin_amdgcn_s_sleep(8); }
#undef IN
#undef BOTH
}

extern "C" void kernel_launch(void* const* d_in, const int* in_sizes, int n_in, void* d_out, int out_size, void* d_ws, size_t ws_size, hipStream_t stream) {
    static int grid = 0;
    if (grid == 0) {
        if (n_in != 20 || in_sizes[0] != M * DM || out_size != M * DM || ws_size < WS_END) { fprintf(stderr, "kernel_launch: unexpected shapes (n_in %d, in0 %d, out %d, ws %zu < %zu); nothing launched\n", n_in, n_in > 0 ? in_sizes[0] : -1, out_size, ws_size, (size_t)WS_END); grid = -1; return; }
        int dev = 0, cus = 0, per_cu = 0;
        if (hipGetDevice(&dev) != hipSuccess || hipDeviceGetAttribute(&cus, hipDeviceAttributeMultiprocessorCount, dev) != hipSuccess) { grid = -1; return; }
        if (hipFuncSetAttribute((const void*)mk_fwd, hipFuncAttributeMaxDynamicSharedMemorySize, LDS_BYTES) != hipSuccess) { fprintf(stderr, "kernel_launch: hipFuncSetAttribute failed\n"); grid = -1; return; }
        if (hipOccupancyMaxActiveBlocksPerMultiprocessor(&per_cu, (const void*)mk_fwd, NWAVES * 64, LDS_BYTES) != hipSuccess || per_cu < 1) fprintf(stderr, "kernel_launch: occupancy query says %d\n", per_cu);
        (void)hipGetLastError();
        grid = cus;
    }
    if (grid < 0) return;
    if (hipMemsetAsync((char*)d_ws + WS_CTL, 0, CTL_ZERO_BYTES, stream) != hipSuccess) return;
    Args a{};
    for (int i = 0; i < 20; ++i) a.in[i] = (const float*)d_in[i];
    a.out = (float*)d_out; a.ws = (unsigned char*)d_ws;
    if (MK_N_LAUNCHES == 1) { a.ph_lo = 0; a.ph_hi = NPH; hipLaunchKernelGGL(mk_fwd, dim3(grid), dim3(NWAVES * 64), LDS_BYTES, stream, a); }
    else for (int p = 0; p < NPH; ++p) { a.ph_lo = p; a.ph_hi = p + 1; hipLaunchKernelGGL(mk_fwd, dim3(grid), dim3(NWAVES * 64), LDS_BYTES, stream, a); }
}
```

```cpp
#include <hip/hip_runtime.h>
#include <cstdio>
#include <cstdint>
#include <cmath>
namespace pg8 {
#define PG8_LAS __attribute__((address_space(3)))
typedef unsigned short bf16_t;
typedef short bf16x8 __attribute__((ext_vector_type(8)));
typedef float f32x4 __attribute__((ext_vector_type(4)));
typedef unsigned u32x4 __attribute__((ext_vector_type(4)));
constexpr int BM = 256, BK = 64, HALF = 128, HTB = HALF * BK * 2  , STAGE_BYTES = 8 * HTB, NXCD = 8, WGM = 8;

__host__ __device__ __forceinline__ int lds_byte(int r, int c) { const int st = (r >> 4) * 2 + (c >> 5), rr = r & 15, cc = c & 31, ob = rr * 64 + cc * 2; return st * 1024 + (ob ^ (((ob >> 9) & 1) << 5)); }
__host__ __device__ __forceinline__ void stage_rc(int b, int& R, int& C) { const int st = b / 1024, sb = b % 1024, swz = sb ^ (((sb >> 9) & 1) << 5); R = (st >> 1) * 16 + swz / 64; C = (st & 1) * 32 + (swz % 64) / 2; }
__host__ __device__ __forceinline__ int perm32(int rho) { const int n = rho >> 4, i = rho & 15; return 8 * (i >> 2) + 4 * n + (i & 3); }

struct Unit { int pm, pn; };
struct Gemm { const bf16_t* A; const bf16_t* Bt; int M, N, K; };

struct StaticOrder {
    int nM, nN, nwg, G, c;
    __host__ __device__ void init(int M, int N, int G_, int c_) { nM = M / BM; nN = N / BM; nwg = nM * nN; G = G_; c = c_; }
    __host__ __device__ bool next(int i, Unit& u) const {
        const long L = (long)i * G + c; if (L >= nwg) return false;
        int wgid = (int)L; { const int q = nwg / NXCD, r = nwg % NXCD, xcd = wgid % NXCD, off = wgid / NXCD; wgid = (xcd < r ? xcd * (q + 1) : r * (q + 1) + (xcd - r) * q) + off; }
        const int nig = WGM * nN, gid = wgid / nig, fm = gid * WGM, gsz = (nM - fm) < WGM ? (nM - fm) : WGM;
        u.pm = fm + ((wgid % nig) % gsz); u.pn = (wgid % nig) / gsz; return true;
    }
    __device__ __forceinline__ void a_ready(const Unit&) const {}
    __device__ __forceinline__ void done(const Unit&) const {}
};

__device__ __forceinline__ unsigned cvt_pk_bf16(float lo, float hi) { unsigned r; asm volatile("v_cvt_pk_bf16_f32 %0, %1, %2" : "=v"(r) : "v"(lo), "v"(hi)); return r; }
__device__ __forceinline__ float rs_of(const float* ssq, int row, float inv_k, float eps) { return 1.0f / sqrtf(ssq[row] * inv_k + eps); }
struct EpiStoreBf16 {
    static constexpr bool PERM = true, AFTER_DRAIN = false;
    bf16_t* O; int ldc; const float* ssq; float inv_k, eps;
    __device__ __forceinline__ void operator()(const f32x4 (&acc)[2][2][4][2], const Unit& u, int wr, int wc, int fr, int fq) const {
        const int row0 = u.pm * BM + wr * 64 + fr, col0 = u.pn * BM + wc * 32 + 8 * fq;
#pragma unroll
        for (int ai = 0; ai < 2; ++ai)
#pragma unroll
            for (int m = 0; m < 4; ++m) { const int row = row0 + ai * HALF + m * 16; bf16_t* rowp = O + (size_t)row * ldc + col0; const float r = rs_of(ssq, row, inv_k, eps);
#pragma unroll
                for (int bj = 0; bj < 2; ++bj) { const f32x4 v0 = acc[ai][bj][m][0] * r, v1 = acc[ai][bj][m][1] * r;
                    u32x4 w; w.x = cvt_pk_bf16(v0[0], v0[1]); w.y = cvt_pk_bf16(v0[2], v0[3]); w.z = cvt_pk_bf16(v1[0], v1[1]); w.w = cvt_pk_bf16(v1[2], v1[3]);
                    *(u32x4*)(rowp + bj * HALF) = w; } }
    }
};
__device__ __forceinline__ float silu_mul(float g, float u) { const float e = __builtin_amdgcn_exp2f(-g * 1.4426950408889634f); return g * __builtin_amdgcn_rcpf(1.0f + e) * u; }
struct EpiSwiGLU {
    static constexpr bool PERM = true, AFTER_DRAIN = false;
    bf16_t* O; int ldc; const float* ssq; float inv_k, eps; int tiledM;
    __device__ __forceinline__ void operator()(const f32x4 (&acc)[2][2][4][2], const Unit& u, int wr, int wc, int fr, int fq) const {
        const int row0 = u.pm * BM + wr * 64 + fr, col0 = u.pn * HALF + wc * 32 + 8 * fq;
#pragma unroll
        for (int ai = 0; ai < 2; ++ai)
#pragma unroll
            for (int m = 0; m < 4; ++m) { const int row = row0 + ai * HALF + m * 16; const float r = rs_of(ssq, row, inv_k, eps);
                bf16_t* rowp = tiledM ? O + ((size_t)(col0 >> 6) * tiledM + row) * 64 + (col0 & 63) : O + (size_t)row * ldc + col0;
                const f32x4 g0 = acc[ai][0][m][0] * r, g1 = acc[ai][0][m][1] * r, u0 = acc[ai][1][m][0] * r, u1 = acc[ai][1][m][1] * r;
                u32x4 w; w.x = cvt_pk_bf16(silu_mul(g0[0], u0[0]), silu_mul(g0[1], u0[1])); w.y = cvt_pk_bf16(silu_mul(g0[2], u0[2]), silu_mul(g0[3], u0[3]));
                w.z = cvt_pk_bf16(silu_mul(g1[0], u1[0]), silu_mul(g1[1], u1[1])); w.w = cvt_pk_bf16(silu_mul(g1[2], u1[2]), silu_mul(g1[3], u1[3]));
                *(u32x4*)rowp = w; }
    }
};
struct EpiResid {
    static constexpr bool PERM = false, AFTER_DRAIN = false;
    const float* base; float* out; int ldc; bf16_t* xb; float* ssq; float* ssp; unsigned* pcnt; PG8_LAS float* xl; int ntn; int xbM;
    __device__ __forceinline__ void operator()(const f32x4 (&acc)[2][2][4][2], const Unit& u, int wr, int wc, int fr, int fq) const {
        const int row0 = u.pm * BM + wr * 64 + fr, col0 = u.pn * BM + wc * 32 + 4 * fq; const int lane = fr + 16 * fq, tid = (wr * 4 + wc) * 64 + lane;
        typedef unsigned u32x2 __attribute__((ext_vector_type(2)));
#pragma unroll
        for (int ai = 0; ai < 2; ++ai)
#pragma unroll
            for (int m = 0; m < 4; ++m) { const int row = row0 + ai * HALF + m * 16; const size_t off = (size_t)row * ldc + col0; float ss = 0.f;
#pragma unroll
                for (int bj = 0; bj < 2; ++bj)
#pragma unroll
                    for (int n = 0; n < 2; ++n) { const f32x4 b = *(const f32x4*)(base + off + bj * HALF + n * 16); const f32x4 o = b + acc[ai][bj][m][n]; *(f32x4*)(out + off + bj * HALF + n * 16) = o;
                        if (xb) { u32x2 w; w.x = cvt_pk_bf16(o[0], o[1]); w.y = cvt_pk_bf16(o[2], o[3]); const int col = col0 + bj * HALF + n * 16; *(u32x2*)(xb + ((size_t)(col >> 6) * xbM + row) * 64 + (col & 63)) = w; }
                        ss += (o[0] * o[0] + o[1] * o[1]) + (o[2] * o[2] + o[3] * o[3]); }
                if (xb) { ss += __int_as_float(__builtin_amdgcn_ds_bpermute((lane ^ 16) << 2, __float_as_int(ss))); ss += __int_as_float(__builtin_amdgcn_ds_bpermute((lane ^ 32) << 2, __float_as_int(ss)));
                    if (fq == 0) xl[(ai * HALF + wr * 64 + m * 16 + fr) * 4 + wc] = ss; } }
        if (xb) {
            asm volatile("s_waitcnt lgkmcnt(0)" ::: "memory"); __builtin_amdgcn_s_barrier(); asm volatile("" ::: "memory");
            if (tid < BM) { const f32x4 p4 = *(const PG8_LAS f32x4*)(xl + tid * 4); const float t = (p4[0] + p4[1]) + (p4[2] + p4[3]);
                __hip_atomic_store(ssp + (size_t)(u.pm * BM + tid) * 16 + u.pn, t, __ATOMIC_RELAXED, __HIP_MEMORY_SCOPE_AGENT); }
            asm volatile("s_waitcnt vmcnt(0)" ::: "memory");
            __builtin_amdgcn_s_barrier(); asm volatile("" ::: "memory");
            if (tid == 0) { const unsigned old = __hip_atomic_fetch_add(pcnt + 64 * u.pm, 1u, __ATOMIC_RELAXED, __HIP_MEMORY_SCOPE_AGENT); ((PG8_LAS unsigned*)xl)[1024] = (old == (unsigned)(ntn - 1)) ? 1u : 0u; }
            asm volatile("s_waitcnt vmcnt(0) lgkmcnt(0)" ::: "memory"); __builtin_amdgcn_s_barrier(); asm volatile("" ::: "memory");
            if (((volatile PG8_LAS unsigned*)xl)[1024] != 0u && tid < BM) {
                __builtin_amdgcn_fence(__ATOMIC_ACQUIRE, "agent");
                const float* pp = ssp + (size_t)(u.pm * BM + tid) * 16; float t = 0.f;
                for (int j = 0; j < ntn; ++j) t += __hip_atomic_load(pp + j, __ATOMIC_RELAXED, __HIP_MEMORY_SCOPE_AGENT);
                ssq[u.pm * BM + tid] = t; }
        }
    }
};

template <class Epi, class Sched, bool ALIGN_EPI = false, bool SP2 = false, bool TILED = false>
__device__ __forceinline__ void gemm_phase(PG8_LAS unsigned char* lds, const Gemm g, const Sched& S, const Epi& E, int tid_) {
    asm volatile("" : "+v"(tid_));
    const int tid = tid_, wid = __builtin_amdgcn_readfirstlane(tid >> 6), lane = tid & 63, wr = wid >> 2, wc = wid & 3, fr = lane & 15, fq = lane >> 4;
    const int K = g.K, nt = K / BK; const int RP = TILED ? BK : K;
    unsigned voffA[2], voffB[2];
#pragma unroll
    for (int i = 0; i < 2; ++i) { int R, C; stage_rc(tid * 16 + i * 8192, R, C); const int Rb = Epi::PERM ? ((R & ~31) + perm32(R & 31)) : R;
        voffA[i] = (unsigned)(R * RP + C) * 2u; voffB[i] = (unsigned)(Rb * RP + C) * 2u; }
    const size_t kstepA = TILED ? (size_t)g.M * BK * 2 : (size_t)(BK * 2), kstepB = TILED ? (size_t)g.N * BK * 2 : (size_t)(BK * 2);
    const size_t hstep = (size_t)HALF * RP * 2;
    const size_t tstep = 2 * hstep;
    const unsigned ldsw = (unsigned)wid * 1024u;
    const int aoff = lds_byte(wr * 64 + fr, fq * 8), boff = lds_byte(wc * 32 + fr, fq * 8);
#define PG8_SA(b, h) (((b) * 2 + (h)) * HTB)
#define PG8_SB(b, h) ((4 + (b) * 2 + (h)) * HTB)
#define PG8_STAGE(bufoff, gbase, voff) do { _Pragma("unroll") for (int _i = 0; _i < 2; ++_i) \
        __builtin_amdgcn_global_load_lds((const unsigned*)((const char*)(gbase) + (voff)[_i]), (PG8_LAS unsigned*)(lds + (bufoff) + ldsw + _i * 8192), 16, 0, 0); } while (0)
#define PG8_LDA(dst, b, h) do { _Pragma("unroll") for (int m = 0; m < 4; ++m) _Pragma("unroll") for (int k = 0; k < 2; ++k) dst[m][k] = *(const PG8_LAS bf16x8*)(lds + PG8_SA(b, h) + aoff + m * 2048 + k * 1024); } while (0)
#define PG8_LDB(dst, b, h) do { _Pragma("unroll") for (int n = 0; n < 2; ++n) _Pragma("unroll") for (int k = 0; k < 2; ++k) dst[n][k] = *(const PG8_LAS bf16x8*)(lds + PG8_SB(b, h) + boff + n * 2048 + k * 1024); } while (0)
#define PG8_MMA(ai, bj, At, Bt) do { __builtin_amdgcn_s_setprio(1); _Pragma("unroll") for (int m = 0; m < 4; ++m) _Pragma("unroll") for (int n = 0; n < 2; ++n) _Pragma("unroll") for (int k = 0; k < 2; ++k) \
        acc[ai][bj][m][n] = __builtin_amdgcn_mfma_f32_16x16x32_bf16(Bt[n][k], At[m][k], acc[ai][bj][m][n], 0, 0, 0); __builtin_amdgcn_s_setprio(0); } while (0)
#define PG8_WAIT_V(n) asm volatile("s_waitcnt vmcnt(" #n ")" ::: "memory")
#define PG8_WAIT_L(n) asm volatile("s_waitcnt lgkmcnt(" #n ")" ::: "memory")
#define PG8_BAR __builtin_amdgcn_s_barrier()
#define PG8_SCHED __builtin_amdgcn_sched_barrier(0)
    Unit cur, nxt; int ui = 0;
    if (!S.next(0, cur)) return;
    f32x4 acc[2][2][4][2];
#pragma unroll
    for (int a = 0; a < 2; ++a)
#pragma unroll
        for (int b = 0; b < 2; ++b)
#pragma unroll
            for (int m = 0; m < 4; ++m)
#pragma unroll
                for (int n = 0; n < 2; ++n) acc[a][b][m][n] = (f32x4){0.f, 0.f, 0.f, 0.f};
    bf16x8 At[4][2], B0[2][2], B1[2][2];
    const char* cA = (const char*)g.A + (size_t)cur.pm * tstep; const char* cB = (const char*)g.Bt + (size_t)cur.pn * tstep;
    S.a_ready(cur);
    if constexpr (SP2) {
        PG8_STAGE(PG8_SB(0, 0), cB, voffB); PG8_STAGE(PG8_SB(0, 1), cB + hstep, voffB); PG8_STAGE(PG8_SA(0, 0), cA, voffA); PG8_STAGE(PG8_SA(0, 1), cA + hstep, voffA);
        if (wr == 1) PG8_BAR;
        PG8_WAIT_V(2); PG8_BAR;
        PG8_STAGE(PG8_SB(1, 0), cB + kstepB, voffB); PG8_STAGE(PG8_SA(1, 0), cA + kstepA, voffA); PG8_STAGE(PG8_SB(1, 1), cB + hstep + kstepB, voffB);
        PG8_WAIT_V(6); PG8_BAR;
    } else {
        PG8_STAGE(PG8_SB(0, 0), cB, voffB); PG8_STAGE(PG8_SA(0, 0), cA, voffA); PG8_STAGE(PG8_SB(0, 1), cB + hstep, voffB); PG8_STAGE(PG8_SA(0, 1), cA + hstep, voffA);
        if (wr == 1) PG8_BAR;
        PG8_WAIT_V(4); PG8_BAR;
        PG8_STAGE(PG8_SB(1, 0), cB + kstepB, voffB); PG8_STAGE(PG8_SA(1, 0), cA + kstepA, voffA); PG8_STAGE(PG8_SB(1, 1), cB + hstep + kstepB, voffB);
        PG8_WAIT_V(6); PG8_BAR;
    }
    for (;;) {
        const bool has_next = S.next(ui + 1, nxt);
        const char* nA = has_next ? (const char*)g.A + (size_t)nxt.pm * tstep : cA; const char* nB = has_next ? (const char*)g.Bt + (size_t)nxt.pn * tstep : cB;
        for (int t = 0; t < nt; t += 2) {
            const bool last = (t == nt - 2);
            const char* a1 = cA + (size_t)(t + 1) * kstepA;
            const char* a2 = last ? nA : cA + (size_t)(t + 2) * kstepA; const char* b2 = last ? nB : cB + (size_t)(t + 2) * kstepB;
            const char* a3 = a2 + kstepA; const char* b3 = b2 + kstepB;
            if (last && has_next) S.a_ready(nxt);
            if constexpr (SP2) {
            PG8_LDB(B0, 0, 0); PG8_LDB(B1, 0, 1); PG8_SCHED; PG8_LDA(At, 0, 0); PG8_STAGE(PG8_SA(1, 1), a1 + hstep, voffA);
            PG8_WAIT_V(8); PG8_WAIT_L(0); PG8_BAR; PG8_MMA(0, 0, At, B0); PG8_MMA(0, 1, At, B1); PG8_BAR; PG8_SCHED;
            PG8_LDA(At, 0, 1); PG8_STAGE(PG8_SB(0, 0), b2, voffB); PG8_STAGE(PG8_SB(0, 1), b2 + hstep, voffB); PG8_STAGE(PG8_SA(0, 0), a2, voffA);
            PG8_WAIT_V(8); PG8_WAIT_L(0); PG8_BAR; PG8_MMA(1, 0, At, B0); PG8_MMA(1, 1, At, B1); PG8_BAR; PG8_SCHED;
            PG8_LDB(B0, 1, 0); PG8_LDB(B1, 1, 1); PG8_SCHED; PG8_LDA(At, 1, 0); PG8_STAGE(PG8_SA(0, 1), a2 + hstep, voffA);
            PG8_WAIT_V(8); PG8_WAIT_L(0); PG8_BAR; PG8_MMA(0, 0, At, B0); PG8_MMA(0, 1, At, B1); PG8_BAR; PG8_SCHED;
            PG8_LDA(At, 1, 1); PG8_STAGE(PG8_SB(1, 0), b3, voffB); PG8_STAGE(PG8_SB(1, 1), b3 + hstep, voffB); PG8_STAGE(PG8_SA(1, 0), a3, voffA);
            PG8_WAIT_V(8); PG8_WAIT_L(0); PG8_BAR; PG8_MMA(1, 0, At, B0); PG8_MMA(1, 1, At, B1); PG8_BAR; PG8_SCHED;
            } else {
            PG8_LDB(B0, 0, 0); PG8_SCHED; PG8_LDA(At, 0, 0); PG8_STAGE(PG8_SA(1, 1), a1 + hstep, voffA);
            PG8_WAIT_L(8); PG8_BAR; PG8_WAIT_L(0); PG8_MMA(0, 0, At, B0); PG8_BAR; PG8_SCHED;
            PG8_LDB(B1, 0, 1); PG8_STAGE(PG8_SB(0, 0), b2, voffB);
            PG8_BAR; PG8_WAIT_L(0); PG8_MMA(0, 1, At, B1); PG8_BAR;
            PG8_LDA(At, 0, 1); PG8_STAGE(PG8_SA(0, 0), a2, voffA);
            PG8_BAR; PG8_WAIT_L(0); PG8_MMA(1, 0, At, B0); PG8_BAR; PG8_SCHED;
            PG8_STAGE(PG8_SB(0, 1), b2 + hstep, voffB);
            PG8_WAIT_V(6); PG8_BAR; PG8_MMA(1, 1, At, B1); PG8_BAR;
            PG8_LDB(B0, 1, 0); PG8_SCHED; PG8_LDA(At, 1, 0); PG8_STAGE(PG8_SA(0, 1), a2 + hstep, voffA);
            PG8_WAIT_L(8); PG8_BAR; PG8_WAIT_L(0); PG8_MMA(0, 0, At, B0); PG8_BAR; PG8_SCHED;
            PG8_LDB(B1, 1, 1); PG8_STAGE(PG8_SB(1, 0), b3, voffB);
            PG8_BAR; PG8_WAIT_L(0); PG8_MMA(0, 1, At, B1); PG8_BAR;
            PG8_LDA(At, 1, 1); PG8_STAGE(PG8_SA(1, 0), a3, voffA);
            PG8_BAR; PG8_WAIT_L(0); PG8_MMA(1, 0, At, B0); PG8_BAR; PG8_SCHED;
            PG8_STAGE(PG8_SB(1, 1), b3 + hstep, voffB);
            PG8_WAIT_V(6); PG8_BAR; PG8_MMA(1, 1, At, B1); PG8_BAR;
            }
        }
        if constexpr (ALIGN_EPI) { if (wr == 0) PG8_BAR; }
        if constexpr (!Epi::AFTER_DRAIN) { E(acc, cur, wr, wc, fr, fq); S.done(cur); }
        if (!has_next) break;
#pragma unroll
        for (int a = 0; a < 2; ++a)
#pragma unroll
            for (int b = 0; b < 2; ++b)
#pragma unroll
                for (int m = 0; m < 4; ++m)
#pragma unroll
                    for (int n = 0; n < 2; ++n) acc[a][b][m][n] = (f32x4){0.f, 0.f, 0.f, 0.f};
        cur = nxt; cA = nA; cB = nB; ++ui;
        if constexpr (ALIGN_EPI) { if (wr == 1) PG8_BAR; }
    }
    PG8_WAIT_V(0);
    if constexpr (!ALIGN_EPI) { if (wr == 0) PG8_BAR; }
    PG8_BAR;
    if constexpr (Epi::AFTER_DRAIN) { E.fused(acc, cur, wr, wc, fr, fq, lds, wid, lane); S.done(cur); }
#undef PG8_SA
#undef PG8_SB
#undef PG8_STAGE
#undef PG8_LDA
#undef PG8_LDB
#undef PG8_MMA
#undef PG8_WAIT_V
#undef PG8_WAIT_L
#undef PG8_BAR
#undef PG8_SCHED
}
}
#ifndef MK_N_LAUNCHES
#define MK_N_LAUNCHES 1
#endif
constexpr int NWAVES = 8;
#ifndef MK_REP_PHASE
#define MK_REP_PHASE -1
#endif
#define REPS(k) (((k) == MK_REP_PHASE) ? 2 : 1)
#ifndef MK_TIME_PHASE
#define MK_TIME_PHASE -1
#endif
constexpr int BATCH = 2, SEQ = 4096, DM = 4096, M = BATCH * SEQ, DEPTH = 2;
constexpr int HD = 128, NH_M = 12, NH_F = 12, NH_D = 4;
constexpr int INW = 12300;
constexpr int PW = 12288;
constexpr int FF = 11008, NGU = 2 * FF;
constexpr int C_QM = 0, C_KM = 1536, C_VM = 3072, C_QF = 4608, C_KF = 6144, C_VF = 7680, C_QD = 9216, C_KD = 10240, C_VD = 11264;
constexpr int NBLK = SEQ / 256;
constexpr int T3A_ROWS = 16, KSUB = 256 / T3A_ROWS;
constexpr float NORM_EPS = 1e-6f;
constexpr int NATT = 40;
constexpr int NPH = 1 + 8 * DEPTH;
constexpr size_t MiB = 1u << 20;
constexpr size_t WS_CTL = 0, CTL_ZERO_BYTES = 1 * MiB;
constexpr size_t WS_ROPE = 1 * MiB;
constexpr size_t WS_WF = 3 * MiB;
constexpr size_t WS_LOGF = 4 * MiB;
constexpr size_t WS_BRAW = 5 * MiB;
constexpr size_t WS_SELM = 6 * MiB;
constexpr size_t WS_SSP = 9 * MiB;
constexpr size_t WS_KPART = 10 * MiB + 512 * 1024;
constexpr size_t WS_WIN = 16 * MiB;
constexpr size_t WS_WOUT = 208 * MiB;
constexpr size_t WS_WGU = 272 * MiB;
constexpr size_t WS_WD = 616 * MiB;
constexpr size_t WS_XN = 788 * MiB;
constexpr size_t WS_PROJ = 852 * MiB;
constexpr size_t WS_HB = 852 * MiB;
constexpr size_t WS_MIX = 1044 * MiB;
constexpr size_t WS_DIFF = 1108 * MiB;
constexpr size_t WS_XB = 1140 * MiB;
constexpr size_t WS_END = 1268 * MiB;
static_assert(WS_WIN + (size_t)DEPTH * PW * DM * 2 <= WS_WOUT && WS_WOUT + (size_t)DEPTH * DM * DM * 2 <= WS_WGU && WS_WGU + (size_t)DEPTH * NGU * DM * 2 <= WS_WD && WS_WD + (size_t)DEPTH * DM * FF * 2 <= WS_XN, "ws map (weights)");
static_assert(WS_XN + (size_t)M * DM * 2 <= WS_PROJ && WS_PROJ + (size_t)M * PW * 2 <= WS_MIX && WS_HB + (size_t)M * FF * 2 <= WS_MIX && WS_MIX + (size_t)M * DM * 2 <= WS_DIFF && WS_DIFF + (size_t)2 * M * 1024 * 2 <= WS_XB && WS_XB + (size_t)M * DM * 4 <= WS_END, "ws map (activations)");
constexpr int CW_TMO = 0, CW_CODE = 1, CW_BAR = 4096;
constexpr int CW_SSQ = 16384;
constexpr int CW_PCNT = 65536;
constexpr int CW_CONV = 98304;
constexpr int CW_ATTQ = 8192;
constexpr int RING_OFF = 0, RING_BYTES = 131072;
constexpr int LDSCTL_OFF = RING_BYTES, MISC_OFF = LDSCTL_OFF + 320;
constexpr int XL_OFF = RING_BYTES + 4096;
constexpr int LDS_BYTES = 147456;

#define GAS __attribute__((address_space(1)))
#define LAS __attribute__((address_space(3)))
typedef unsigned short bf16;
typedef unsigned v4u __attribute__((ext_vector_type(4)));
typedef unsigned v2u __attribute__((ext_vector_type(2)));
typedef float f32x4 __attribute__((ext_vector_type(4)));
typedef float f32x2 __attribute__((ext_vector_type(2)));
typedef short bf16x8 __attribute__((ext_vector_type(8)));
typedef GAS unsigned gu32;
#define RLX_AGENT __ATOMIC_RELAXED, __HIP_MEMORY_SCOPE_AGENT
#define LDS_WAIT() asm volatile("s_waitcnt lgkmcnt(0)" ::: "memory")
#define VM_WAIT() asm volatile("s_waitcnt vmcnt(0)" ::: "memory")
__device__ __forceinline__ unsigned f2bf(float f) { unsigned u = __builtin_bit_cast(unsigned, f); return (u + 0x7fffu + ((u >> 16) & 1u)) >> 16; }
__device__ __forceinline__ unsigned pk2(float lo, float hi) { return f2bf(lo) | (f2bf(hi) << 16); }
__device__ __forceinline__ float bflo(unsigned w) { return __uint_as_float(w << 16); }
__device__ __forceinline__ float bfhi(unsigned w) { return __uint_as_float(w & 0xffff0000u); }
__device__ __forceinline__ float bf2f(bf16 b) { return __uint_as_float((unsigned)b << 16); }
__device__ __forceinline__ float shx(float v, int o, int lane) { return __int_as_float(__builtin_amdgcn_ds_bpermute((lane ^ o) << 2, __float_as_int(v))); }
__device__ __forceinline__ float wave_sum(float v, int lane) {
#pragma unroll
    for (int o = 1; o < 64; o <<= 1) v += shx(v, o, lane);
    return v;
}
__device__ __forceinline__ float wave_max(float v, int lane) {
#pragma unroll
    for (int o = 1; o < 64; o <<= 1) v = fmaxf(v, shx(v, o, lane));
    return v;
}
__device__ __forceinline__ float dpp_xor1(float v) { return __int_as_float(__builtin_amdgcn_mov_dpp(__float_as_int(v), 0xB1, 0xf, 0xf, true)); }
__device__ __forceinline__ int fresh_tid(int wave0) { int lane; asm volatile("v_mbcnt_lo_u32_b32 %0, -1, 0\n\tv_mbcnt_hi_u32_b32 %0, -1, %0" : "=v"(lane)); return wave0 * 64 + lane; }
#define FRESH_IDS(vcu_) const int tid = fresh_tid(wave0); const int lane = tid & 63, wave = wave0; const int gw = (vcu_) * NWAVES + wave; (void)gw; (void)lane; (void)wave; (void)tid

#define XB_TMO      128
#define XB_XCNT(j)  (256  + 64 * (j))
#define XB_XSUB(j)  (1280 + 64 * (j))
#define XB_XGEN(j)  (2304 + 64 * (j))
#define XB_TOP      3328
#define XB_TOPGEN   3392
#define XCD_BAR_WORDS 3456
#define XB_SPIN_CAP (1u << 18)

__device__ __forceinline__ unsigned xb_ld(unsigned* p)              { return __hip_atomic_load(p, __ATOMIC_RELAXED, __HIP_MEMORY_SCOPE_AGENT); }
__device__ __forceinline__ unsigned xb_add(unsigned* p, unsigned v) { return __hip_atomic_fetch_add(p, v, __ATOMIC_RELAXED, __HIP_MEMORY_SCOPE_AGENT); }
__device__ __forceinline__ unsigned xb_xcc_id() { return (unsigned)__builtin_amdgcn_s_getreg((3 << 11) | 20) & 0xFu; }
#define XB_SPIN(cond, bar) do { unsigned _sp = 0; while (cond) { __builtin_amdgcn_s_sleep(1); \
    if ((++_sp & 255u) == 0u) { if (xb_ld(&(bar)[XB_TMO])) break; if (_sp > XB_SPIN_CAP) { atomicAdd(&(bar)[XB_TMO], 1u); break; } } } } while (0)

struct XcdBarrier {
    unsigned* bar; unsigned x;
    volatile LAS unsigned* st;
};

__device__ __forceinline__ XcdBarrier xcd_barrier_post(unsigned* bar, volatile LAS unsigned* st) {
    XcdBarrier b; b.bar = bar; b.x = xb_xcc_id(); b.st = st;
    if (threadIdx.x == 0) (void)xb_add(&bar[XB_XCNT(b.x)], 1u);
    return b;
}
__device__ __forceinline__ void xcd_barrier_complete(unsigned* bar, unsigned x, unsigned& nloc, unsigned& nx) {
    const unsigned G = gridDim.x * gridDim.y * gridDim.z;
    unsigned sum, cnt, mine, sp = 0u;
    for (;;) {
        sum = 0u; cnt = 0u; mine = 0u;
#pragma unroll
        for (unsigned j = 0; j < 16; ++j) { const unsigned c = xb_ld(&bar[XB_XCNT(j)]); sum += c; cnt += (c > 0u) ? 1u : 0u; mine = (j == x) ? c : mine; }
        if (sum == G) break;
        __builtin_amdgcn_s_sleep(1);
        if ((++sp & 255u) == 0u) { if (xb_ld(&bar[XB_TMO])) break; if (sp > XB_SPIN_CAP) { atomicAdd(&bar[XB_TMO], 1u); break; } }
    }
    nloc = mine > 0u ? mine : 1u; nx = cnt > 0u ? cnt : 1u;
}

__device__ __forceinline__ void xcd_barrier(const XcdBarrier& b) {
    asm volatile("s_waitcnt vmcnt(0)" ::: "memory");
    __syncthreads();
    if (threadIdx.x == 0) {
        unsigned* bar = b.bar;
        __builtin_amdgcn_s_waitcnt(0);
        unsigned nloc = b.st[0], nx = b.st[1];
        if (nloc == 0u) { xcd_barrier_complete(bar, b.x, nloc, nx); b.st[0] = nloc; b.st[1] = nx; }
        const unsigned old = xb_add(&bar[XB_XSUB(b.x)], 1u);
        const unsigned gen = old / nloc;
        if (old + 1u == (gen + 1u) * nloc) {
            __builtin_amdgcn_fence(__ATOMIC_RELEASE, "agent");
            asm volatile("s_waitcnt vmcnt(0)" ::: "memory");
            const unsigned og = xb_add(&bar[XB_TOP], 1u);
            const unsigned tg = og / nx;
            if (og + 1u == (tg + 1u) * nx) xb_add(&bar[XB_TOPGEN], 1u);
            else XB_SPIN(xb_ld(&bar[XB_TOPGEN]) == tg, bar);
            __builtin_amdgcn_fence(__ATOMIC_ACQUIRE, "agent");
            xb_add(&bar[XB_XGEN(b.x)], 1u);
            asm volatile("s_waitcnt vmcnt(0)" ::: "memory");
        } else {
            XB_SPIN(xb_ld(&bar[XB_XGEN(b.x)]) == gen, bar);
            __builtin_amdgcn_fence(__ATOMIC_ACQUIRE, "agent");
            asm volatile("s_waitcnt vmcnt(0)" ::: "memory");
        }
    }
    __syncthreads();
}


namespace att {
typedef short s16x4 __attribute__((ext_vector_type(4)));
typedef float f32x16 __attribute__((ext_vector_type(16)));
typedef unsigned u32x4 __attribute__((ext_vector_type(4)));
constexpr int NW = 8, QBLK = 32, KVBLK = 64, QB = NW * QBLK, D = 128;
constexpr int SHM_V = KVBLK * D * 2, SHM_K = KVBLK * D * 2;
constexpr int OFF_WS = 2 * SHM_V + 2 * SHM_K, OFF_BIAS = OFF_WS + NW * 64 * 4, OFF_NXT = OFF_BIAS + SEQ * 4, OFF_WT = OFF_NXT + 16, LDS_BYTES = OFF_WT + 64;
constexpr int QITEMS = (BATCH * NATT / 8) * (SEQ / QB);
constexpr float SCALE = 0.08838834764831845f, THR = 8.f;
constexpr int PITCH = PW;
#define KSWZ(row, colB) ((row) * 256 + ((colB) ^ (((row) & 7) << 4)))
#define SBAR() __builtin_amdgcn_sched_barrier(0)
__device__ __forceinline__ int v_st(int k, int c) { const int kk = (k & ~0xC) | ((k & 4) << 1) | ((k & 8) >> 1); return ((kk >> 3) * 4 + (c >> 5)) * 512 + ((kk & 7) * 32 + (c & 31)) * 2; }
__device__ __forceinline__ int v_rd_base(int lane) { return ((lane & 3) << 3) | (((lane >> 2) & 3) << 6) | (((lane >> 4) & 1) << 5) | (((lane >> 5) & 1) << 8); }
constexpr int v_rd_off(int d0, int ks, int half) { return d0 * 512 + ks * 4096 + half * 2048; }
__device__ __forceinline__ int crow(int r, int hi) { return (r & 3) + 8 * (r >> 2) + 4 * hi; }
__device__ __forceinline__ unsigned cvtpk(float lo, float hi) { unsigned r; asm volatile("v_cvt_pk_bf16_f32 %0, %1, %2" : "=v"(r) : "v"(lo), "v"(hi)); return r; }
__device__ __forceinline__ bf16x8 load8(const bf16* p) { return *reinterpret_cast<const bf16x8*>(p); }
__device__ __forceinline__ void mask_tile(f32x16& p0, f32x16& p1, int dq) {
    const float NEG = -__builtin_inff();
#pragma unroll
    for (int r = 0; r < 16; ++r) { const int c = (r & 3) + 8 * (r >> 2); if (dq - c < 0) p0[r] = NEG; if (dq - c - 32 < 0) p1[r] = NEG; }
}
__device__ __forceinline__ void partialSM(f32x16& p0, f32x16& p1, float& m_reg, float& mn, float& alpha) {
    float pmax = p0[0];
#pragma unroll
    for (int r = 1; r < 16; ++r) pmax = fmaxf(pmax, p0[r]);
#pragma unroll
    for (int r = 0; r < 16; ++r) pmax = fmaxf(pmax, p1[r]);
    { auto rr = __builtin_amdgcn_permlane32_swap(__float_as_uint(pmax), __float_as_uint(pmax), false, false); pmax = fmaxf(__uint_as_float(rr[0]), __uint_as_float(rr[1])); }
    constexpr float C2 = 1.4426950408889634f * SCALE;
    if (__builtin_expect(__all((pmax - m_reg) * SCALE <= THR), 1)) { mn = m_reg; alpha = 1.f; }
    else { mn = fmaxf(m_reg, pmax); alpha = __builtin_amdgcn_exp2f((m_reg - mn) * C2); m_reg = mn; }
    const float mnL = -mn * C2;
#pragma unroll
    for (int r = 0; r < 16; ++r) p0[r] = fmaf(p0[r], C2, mnL);
#pragma unroll
    for (int r = 0; r < 16; ++r) p1[r] = fmaf(p1[r], C2, mnL);
#pragma unroll
    for (int r = 0; r < 16; ++r) p0[r] = __builtin_amdgcn_exp2f(p0[r]);
}
__device__ __forceinline__ void finishSM(f32x16& p0, f32x16& p1, float alpha, float& l_reg, bf16x8& pa0, bf16x8& pa1, bf16x8& pa2, bf16x8& pa3) {
#pragma unroll
    for (int r = 0; r < 16; ++r) p1[r] = __builtin_amdgcn_exp2f(p1[r]);
    float ps = 0;
#pragma unroll
    for (int r = 0; r < 16; ++r) ps += p0[r];
#pragma unroll
    for (int r = 0; r < 16; ++r) ps += p1[r];
    { auto rr = __builtin_amdgcn_permlane32_swap(__float_as_uint(ps), __float_as_uint(ps), false, false); ps = __uint_as_float(rr[0]) + __uint_as_float(rr[1]); }
    l_reg = l_reg * alpha + ps;
#define PK4(P, B_, OUT) do { unsigned a0 = cvtpk(P[B_+0], P[B_+1]), a1 = cvtpk(P[B_+2], P[B_+3]);                          \
        unsigned b0 = cvtpk(P[B_+4], P[B_+5]), b1 = cvtpk(P[B_+6], P[B_+7]);                                             \
        auto r0 = __builtin_amdgcn_permlane32_swap(a0, b0, false, false); auto r1 = __builtin_amdgcn_permlane32_swap(a1, b1, false, false); \
        u32x4 w = {r0[0], r1[0], r0[1], r1[1]}; OUT = *reinterpret_cast<bf16x8*>(&w); } while (0)
    PK4(p0, 0, pa0); PK4(p0, 8, pa1); PK4(p1, 0, pa2); PK4(p1, 8, pa3);
#undef PK4
}
template <int KB>
__device__ __forceinline__ void qkt(f32x16& p0, f32x16& p1, const char* K_lds, int r32, int hi, const bf16x8* qr, const float* bt, float rowinit) {
    if (bt) { const f32x4* bp = (const f32x4*)(bt + 4 * hi);
#pragma unroll
        for (int g = 0; g < 4; ++g) { const f32x4 a = bp[2 * g], b = bp[2 * g + 8];
            p0[4 * g] = a[0]; p0[4 * g + 1] = a[1]; p0[4 * g + 2] = a[2]; p0[4 * g + 3] = a[3]; p1[4 * g] = b[0]; p1[4 * g + 1] = b[1]; p1[4 * g + 2] = b[2]; p1[4 * g + 3] = b[3]; } }
    else {
#pragma unroll
        for (int r = 0; r < 16; ++r) { p0[r] = rowinit; p1[r] = rowinit; } }
    const char* kb[4];
#pragma unroll
    for (int dd = 0; dd < 4; ++dd) kb[dd] = K_lds + KB * SHM_K + KSWZ(r32, (dd * 16 + hi * 8) * 2);
#pragma unroll
    for (int d0 = 0; d0 < 8; ++d0) { const char* a = kb[d0 & 3] + (d0 >> 2) * 128;
        bf16x8 b0 = *reinterpret_cast<const bf16x8*>(a);
        bf16x8 b1 = *reinterpret_cast<const bf16x8*>(a + 32 * 256);
        p0 = __builtin_amdgcn_mfma_f32_32x32x16_bf16(b0, qr[d0], p0, 0, 0, 0);
        p1 = __builtin_amdgcn_mfma_f32_32x32x16_bf16(b1, qr[d0], p1, 0, 0, 0); }
}
template <int VB>
__device__ __forceinline__ void pv_tile(f32x16* o, int vb0, bf16x8 pa0, bf16x8 pa1, bf16x8 pa2, bf16x8 pa3) {
#define TRRD(dst, off) asm volatile("ds_read_b64_tr_b16 %0, %1 offset:%2" : "=&v"(dst) : "v"(vb0), "i"(off) : "memory")
#define PV_D0(d0) do { s16x4 l0, l1, l2, l3, h0, h1, h2, h3; constexpr int b_ = VB * SHM_V + v_rd_off(d0, 0, 0); \
        TRRD(l0, b_); TRRD(h0, b_ + 2048); TRRD(l1, b_ + 4096); TRRD(h1, b_ + 6144); TRRD(l2, b_ + 8192); TRRD(h2, b_ + 10240); TRRD(l3, b_ + 12288); TRRD(h3, b_ + 14336); \
        asm volatile("s_waitcnt lgkmcnt(0)" ::: "memory"); SBAR();   \
        o[d0] = __builtin_amdgcn_mfma_f32_32x32x16_bf16(pa0, (bf16x8){l0[0], l0[1], l0[2], l0[3], h0[0], h0[1], h0[2], h0[3]}, o[d0], 0, 0, 0);   \
        o[d0] = __builtin_amdgcn_mfma_f32_32x32x16_bf16(pa1, (bf16x8){l1[0], l1[1], l1[2], l1[3], h1[0], h1[1], h1[2], h1[3]}, o[d0], 0, 0, 0);   \
        o[d0] = __builtin_amdgcn_mfma_f32_32x32x16_bf16(pa2, (bf16x8){l2[0], l2[1], l2[2], l2[3], h2[0], h2[1], h2[2], h2[3]}, o[d0], 0, 0, 0);   \
        o[d0] = __builtin_amdgcn_mfma_f32_32x32x16_bf16(pa3, (bf16x8){l3[0], l3[1], l3[2], l3[3], h3[0], h3[1], h3[2], h3[3]}, o[d0], 0, 0, 0); } while (0)
    PV_D0(0); PV_D0(1); PV_D0(2); PV_D0(3);
#undef PV_D0
#undef TRRD
}
struct BlockRef { int bh, qb; };
struct HeadCols { int qcol, kcol, vcol, type, ocol, opitch, ohstep; size_t obase_off; };
__device__ __forceinline__ HeadCols head_cols(int hidx) {
    HeadCols d;
    if (hidx < 12) { d.type = 0; d.qcol = C_QM + hidx * HD; d.kcol = C_KM + hidx * HD; d.vcol = C_VM + hidx * HD; d.obase_off = WS_MIX + (size_t)((hidx * HD) >> 6) * M * 64 * 2; d.opitch = 64; d.ohstep = M * 64; d.ocol = 0; }
    else if (hidx < 24) { const int h = hidx - 12; d.type = 1; d.qcol = C_QF + h * HD; d.kcol = C_KF + h * HD; d.vcol = C_VF + h * HD; d.obase_off = WS_MIX + (size_t)((1536 + h * HD) >> 6) * M * 64 * 2; d.opitch = 64; d.ohstep = M * 64; d.ocol = 0; }
    else { const int x = hidx - 24, h = x >> 2, mp = (x >> 1) & 1, e = x & 1; d.type = 2; d.qcol = C_QD + h * 256 + mp * HD; d.kcol = C_KD + h * 256 + mp * HD; d.vcol = C_VD + h * 256 + e * HD;
        d.obase_off = WS_DIFF + (size_t)mp * M * 1024 * 2; d.opitch = 1024; d.ohstep = 64; d.ocol = h * 256 + e * HD; }
    return d;
}
#define LAUNDER_S(x) asm volatile("" : "+s"(x))
__device__ const unsigned char Q_ORDER[160] = {15,31,47,111,127,143,159,14,30,46,110,126,142,158,13,29,45,109,125,141,157,12,28,44,108,124,140,156,11,27,43,107,123,139,155,10,26,42,106,122,138,154,9,25,41,105,121,137,153,8,24,40,104,120,136,152,7,23,39,103,119,135,151,63,79,95,6,22,38,102,118,134,150,62,78,94,61,77,93,5,21,37,101,117,133,149,60,76,92,59,75,91,4,20,36,100,116,132,148,58,74,90,57,73,89,56,72,88,3,19,35,99,115,131,147,55,71,87,54,70,86,2,18,34,98,114,130,146,53,69,85,52,68,84,1,17,33,97,113,129,145,51,67,83,50,66,82,0,16,32,96,112,128,144,49,65,81,48,64,80};
__device__ __forceinline__ BlockRef q_item(int qx, int k) { const int e = __builtin_amdgcn_readfirstlane((int)Q_ORDER[k]), ui = e >> 4, q4 = qx & 3; BlockRef r;
    const int hidx = ui < 3 ? 3 * q4 + ui : (ui < 6 ? 12 + 3 * q4 + (ui - 3) : 24 + 4 * q4 + (ui - 6));
    r.bh = (qx >> 2) * NATT + hidx; r.qb = e & 15; return r; }
struct Seam { bf16x8 qr[8]; bf16x8 st_v0, st_v1, st_k0, st_k1; };
#define ROW(p, k0, rr) ((p) + (size_t)((k0) + (rr)) * PITCH + sc)
#define VMW() asm volatile("s_waitcnt vmcnt(0)" ::: "memory")
#define VMWN(n) asm volatile("s_waitcnt vmcnt(%0)" :: "i"(n) : "memory")
#define SLOAD_H(Kp, Vp, k0) do { S.st_v0 = load8(ROW(Vp, k0, sr)); S.st_v1 = load8(ROW(Vp, k0, 32 + sr)); S.st_k0 = load8(ROW(Kp, k0, sr)); S.st_k1 = load8(ROW(Kp, k0, 32 + sr)); } while (0)
#define SWRITE_HK(bf) do { *(bf16x8*)(K_lds + (bf) * SHM_K + kws) = S.st_k0; *(bf16x8*)(K_lds + (bf) * SHM_K + kws + 32 * 256) = S.st_k1; } while (0)
#define SWRITE_HV(bf) do { *(bf16x8*)(V_lds + (bf) * SHM_V + vst0) = S.st_v0; *(bf16x8*)(V_lds + (bf) * SHM_V + vst1) = S.st_v1; } while (0)
#define SWRITE_H(bf) do { SWRITE_HV(bf); SWRITE_HK(bf); } while (0)
__device__ __forceinline__ void prime(BlockRef cur, unsigned char* wsb, char* lds, Seam& S, int tid) {
    const int wid = __builtin_amdgcn_readfirstlane(tid >> 6), lane = tid & 63, r32 = lane & 31, hi = lane >> 5;
    const int sr = tid >> 4, sc = (tid & 15) * 8, kws = KSWZ(sr, sc * 2); char* K_lds = lds + 2 * SHM_V;
    const int b = cur.bh / NATT; const HeadCols hc = head_cols(cur.bh - b * NATT);
    const bf16* PROJ = (const bf16*)(wsb + WS_PROJ); const size_t rowb = (size_t)b * SEQ;
    const bf16* Qp = PROJ + (rowb + (size_t)cur.qb * QB) * PITCH + hc.qcol; const bf16* Kp = PROJ + rowb * PITCH + hc.kcol; const bf16* Vp = PROJ + rowb * PITCH + hc.vcol;
#pragma unroll
    for (int d0 = 0; d0 < 8; ++d0) S.qr[d0] = load8(Qp + (size_t)(wid * QBLK + r32) * PITCH + d0 * 16 + hi * 8);
    SLOAD_H(Kp, Vp, cur.qb * QB + QB - KVBLK); VMW(); SWRITE_HK(0);
    __syncthreads();
}
__device__ __forceinline__ int block(BlockRef cur, unsigned* qctr, int qx, unsigned char* wsb, char* lds, Seam& S, int tid, float fox_thr) {
    const int wid = __builtin_amdgcn_readfirstlane(tid >> 6), lane = tid & 63, r32 = lane & 31, hi = lane >> 5;
    const int P0 = cur.qb * QB;
    const int NT = (P0 + QB) / KVBLK;
    int NS = NT;
    const int qlo = P0 + wid * QBLK, qm = qlo + r32 - 4 * hi;
    char* V_lds = lds; char* K_lds = lds + 2 * SHM_V;
    float* ws = (float*)(lds + OFF_WS) + wid * 64; float* li_l = ws, * al_l = ws + 32;
    float* blds = (float*)(lds + OFF_BIAS);
    float m_reg = -1e30f, l_reg = 0; f32x16 o[4] = {};
    const int sr = tid >> 4, sc = (tid & 15) * 8, vst0 = v_st(sr, sc), vst1 = v_st(32 + sr, sc), kws = KSWZ(sr, sc * 2);
    const int vb0 = (int)(uintptr_t)V_lds + v_rd_base(lane);
    const int cb = cur.bh / NATT, chx = cur.bh - cb * NATT; const HeadCols hc = head_cols(chx);
    const bf16* Kh = (const bf16*)(wsb + WS_PROJ) + (size_t)cb * SEQ * PITCH + hc.kcol; const bf16* Vh = (const bf16*)(wsb + WS_PROJ) + (size_t)cb * SEQ * PITCH + hc.vcol;
    const bool hb = hc.type == 1;
    unsigned nfetch = 0u; if (tid == 0) nfetch = __hip_atomic_fetch_add(qctr, 1u, __ATOMIC_RELAXED, __HIP_MEMORY_SCOPE_AGENT);
    unsigned selm = 0xffffffffu;
    int tid_h = tid; asm volatile("" : "+v"(tid_h)); const int lane_h = tid_h & 63;
    unsigned char* wsh = wsb; asm volatile("" : "+s"(wsh));
    if (hc.type == 0) {
        const int j = cur.qb; selm = 1u << j;
        if (j > 0) {
            const float* kp = (const float*)(wsh + WS_KPART) + (size_t)(cb * 12 + chx) * NBLK * KSUB * HD;
            for (int idx = tid_h; idx < j * HD; idx += NW * 64) { const int n = idx >> 7, d = idx & 127; const float* q_ = kp + (size_t)n * KSUB * HD + d; float a = 0.f;
#pragma unroll
                for (int sub = 0; sub < KSUB; ++sub) a += q_[sub * HD];
                blds[idx] = a * (1.0f / 256.0f); }
            __syncthreads();
            float b0 = -__builtin_inff(), b1 = b0, b2 = b0; int i0 = -1, i1 = -1, i2 = -1;
            for (int n = 0; n < j; ++n) { const float* km = blds + n * HD + 8 * (lane_h >> 5); float a = 0.f;
#pragma unroll
                for (int d0 = 0; d0 < 8; ++d0) { const f32x4 k0 = *(const f32x4*)(km + 16 * d0), k1 = *(const f32x4*)(km + 16 * d0 + 4); const bf16x8 qv = S.qr[d0];
                    a += bf2f((bf16)qv[0]) * k0[0] + bf2f((bf16)qv[1]) * k0[1] + bf2f((bf16)qv[2]) * k0[2] + bf2f((bf16)qv[3]) * k0[3] + bf2f((bf16)qv[4]) * k1[0] + bf2f((bf16)qv[5]) * k1[1] + bf2f((bf16)qv[6]) * k1[2] + bf2f((bf16)qv[7]) * k1[3]; }
                { auto rr = __builtin_amdgcn_permlane32_swap(__float_as_uint(a), __float_as_uint(a), false, false); a = __uint_as_float(rr[0]) + __uint_as_float(rr[1]); }
                if (a > b0) { b2 = b1; i2 = i1; b1 = b0; i1 = i0; b0 = a; i0 = n; } else if (a > b1) { b2 = b1; i2 = i1; b1 = a; i1 = n; } else if (a > b2) { b2 = a; i2 = n; } }
            if (i0 >= 0) selm |= 1u << i0; if (i1 >= 0) selm |= 1u << i1; if (i2 >= 0) selm |= 1u << i2;
        }
    }
    if (hb) { const float* lf = (const float*)(wsh + WS_LOGF) + (size_t)(cb * 12 + (chx - 12)) * SEQ; const int nk = P0 + QB;
        float v[8]; float tot = 0.f; const bool act = tid_h * 8 < nk;
        if (act) { const f32x4 a = *(const f32x4*)(lf + 8 * tid_h), b = *(const f32x4*)(lf + 8 * tid_h + 4);
            v[0] = a[0]; v[1] = v[0] + a[1]; v[2] = v[1] + a[2]; v[3] = v[2] + a[3]; v[4] = v[3] + b[0]; v[5] = v[4] + b[1]; v[6] = v[5] + b[2]; v[7] = v[6] + b[3]; tot = v[7]; }
        else {
#pragma unroll
            for (int i = 0; i < 8; ++i) v[i] = 0.f; }
        float inc = tot;
#pragma unroll
        for (int o_ = 1; o_ < 64; o_ <<= 1) { const float t_ = __int_as_float(__builtin_amdgcn_ds_bpermute((lane_h >= o_ ? lane_h - o_ : lane_h) << 2, __float_as_int(inc))); if (lane_h >= o_) inc += t_; }
        float* wt = (float*)(lds + OFF_WT);
        if (lane_h == 63) wt[wid] = inc;
        __syncthreads();
        float off = inc - tot;
        for (int w_ = 0; w_ < wid; ++w_) off += wt[w_];
        if (act) { f32x4 a, b; a[0] = (off + v[0]) * -11.313708498984761f; a[1] = (off + v[1]) * -11.313708498984761f; a[2] = (off + v[2]) * -11.313708498984761f; a[3] = (off + v[3]) * -11.313708498984761f;
            b[0] = (off + v[4]) * -11.313708498984761f; b[1] = (off + v[5]) * -11.313708498984761f; b[2] = (off + v[6]) * -11.313708498984761f; b[3] = (off + v[7]) * -11.313708498984761f;
            *(f32x4*)(blds + 8 * tid_h) = a; *(f32x4*)(blds + 8 * tid_h + 4) = b; }
        __syncthreads();
        if (wid == 0) { const float thr = fox_thr;
            const int ti = NT - 1 - lane_h; bool dead = false;
            if (lane_h >= 4 && ti >= 0) dead = (blds[P0] - blds[64 * ti + 63]) > thr;
            const unsigned long long bm = __ballot(dead);
            int ns = NT; if (bm != 0ull) { ns = __builtin_ctzll(bm); ns = (ns + 1) & ~1; if (ns > NT) ns = NT; }
            if (lane_h == 0) *(volatile int*)(lds + OFF_WT + 32) = ns; }
        __syncthreads();
        NS = __builtin_amdgcn_readfirstlane(*(volatile int*)(lds + OFF_WT + 32)); }
#define RESC(a) do { if (__any((a) < 1.f)) { if (hi == 0) al_l[r32] = (a); asm volatile("s_waitcnt lgkmcnt(0)" ::: "memory");              \
                     for (int d_ = 0; d_ < 4; ++d_) for (int r = 0; r < 16; ++r) o[d_][r] *= al_l[crow(r, hi)]; } } while (0)
#define KBASE(i) ((NT - 1 - (i)) * KVBLK)
#define BT(i) (hb ? blds + KBASE(i) : (const float*)nullptr)
#define RI(i) ((((selm >> ((NT - 1 - (i)) >> 2)) & 1u) != 0u) ? 0.f : -__builtin_inff())
#define MASKT(P0_, P1_, t) do { const int kb_ = KBASE(t); if (kb_ + KVBLK - 1 > qlo) mask_tile(P0_, P1_, qm - kb_); } while (0)
#define SEAM_K0() do { VMWN(8); SWRITE_HK(0); SBAR(); } while (0)
    f32x16 pA0, pA1, pB0, pB1; float mnA, mnB, alA, alB; bf16x8 pa0, pa1, pa2, pa3;
    SWRITE_HV(0); SBAR();
    SLOAD_H(Kh, Vh, KBASE(1));
    SBAR(); qkt<0>(pA0, pA1, K_lds, r32, hi, S.qr, BT(0), RI(0));
    MASKT(pA0, pA1, 0); partialSM(pA0, pA1, m_reg, mnA, alA);
    VMW(); SWRITE_H(1);
    if (tid == 0) *(volatile unsigned*)(lds + OFF_NXT) = nfetch;
    __syncthreads();
    const int nk = __builtin_amdgcn_readfirstlane((int)*(volatile unsigned*)(lds + OFF_NXT));
#define HALF_STEP(PX0, PX1, mnX, alX, PY0, PY1, alY, t, KB, VB, SB) do {                                                      \
        SBAR(); qkt<KB>(PX0, PX1, K_lds, r32, hi, S.qr, BT(t), RI(t));                                                        \
        finishSM(PY0, PY1, alY, l_reg, pa0, pa1, pa2, pa3); SBAR();                                                           \
        if ((t) + 1 < NS) { SLOAD_H(Kh, Vh, KBASE((t) + 1)); SBAR(); }                                                        \
        pv_tile<VB>(o, vb0, pa0, pa1, pa2, pa3); MASKT(PX0, PX1, (t)); partialSM(PX0, PX1, m_reg, mnX, alX);                  \
        __syncthreads();                                                                                                      \
        if ((t) + 1 < NS) { VMW(); SWRITE_H(SB); }                                                                            \
        RESC(alX); __syncthreads(); } while (0)
    for (int t = 1; t + 1 < NS; t += 2) {
        HALF_STEP(pB0, pB1, mnB, alB, pA0, pA1, alA, t, 1, 0, 0);
        HALF_STEP(pA0, pA1, mnA, alA, pB0, pB1, alB, t + 1, 0, 1, 1);
    }
    SBAR(); qkt<1>(pB0, pB1, K_lds, r32, hi, S.qr, BT(NS - 1), RI(NS - 1)); SBAR();
    { const BlockRef nxt = (nk < QITEMS) ? q_item(qx, nk) : cur; int nbh = nxt.bh, nqb = nxt.qb; LAUNDER_S(nbh); LAUNDER_S(nqb);
      const int nb = nbh / NATT; const HeadCols nh = head_cols(nbh - nb * NATT); const bf16* PROJ = (const bf16*)(wsb + WS_PROJ); const size_t rowb = (size_t)nb * SEQ;
      const bf16* nK = PROJ + rowb * PITCH + nh.kcol; const bf16* nV = PROJ + rowb * PITCH + nh.vcol; const bf16* nQ = PROJ + (rowb + (size_t)nqb * QB) * PITCH + nh.qcol;
      SLOAD_H(nK, nV, nqb * QB + QB - KVBLK); SBAR();
#pragma unroll
      for (int d0 = 0; d0 < 8; ++d0) S.qr[d0] = load8(nQ + (size_t)(wid * QBLK + r32) * PITCH + d0 * 16 + hi * 8); }
    SBAR();
    finishSM(pA0, pA1, alA, l_reg, pa0, pa1, pa2, pa3); SBAR();
    pv_tile<0>(o, vb0, pa0, pa1, pa2, pa3);
    MASKT(pB0, pB1, NS - 1); partialSM(pB0, pB1, m_reg, mnB, alB); __syncthreads(); RESC(alB);
    finishSM(pB0, pB1, alB, l_reg, pa0, pa1, pa2, pa3); SBAR(); pv_tile<1>(o, vb0, pa0, pa1, pa2, pa3);
    SBAR(); SEAM_K0();
    if (hi == 0) li_l[r32] = l_reg; asm volatile("s_waitcnt lgkmcnt(0)" ::: "memory");
    float rli[16];
#pragma unroll
    for (int r = 0; r < 16; ++r) rli[r] = __builtin_amdgcn_rcpf(li_l[crow(r, hi)]);
    { int obh = cur.bh, oqb = cur.qb; LAUNDER_S(obh); LAUNDER_S(oqb);
      const int ob = obh / NATT; const HeadCols oh = head_cols(obh - ob * NATT); const int opitch = oh.opitch, ohstep = oh.ohstep;
      bf16* Ow = (bf16*)(wsb + oh.obase_off) + ((size_t)ob * SEQ + (size_t)oqb * QB + wid * QBLK) * opitch + oh.ocol;
      int hi_e = hi; asm volatile("" : "+v"(hi_e));
      bf16* Ol = Ow + (size_t)(4 * hi_e) * opitch + r32;
#pragma unroll
      for (int r = 0; r < 16; ++r) { const int orow = (r & 3) + 8 * (r >> 2);
#pragma unroll
        for (int d0 = 0; d0 < 4; ++d0) { const float v = o[d0][r] * rli[r]; const float vn = __int_as_float(__builtin_amdgcn_mov_dpp(__float_as_int(v), 0xB1, 0xf, 0xf, true));
            if ((r32 & 1) == 0) *(unsigned*)(Ol + (size_t)orow * opitch + (size_t)(d0 >> 1) * ohstep + (d0 & 1) * 32) = cvtpk(v, vn); } } }
    __syncthreads();
    return nk;
#undef RESC
#undef KBASE
#undef BT
#undef RI
#undef MASKT
#undef SEAM_K0
#undef HALF_STEP
}
#undef ROW
#undef VMW
#undef VMWN
#undef SLOAD_H
#undef SWRITE_HK
#undef SWRITE_HV
#undef SWRITE_H
#undef KSWZ
#undef SBAR
}

struct Args { const float* in[20]; float* out; unsigned char* ws; int ph_lo, ph_hi; };
typedef const __attribute__((address_space(4))) Args* KArgs;
__device__ __forceinline__ KArgs kargs() { KArgs k = (KArgs)__builtin_amdgcn_kernarg_segment_ptr(); asm volatile("" : "+s"(k)); return k; }

__device__ __forceinline__ void p0_prologue(unsigned char* ws, LAS unsigned char* lds, int vcu, int NGW, int wave0, int lsel, int part) {
    FRESH_IDS(vcu);
    KArgs ka = kargs(); const float* in2 = ka->in[2]; const float* in15 = ka->in[15]; const float* in17 = ka->in[17]; const float* in18 = ka->in[18]; const float* in19 = ka->in[19]; const float* gA = ka->in[1]; const float* gF = ka->in[16];
    { constexpr int T_IN = (DM / 64) * (PW / 256), T_OUT = (DM / 64) * (DM / 256), T_G = (DM / 64) * (FF / 256), T_D = (FF / 64) * (DM / 256), T_LAYER = T_IN + T_OUT + 2 * T_G + T_D;
      const int G_ = NGW / NWAVES;
      LAS unsigned char* img = lds + RING_OFF;
      f32x4 ld[8];
      const float* W = nullptr; int sstride = 0, scol = 0, k0 = 0, K_ = 0, n0d = 0, mode = 0, nrows = 0; bf16* WT = nullptr; const float* gk = nullptr;
#define P0_DECODE(tl_) do { const int l_ = (tl_) / T_LAYER; int r_ = (tl_) - l_ * T_LAYER; gk = nullptr; mode = 0; \
        if (r_ < T_IN) { const int nb_ = PW / 256, kb_ = r_ / nb_, n0_ = (r_ - kb_ * nb_) * 256; W = in2 + (size_t)l_ * DM * INW; sstride = INW; scol = n0_ + (n0_ >= C_QD ? 12 : 0); k0 = 64 * kb_; WT = (bf16*)(ws + WS_WIN) + (size_t)l_ * PW * DM; K_ = DM; n0d = n0_; nrows = PW; gk = gA + l_ * DM; } \
        else if ((r_ -= T_IN) < T_OUT) { const int nb_ = DM / 256, kb_ = r_ / nb_, n0_ = (r_ - kb_ * nb_) * 256; W = in15 + (size_t)l_ * DM * DM; sstride = DM; scol = n0_; k0 = 64 * kb_; WT = (bf16*)(ws + WS_WOUT) + (size_t)l_ * DM * DM; K_ = DM; n0d = n0_; nrows = DM; } \
        else if ((r_ -= T_OUT) < 2 * T_G) { const int wh_ = r_ >= T_G; if (wh_) r_ -= T_G; const int nb_ = FF / 256, kb_ = r_ / nb_, n0_ = (r_ - kb_ * nb_) * 256; W = (wh_ ? in18 : in17) + (size_t)l_ * DM * FF; sstride = FF; scol = n0_; k0 = 64 * kb_; \
            WT = (bf16*)(ws + WS_WGU) + (size_t)l_ * NGU * DM; K_ = DM; n0d = n0_; nrows = NGU; gk = gF + l_ * DM; mode = 1 + wh_; } \
        else { r_ -= 2 * T_G; const int nb_ = DM / 256, kb_ = r_ / nb_, n0_ = (r_ - kb_ * nb_) * 256; W = in19 + (size_t)l_ * FF * DM; sstride = DM; scol = n0_; k0 = 64 * kb_; WT = (bf16*)(ws + WS_WD) + (size_t)l_ * DM * FF; K_ = FF; n0d = n0_; nrows = DM; } } while (0)
#define P0_LOADS() do { const float* wp_ = W + (size_t)(k0 + 8 * wave) * sstride + scol + 4 * lane; \
        _Pragma("unroll") for (int i_ = 0; i_ < 8; ++i_) ld[i_] = __builtin_nontemporal_load((const f32x4*)(wp_ + (size_t)i_ * sstride)); } while (0)
      const int p_lo = part == 0 ? 0 : (part == 1 ? T_IN : (part == 2 ? T_IN + T_OUT : T_IN + T_OUT + 2 * T_G)), p_hi = part == 0 ? T_IN : (part == 1 ? T_IN + T_OUT : (part == 2 ? T_IN + T_OUT + 2 * T_G : T_LAYER));
      unsigned* cq = (unsigned*)(ws + WS_CTL) + CW_CONV + (lsel * 8 + part) * 64; LAS unsigned* cw = (LAS unsigned*)(lds + RING_OFF + 65536);
      const int tbase = lsel * T_LAYER + p_lo, ntile = p_hi - p_lo;
      if (tid == 0) { const unsigned a0 = __hip_atomic_fetch_add(cq, 2u, __ATOMIC_RELAXED, __HIP_MEMORY_SCOPE_AGENT); cw[0] = a0; }
      __syncthreads();
      int ta = (int)cw[0], tb = ta + 1;
      __syncthreads();
      if (ta < ntile) { P0_DECODE(tbase + ta); P0_LOADS(); }
      while (ta < ntile) {
        unsigned fc = 0u; if (tid == 0) fc = __hip_atomic_fetch_add(cq, 1u, __ATOMIC_RELAXED, __HIP_MEMORY_SCOPE_AGENT);
#pragma unroll
        for (int i_ = 0; i_ < 8; ++i_) *(LAS f32x4*)(img + (8 * wave + i_) * 1024 + ((lane ^ wave) << 4)) = ld[i_];
        bf16* WTc = WT; const int k0c = k0, n0c = n0d, modec = mode, nrc = nrows; const float* gkc = gk; (void)K_;
        __syncthreads();
        if (tb < ntile) { P0_DECODE(tbase + tb); P0_LOADS(); }
        { const int c = tid & 7; f32x4 ga = {1.f, 1.f, 1.f, 1.f}, gb = {1.f, 1.f, 1.f, 1.f};
          if (gkc) { ga = *(const f32x4*)(gkc + k0c + 8 * c); gb = *(const f32x4*)(gkc + k0c + 8 * c + 4); }
#pragma unroll
          for (int j_ = 0; j_ < 4; ++j_) { const int n = (tid >> 3) + 64 * j_;
            const LAS unsigned char* sp = img + (8 * c) * 1024 + ((((n >> 2) ^ c) & 63) << 4) + ((n & 3) << 2);
            float v[8];
#pragma unroll
            for (int i_ = 0; i_ < 8; ++i_) v[i_] = *(const LAS float*)(sp + i_ * 1024);
            v4u o; o.x = pk2(v[0] * ga.x, v[1] * ga.y); o.y = pk2(v[2] * ga.z, v[3] * ga.w); o.z = pk2(v[4] * gb.x, v[5] * gb.y); o.w = pk2(v[6] * gb.z, v[7] * gb.w);
            const int na = n0c + n; const int drow = (modec == 0) ? na : ((na >> 7) * 256 + (modec - 1) * 128 + (na & 127));
            bf16* dp = WTc + ((size_t)(k0c >> 6) * nrc + drow) * 64 + 8 * c;
            *(GAS v4u*)dp = o; } }
        if (tid == 0) cw[0] = fc;
        __syncthreads();
        ta = tb; tb = (int)cw[0];
      }
      __syncthreads();
#undef P0_DECODE
#undef P0_LOADS
    }
    if (lsel != 0 || part != 0) return;
    const int gt = gw * 64 + lane, NGT = NGW * 64;
    for (int i = gt; i < DEPTH * 16 * DM; i += NGT) { const int l = i / (16 * DM), c = (i / DM) & 15, k = i % DM;
        ((bf16*)(ws + WS_WF))[i] = (c < 12) ? (bf16)f2bf(in2[((size_t)l * DM + k) * INW + 9216 + c] * gA[l * DM + k]) : (bf16)0; }
    { const float* x = ka->in[0]; float* ssq0 = (float*)(ws + WS_CTL) + CW_SSQ;
      for (int m = gw; m < M; m += NGW) { const GAS f32x4* xr = (const GAS f32x4*)(x + (size_t)m * DM) + lane; bf16* xa = (bf16*)(ws + WS_XN); float sq = 0.f;
#pragma unroll
        for (int j = 0; j < 16; ++j) { const f32x4 v = xr[64 * j]; sq += (v.x * v.x + v.y * v.y) + (v.z * v.z + v.w * v.w); v2u o; o.x = pk2(v.x, v.y); o.y = pk2(v.z, v.w); const int col = 4 * lane + 256 * j; *(GAS v2u*)(xa + ((size_t)(col >> 6) * M + m) * 64 + (col & 63)) = o; }
        sq = wave_sum(sq, lane); if (lane == 0) ssq0[m] = sq; } }
    for (int i = gt; i < SEQ * 64; i += NGT) { const int pos = i >> 6, fi = i & 63;
        const float invf = 1.0f / powf(10000.0f, (float)fi * (1.0f / 64.0f)); const float ang = (float)pos * invf;
        const double rev = (double)ang * 0.15915494309189533576888; const float fr = (float)(rev - rint(rev));
        ((f32x2*)(ws + WS_ROPE))[i] = (f32x2){__builtin_amdgcn_cosf(fr), __builtin_amdgcn_sinf(fr)}; }
}

constexpr int T3B_TILES = M / 16;
#define DPPF(v, ctrl) __int_as_float(__builtin_amdgcn_mov_dpp(__float_as_int(v), (ctrl), 0xf, 0xf, true))
__device__ __forceinline__ void t3_phase(unsigned char* ws, LAS unsigned char* lds, int l, int vcu, int G, int wave0) {
    FRESH_IDS(vcu);
    KArgs ka = kargs();
    { LAS f32x4* red = (LAS f32x4*)(lds + RING_OFF);
      const int tsel = wave >> 2, kq = wave & 3;
      for (int tb0 = vcu * 2; tb0 < T3B_TILES; tb0 += 2 * G) {
        const int t = tb0 + tsel;
        const bf16* A = (const bf16*)(ws + WS_XN) + ((size_t)(kq * 16) * M + (16 * t + (lane & 15))) * 64 + 8 * (lane >> 4);
        const bf16* B = (const bf16*)(ws + WS_WF) + (size_t)l * 16 * DM + (size_t)(lane & 15) * DM + kq * 1024 + 8 * (lane >> 4);
        f32x4 acc = {0.f, 0.f, 0.f, 0.f};
#pragma unroll 16
        for (int i = 0; i < 32; ++i) { const bf16x8 a = *(const bf16x8*)(A + (size_t)(i >> 1) * M * 64 + 32 * (i & 1)), b = *(const bf16x8*)(B + 32 * i); acc = __builtin_amdgcn_mfma_f32_16x16x32_bf16(a, b, acc, 0, 0, 0); }
        red[(tsel * 4 + kq) * 64 + lane] = acc;
        __syncthreads();
        if (kq == 0) {
            const f32x4 s4 = (red[(tsel * 4 + 0) * 64 + lane] + red[(tsel * 4 + 1) * 64 + lane]) + (red[(tsel * 4 + 2) * 64 + lane] + red[(tsel * 4 + 3) * 64 + lane]);
            const int c = lane & 15;
            if (c < 12) { const float fb = ka->in[7][l * 12 + c]; const float* ssq = (const float*)(ws + WS_CTL) + CW_SSQ + 2 * l * M;
                const int row0 = 16 * t + 4 * (lane >> 4), b = row0 / SEQ, s0 = row0 & (SEQ - 1); f32x4 ls;
#pragma unroll
                for (int r = 0; r < 4; ++r) { const float z = s4[r] * pg8::rs_of(ssq, row0 + r, 1.0f / DM, NORM_EPS) + fb; ls[r] = fminf(z, 0.f) - log1pf(expf(-fabsf(z))); }
                *(f32x4*)((float*)(ws + WS_LOGF) + (size_t)(b * 12 + c) * SEQ + s0) = ls; } }
        __syncthreads();
      } }
    bf16* PROJ = (bf16*)(ws + WS_PROJ);
    const int g = gw & 15; constexpr int NCH = M / T3A_ROWS;
    int col0; const float* gsel; bool rot, km = false;
    if (g < 3) { col0 = C_QM + 512 * g; gsel = ka->in[3]; rot = true; }
    else if (g < 6) { col0 = C_KM + 512 * (g - 3); gsel = ka->in[4]; rot = true; km = true; }
    else if (g < 9) { col0 = C_QF + 512 * (g - 6); gsel = ka->in[5]; rot = false; }
    else if (g < 12) { col0 = C_KF + 512 * (g - 9); gsel = ka->in[6]; rot = false; }
    else if (g < 14) { col0 = C_QD + 512 * (g - 12); gsel = ka->in[8]; rot = true; }
    else { col0 = C_KD + 512 * (g - 14); gsel = ka->in[9]; rot = true; }
    const int hv = lane >> 4, c8 = (lane & 15) * 8, cstep = (G * NWAVES) >> 4;
    float gn[8], dc[8], dsn[8];
    { const float* gp = gsel + l * HD + c8;
#pragma unroll
      for (int e = 0; e < 8; ++e) gn[e] = gp[e];
      const GAS f32x4* r1 = (const GAS f32x4*)((const float*)(ws + WS_ROPE) + ((size_t)1 * 64 + (c8 & 63)) * 2);
#pragma unroll
      for (int q = 0; q < 4; ++q) { const f32x4 b = r1[q]; dc[2 * q] = b.x; dsn[2 * q] = b.y; dc[2 * q + 1] = b.z; dsn[2 * q + 1] = b.w; } }
    const bool up = (lane & 8) != 0;
    const unsigned voff = (unsigned)(col0 + hv * 128 + c8) * 2u;
    for (int chunk = gw >> 4; chunk < NCH; chunk += cstep) {
        v4u w[T3A_ROWS]; float cs[8], sn[8];
        { const int row0_ = chunk * T3A_ROWS; GAS char* ub_ = (GAS char*)PROJ + (size_t)row0_ * PW * 2;
#pragma unroll
          for (int rr = 0; rr < T3A_ROWS; ++rr) w[rr] = *(GAS v4u*)(ub_ + (size_t)rr * PW * 2 + voff);
          const GAS f32x4* rp_ = (const GAS f32x4*)((const float*)(ws + WS_ROPE) + ((size_t)(row0_ & (SEQ - 1)) * 64 + (c8 & 63)) * 2);
#pragma unroll
          for (int q = 0; q < 4; ++q) { const f32x4 a = rp_[q]; cs[2 * q] = a.x; sn[2 * q] = a.y; cs[2 * q + 1] = a.z; sn[2 * q + 1] = a.w; } }
        const int row0 = chunk * T3A_ROWS, pos0 = row0 & (SEQ - 1);
        GAS char* ub0 = (GAS char*)PROJ + (size_t)row0 * PW * 2;
        float ks[8];
#pragma unroll
        for (int e = 0; e < 8; ++e) ks[e] = 0.f;
#pragma unroll
        for (int rr = 0; rr < T3A_ROWS; ++rr) {
            float y[8];
            y[0] = bflo(w[rr].x); y[1] = bfhi(w[rr].x); y[2] = bflo(w[rr].y); y[3] = bfhi(w[rr].y); y[4] = bflo(w[rr].z); y[5] = bfhi(w[rr].z); y[6] = bflo(w[rr].w); y[7] = bfhi(w[rr].w);
            float ss = 0.f;
#pragma unroll
            for (int e = 0; e < 8; ++e) ss += y[e] * y[e];
            ss += DPPF(ss, 0xB1); ss += DPPF(ss, 0x4E); ss += DPPF(ss, 0x141); ss += DPPF(ss, 0x140);
            const float sc = 1.0f / sqrtf(ss * (1.0f / HD) + NORM_EPS);
#pragma unroll
            for (int e = 0; e < 8; ++e) y[e] = y[e] * sc * gn[e];
            if (rot) {
#pragma unroll
                for (int e = 0; e < 8; ++e) { const float o = DPPF(y[e], 0x128);
                    y[e] = up ? (y[e] * cs[e] + o * sn[e]) : (y[e] * cs[e] - o * sn[e]);
                    const float cn = cs[e] * dc[e] - sn[e] * dsn[e]; sn[e] = sn[e] * dc[e] + cs[e] * dsn[e]; cs[e] = cn; }
            }
            v4u o; o.x = pk2(y[0], y[1]); o.y = pk2(y[2], y[3]); o.z = pk2(y[4], y[5]); o.w = pk2(y[6], y[7]);
            *(GAS v4u*)(ub0 + (size_t)rr * PW * 2 + voff) = o;
            if (km) {
#pragma unroll
                for (int e = 0; e < 8; ++e) ks[e] += y[e];
            }
        }
        if (km) {
            const int b = row0 / SEQ, blk = pos0 >> 8, sub = (pos0 & 255) / T3A_ROWS, h = 4 * (g - 3) + hv;
            float* kp = (float*)(ws + WS_KPART) + ((((size_t)(b * 12 + h) * NBLK + blk) * KSUB + sub) * HD) + c8;
            *(f32x4*)kp = (f32x4){ks[0], ks[1], ks[2], ks[3]}; *(f32x4*)(kp + 4) = (f32x4){ks[4], ks[5], ks[6], ks[7]};
        }
    }
}
__device__ __forceinline__ void attn_phase(unsigned char* ws, char* lds, int vcu, int G, int wave0, int layer) {
    const int tid = fresh_tid(wave0);
    int qx = (vcu * 8) / G; if (qx > 7) qx = 7;
    unsigned* qctr = (unsigned*)(ws + WS_CTL) + CW_ATTQ + (layer * 8 + qx) * 64;
    if (tid == 0) *(volatile unsigned*)(lds + att::OFF_NXT) = __hip_atomic_fetch_add(qctr, 1u, __ATOMIC_RELAXED, __HIP_MEMORY_SCOPE_AGENT);
    __syncthreads();
    int k = __builtin_amdgcn_readfirstlane((int)*(volatile unsigned*)(lds + att::OFF_NXT));
    __syncthreads();
    if (k >= att::QITEMS) return;
    float fox_thr;
    { const float* gq = kargs()->in[5] + layer * HD; const float* gk_ = kargs()->in[6] + layer * HD; const int lane = tid & 63;
      float mq = fmaxf(fabsf(gq[lane]), fabsf(gq[lane + 64])), mk = fmaxf(fabsf(gk_[lane]), fabsf(gk_[lane + 64]));
      mq = wave_max(mq, lane); mk = wave_max(mk, lane);
      fox_thr = __int_as_float(__builtin_amdgcn_readfirstlane(__float_as_int(106.0f * 11.313708498984761f + 2.0f * (128.0f * 1.02f) * mq * mk))); }
    att::Seam S;
    att::prime(att::q_item(qx, k), ws, lds, S, tid);
    for (;;) {
        const int nk = att::block(att::q_item(qx, k), qctr, qx, ws, lds, S, tid, fox_thr);
        if (nk >= att::QITEMS) break;
        k = nk;
    }
}
__device__ __forceinline__ void t5_phase(unsigned char* ws, int l, int vcu, int NGW, int wave0) {
    FRESH_IDS(vcu);
    KArgs ka = kargs(); const float* q1 = ka->in[10]; const float* k1 = ka->in[11]; const float* q2 = ka->in[12]; const float* k2 = ka->in[13];
    float s1 = q1[l * HD + lane] * k1[l * HD + lane] + q1[l * HD + 64 + lane] * k1[l * HD + 64 + lane];
    float s2 = q2[l * HD + lane] * k2[l * HD + lane] + q2[l * HD + 64 + lane] * k2[l * HD + 64 + lane];
    const float lam_init = 0.8f - 0.6f * expf(-0.3f * (float)l);
    const float lam = expf(wave_sum(s1, lane)) - expf(wave_sum(s2, lane)) + lam_init;
    const f32x4 gn = *(const f32x4*)(ka->in[14] + l * 256 + 4 * lane);
    const bf16* D0 = (const bf16*)(ws + WS_DIFF); const bf16* D1 = D0 + (size_t)M * 1024; bf16* MIX = (bf16*)(ws + WS_MIX);
    for (int it = gw; it < M * NH_D; it += NGW) {
        const int row = it >> 2, h = it & 3;
        const v2u a = *(const v2u*)(D0 + (size_t)row * 1024 + h * 256 + 4 * lane), b = *(const v2u*)(D1 + (size_t)row * 1024 + h * 256 + 4 * lane);
        const float v0 = bflo(a.x) - lam * bflo(b.x), v1 = bfhi(a.x) - lam * bfhi(b.x), v2 = bflo(a.y) - lam * bflo(b.y), v3 = bfhi(a.y) - lam * bfhi(b.y);
        const float ss = wave_sum((v0 * v0 + v1 * v1) + (v2 * v2 + v3 * v3), lane);
        const float sc = (1.0f / sqrtf(ss * (1.0f / 256.0f) + NORM_EPS)) * (1.0f - lam_init);
        v2u o; o.x = pk2(v0 * sc * gn.x, v1 * sc * gn.y); o.y = pk2(v2 * sc * gn.z, v3 * sc * gn.w);
        { const int col = 3072 + h * 256 + 4 * lane; *(v2u*)(MIX + ((size_t)(col >> 6) * M + row) * 64 + (col & 63)) = o; }
    }
}

__global__ void __launch_bounds__(NWAVES * 64, 2) mk_fwd(Args args_unused) {
    extern __shared__ __attribute__((aligned(16))) unsigned char lds_raw[];
    LAS unsigned char* lds = (LAS unsigned char*)lds_raw;
    volatile LAS unsigned* MISC = (volatile LAS unsigned*)(lds + MISC_OFF);
    const int wave0 = __builtin_amdgcn_readfirstlane((int)threadIdx.x >> 6);
    const int tid = fresh_tid(wave0);
    const int G = gridDim.x; const int bx = blockIdx.x; const int vcu = (G % 8 == 0) ? (bx % 8) * (G / 8) + bx / 8 : bx;
    const int NGW = G * NWAVES;
    for (int u = tid; u < (LDS_BYTES - LDSCTL_OFF) / 4; u += NWAVES * 64) ((LAS unsigned*)(lds + LDSCTL_OFF))[u] = 0u;
    __syncthreads();
    XcdBarrier bar; { unsigned char* ws0 = kargs()->ws; bar.bar = (unsigned*)(ws0 + WS_CTL) + CW_BAR; bar.x = 0; bar.st = nullptr;
        if (MK_N_LAUNCHES == 1) bar = xcd_barrier_post((unsigned*)(ws0 + WS_CTL) + CW_BAR, MISC + 8); }
#define GRID_BAR() do { if (MK_N_LAUNCHES == 1) xcd_barrier(bar); } while (0)
    const int lo = kargs()->ph_lo, hi = kargs()->ph_hi;
#define IN(k) (lo <= (k) && (k) < hi)
    unsigned long long tpA = 0ull, tpD = 0ull;
#define TP_BEGIN(k) do { if (MK_TIME_PHASE >= 0 && (k) == MK_TIME_PHASE) tpA = __builtin_amdgcn_s_memrealtime(); } while (0)
#define TP_END(k) do { if (MK_TIME_PHASE >= 0 && (k) == MK_TIME_PHASE) tpD = __builtin_amdgcn_s_memrealtime() - tpA; } while (0)
#define BOTH(k) (IN(k) && IN((k) + 1))
    if (IN(0)) { TP_BEGIN(0); for (int rep = 0; rep < REPS(100); ++rep) p0_prologue(kargs()->ws, lds, vcu, NGW, wave0, 0, 0); if (BOTH(0)) GRID_BAR(); TP_END(0); }
    for (int l = 0; l < DEPTH; ++l) {
        const int pb = 2 + 8 * l;
        if (l > 0 && IN(pb - 1)) { TP_BEGIN(pb - 1); p0_prologue(kargs()->ws, lds, vcu, NGW, wave0, l, 0); if (BOTH(pb - 1)) GRID_BAR(); TP_END(pb - 1); }
        if (IN(pb + 0)) { TP_BEGIN(pb + 0); unsigned char* ws = kargs()->ws;
            pg8::Gemm g{(const bf16*)(ws + WS_XN), (const bf16*)(ws + WS_WIN) + (size_t)l * PW * DM, M, PW, DM}; pg8::StaticOrder S; S.init(M, PW, G, bx);
            pg8::EpiStoreBf16 E{(bf16*)(ws + WS_PROJ), PW, (const float*)(ws + WS_CTL) + CW_SSQ + 2 * l * M, 1.0f / DM, NORM_EPS};
            for (int rep = 0; rep < REPS(0); ++rep) pg8::gemm_phase<pg8::EpiStoreBf16, pg8::StaticOrder, true, true, true>(lds + RING_OFF, g, S, E, fresh_tid(wave0));
            if (BOTH(pb + 0)) GRID_BAR(); TP_END(pb + 0); }
        if (IN(pb + 1)) { TP_BEGIN(pb + 1); t3_phase(kargs()->ws, lds, l, vcu, G, wave0); p0_prologue(kargs()->ws, lds, vcu, NGW, wave0, l, 1);     if (BOTH(pb + 1)) GRID_BAR(); TP_END(pb + 1); }
        if (IN(pb + 2)) { TP_BEGIN(pb + 2);
            attn_phase(kargs()->ws, (char*)lds_raw + RING_OFF, vcu, G, wave0, l);
            if (BOTH(pb + 2)) GRID_BAR(); TP_END(pb + 2); }
        if (IN(pb + 3)) { TP_BEGIN(pb + 3); for (int rep = 0; rep < REPS(4); ++rep) t5_phase(kargs()->ws, l, vcu, NGW, wave0); if (BOTH(pb + 3)) GRID_BAR(); TP_END(pb + 3); }
        if (IN(pb + 4)) { TP_BEGIN(pb + 4); KArgs ka = kargs(); unsigned char* ws = ka->ws; const float* xin = (l == 0) ? ka->in[0] : (const float*)(ws + WS_XB);
            pg8::Gemm g{(const bf16*)(ws + WS_MIX), (const bf16*)(ws + WS_WOUT) + (size_t)l * DM * DM, M, DM, DM}; pg8::StaticOrder S; S.init(M, DM, G, bx);
            pg8::EpiResid E{xin, ka->out, DM, (bf16*)(ws + WS_XN), (float*)(ws + WS_CTL) + CW_SSQ + (2 * l + 1) * M, (float*)(ws + WS_SSP) + (size_t)(2 * l) * M * 16, (unsigned*)(ws + WS_CTL) + CW_PCNT + (2 * l) * 32 * 64, (LAS float*)(lds + XL_OFF), DM / 256, M};
            pg8::gemm_phase<pg8::EpiResid, pg8::StaticOrder, true, true, true>(lds + RING_OFF, g, S, E, fresh_tid(wave0));
            p0_prologue(ws, lds, vcu, NGW, wave0, l, 2);
            if (BOTH(pb + 4)) GRID_BAR(); TP_END(pb + 4); }
        if (IN(pb + 5)) { TP_BEGIN(pb + 5); unsigned char* ws = kargs()->ws;
            pg8::Gemm g{(const bf16*)(ws + WS_XN), (const bf16*)(ws + WS_WGU) + (size_t)l * NGU * DM, M, NGU, DM}; pg8::StaticOrder S; S.init(M, NGU, G, bx);
            pg8::EpiSwiGLU E{(bf16*)(ws + WS_HB), FF, (const float*)(ws + WS_CTL) + CW_SSQ + (2 * l + 1) * M, 1.0f / DM, NORM_EPS, M};
            for (int rep = 0; rep < REPS(6); ++rep) pg8::gemm_phase<pg8::EpiSwiGLU, pg8::StaticOrder, true, true, true>(lds + RING_OFF, g, S, E, fresh_tid(wave0));
            p0_prologue(ws, lds, vcu, NGW, wave0, l, 3);
            if (BOTH(pb + 5)) GRID_BAR(); TP_END(pb + 5); }
        if (IN(pb + 6)) { TP_BEGIN(pb + 6); KArgs ka = kargs(); unsigned char* ws = ka->ws; const bool lastl = (l == DEPTH - 1); float* x2 = lastl ? ka->out : (float*)(ws + WS_XB);
            pg8::Gemm g{(const bf16*)(ws + WS_HB), (const bf16*)(ws + WS_WD) + (size_t)l * DM * FF, M, DM, FF}; pg8::StaticOrder S; S.init(M, DM, G, bx);
            pg8::EpiResid E{ka->out, x2, DM, lastl ? (bf16*)nullptr : (bf16*)(ws + WS_XN), (float*)(ws + WS_CTL) + CW_SSQ + (2 * l + 2) * M, (float*)(ws + WS_SSP) + (size_t)(2 * l + 1) * M * 16, (unsigned*)(ws + WS_CTL) + CW_PCNT + (2 * l + 1) * 32 * 64, (LAS float*)(lds + XL_OFF), DM / 256, M};
            pg8::gemm_phase<pg8::EpiResid, pg8::StaticOrder, true, true, true>(lds + RING_OFF, g, S, E, fresh_tid(wave0));
              TP_END(pb + 6); }
    }
    if (MK_TIME_PHASE >= 0 && blockIdx.x == 0) { const unsigned long long t0 = __builtin_amdgcn_s_memrealtime(); while (__builtin_amdgcn_s_memrealtime() - t0 < tpD) __builtin_amdgcn_s_sleep(8); }
#undef IN
#undef BOTH
}

extern "C" void kernel_launch(void* const* d_in, const int* in_sizes, int n_in, void* d_out, int out_size, void* d_ws, size_t ws_size, hipStream_t stream) {
    static int grid = 0;
    if (grid == 0) {
        if (n_in != 20 || in_sizes[0] != M * DM || out_size != M * DM || ws_size < WS_END) { fprintf(stderr, "kernel_launch: unexpected shapes (n_in %d, in0 %d, out %d, ws %zu < %zu); nothing launched\n", n_in, n_in > 0 ? in_sizes[0] : -1, out_size, ws_size, (size_t)WS_END); grid = -1; return; }
        int dev = 0, cus = 0, per_cu = 0;
        if (hipGetDevice(&dev) != hipSuccess || hipDeviceGetAttribute(&cus, hipDeviceAttributeMultiprocessorCount, dev) != hipSuccess) { grid = -1; return; }
        if (hipFuncSetAttribute((const void*)mk_fwd, hipFuncAttributeMaxDynamicSharedMemorySize, LDS_BYTES) != hipSuccess) { fprintf(stderr, "kernel_launch: hipFuncSetAttribute failed\n"); grid = -1; return; }
        if (hipOccupancyMaxActiveBlocksPerMultiprocessor(&per_cu, (const void*)mk_fwd, NWAVES * 64, LDS_BYTES) != hipSuccess || per_cu < 1) fprintf(stderr, "kernel_launch: occupancy query says %d\n", per_cu);
        (void)hipGetLastError();
        grid = cus;
    }
    if (grid < 0) return;
    if (hipMemsetAsync((char*)d_ws + WS_CTL, 0, CTL_ZERO_BYTES, stream) != hipSuccess) return;
    Args a{};
    for (int i = 0; i < 20; ++i) a.in[i] = (const float*)d_in[i];
    a.out = (float*)d_out; a.ws = (unsigned char*)d_ws;
    if (MK_N_LAUNCHES == 1) { a.ph_lo = 0; a.ph_hi = NPH; hipLaunchKernelGGL(mk_fwd, dim3(grid), dim3(NWAVES * 64), LDS_BYTES, stream, a); }
    else for (int p = 0; p < NPH; ++p) { a.ph_lo = p; a.ph_hi = p + 1; hipLaunchKernelGGL(mk_fwd, dim3(grid), dim3(NWAVES * 64), LDS_BYTES, stream, a); }
}
```

```cpp
#include <hip/hip_runtime.h>
#include <cstdio>
#include <cstdint>
#include <cmath>
namespace pg8 {
#define PG8_LAS __attribute__((address_space(3)))
typedef unsigned short bf16_t;
typedef short bf16x8 __attribute__((ext_vector_type(8)));
typedef float f32x4 __attribute__((ext_vector_type(4)));
typedef unsigned u32x4 __attribute__((ext_vector_type(4)));
constexpr int BM = 256, BK = 64, HALF = 128, HTB = HALF * BK * 2  , STAGE_BYTES = 8 * HTB, NXCD = 8, WGM = 8;

__host__ __device__ __forceinline__ int lds_byte(int r, int c) { const int st = (r >> 4) * 2 + (c >> 5), rr = r & 15, cc = c & 31, ob = rr * 64 + cc * 2; return st * 1024 + (ob ^ (((ob >> 9) & 1) << 5)); }
__host__ __device__ __forceinline__ void stage_rc(int b, int& R, int& C) { const int st = b / 1024, sb = b % 1024, swz = sb ^ (((sb >> 9) & 1) << 5); R = (st >> 1) * 16 + swz / 64; C = (st & 1) * 32 + (swz % 64) / 2; }
__host__ __device__ __forceinline__ int perm32(int rho) { const int n = rho >> 4, i = rho & 15; return 8 * (i >> 2) + 4 * n + (i & 3); }

struct Unit { int pm, pn; };
struct Gemm { const bf16_t* A; const bf16_t* Bt; int M, N, K; };

struct StaticOrder {
    int nM, nN, nwg, G, c;
    __host__ __device__ void init(int M, int N, int G_, int c_) { nM = M / BM; nN = N / BM; nwg = nM * nN; G = G_; c = c_; }
    __host__ __device__ bool next(int i, Unit& u) const {
        const long L = (long)i * G + c; if (L >= nwg) return false;
        int wgid = (int)L; { const int q = nwg / NXCD, r = nwg % NXCD, xcd = wgid % NXCD, off = wgid / NXCD; wgid = (xcd < r ? xcd * (q + 1) : r * (q + 1) + (xcd - r) * q) + off; }
        const int nig = WGM * nN, gid = wgid / nig, fm = gid * WGM, gsz = (nM - fm) < WGM ? (nM - fm) : WGM;
        u.pm = fm + ((wgid % nig) % gsz); u.pn = (wgid % nig) / gsz; return true;
    }
    __device__ __forceinline__ void a_ready(const Unit&) const {}
    __device__ __forceinline__ void done(const Unit&) const {}
};

__device__ __forceinline__ unsigned cvt_pk_bf16(float lo, float hi) { unsigned r; asm volatile("v_cvt_pk_bf16_f32 %0, %1, %2" : "=v"(r) : "v"(lo), "v"(hi)); return r; }
__device__ __forceinline__ float rs_of(const float* ssq, int row, float inv_k, float eps) { return 1.0f / sqrtf(ssq[row] * inv_k + eps); }
struct EpiStoreBf16 {
    static constexpr bool PERM = true, AFTER_DRAIN = false;
    bf16_t* O; int ldc; const float* ssq; float inv_k, eps;
    __device__ __forceinline__ void operator()(const f32x4 (&acc)[2][2][4][2], const Unit& u, int wr, int wc, int fr, int fq) const {
        const int row0 = u.pm * BM + wr * 64 + fr, col0 = u.pn * BM + wc * 32 + 8 * fq;
#pragma unroll
        for (int ai = 0; ai < 2; ++ai)
#pragma unroll
            for (int m = 0; m < 4; ++m) { const int row = row0 + ai * HALF + m * 16; bf16_t* rowp = O + (size_t)row * ldc + col0; const float r = rs_of(ssq, row, inv_k, eps);
#pragma unroll
                for (int bj = 0; bj < 2; ++bj) { const f32x4 v0 = acc[ai][bj][m][0] * r, v1 = acc[ai][bj][m][1] * r;
                    u32x4 w; w.x = cvt_pk_bf16(v0[0], v0[1]); w.y = cvt_pk_bf16(v0[2], v0[3]); w.z = cvt_pk_bf16(v1[0], v1[1]); w.w = cvt_pk_bf16(v1[2], v1[3]);
                    *(u32x4*)(rowp + bj * HALF) = w; } }
    }
};
__device__ __forceinline__ float silu_mul(float g, float u) { const float e = __builtin_amdgcn_exp2f(-g * 1.4426950408889634f); return g * __builtin_amdgcn_rcpf(1.0f + e) * u; }
struct EpiSwiGLU {
    static constexpr bool PERM = true, AFTER_DRAIN = false;
    bf16_t* O; int ldc; const float* ssq; float inv_k, eps; int tiledM;
    __device__ __forceinline__ void operator()(const f32x4 (&acc)[2][2][4][2], const Unit& u, int wr, int wc, int fr, int fq) const {
        const int row0 = u.pm * BM + wr * 64 + fr, col0 = u.pn * HALF + wc * 32 + 8 * fq;
#pragma unroll
        for (int ai = 0; ai < 2; ++ai)
#pragma unroll
            for (int m = 0; m < 4; ++m) { const int row = row0 + ai * HALF + m * 16; const float r = rs_of(ssq, row, inv_k, eps);
                bf16_t* rowp = tiledM ? O + ((size_t)(col0 >> 6) * tiledM + row) * 64 + (col0 & 63) : O + (size_t)row * ldc + col0;
                const f32x4 g0 = acc[ai][0][m][0] * r, g1 = acc[ai][0][m][1] * r, u0 = acc[ai][1][m][0] * r, u1 = acc[ai][1][m][1] * r;
                u32x4 w; w.x = cvt_pk_bf16(silu_mul(g0[0], u0[0]), silu_mul(g0[1], u0[1])); w.y = cvt_pk_bf16(silu_mul(g0[2], u0[2]), silu_mul(g0[3], u0[3]));
                w.z = cvt_pk_bf16(silu_mul(g1[0], u1[0]), silu_mul(g1[1], u1[1])); w.w = cvt_pk_bf16(silu_mul(g1[2], u1[2]), silu_mul(g1[3], u1[3]));
                *(u32x4*)rowp = w; }
    }
};
struct EpiResid {
    static constexpr bool PERM = false, AFTER_DRAIN = false;
    const float* base; float* out; int ldc; bf16_t* xb; float* ssq; float* ssp; unsigned* pcnt; PG8_LAS float* xl; int ntn; int xbM;
    __device__ __forceinline__ void operator()(const f32x4 (&acc)[2][2][4][2], const Unit& u, int wr, int wc, int fr, int fq) const {
        const int row0 = u.pm * BM + wr * 64 + fr, col0 = u.pn * BM + wc * 32 + 4 * fq; const int lane = fr + 16 * fq, tid = (wr * 4 + wc) * 64 + lane;
        typedef unsigned u32x2 __attribute__((ext_vector_type(2)));
#pragma unroll
        for (int ai = 0; ai < 2; ++ai)
#pragma unroll
            for (int m = 0; m < 4; ++m) { const int row = row0 + ai * HALF + m * 16; const size_t off = (size_t)row * ldc + col0; float ss = 0.f;
#pragma unroll
                for (int bj = 0; bj < 2; ++bj)
#pragma unroll
                    for (int n = 0; n < 2; ++n) { const f32x4 b = *(const f32x4*)(base + off + bj * HALF + n * 16); const f32x4 o = b + acc[ai][bj][m][n]; *(f32x4*)(out + off + bj * HALF + n * 16) = o;
                        if (xb) { u32x2 w; w.x = cvt_pk_bf16(o[0], o[1]); w.y = cvt_pk_bf16(o[2], o[3]); const int col = col0 + bj * HALF + n * 16; *(u32x2*)(xb + ((size_t)(col >> 6) * xbM + row) * 64 + (col & 63)) = w; }
                        ss += (o[0] * o[0] + o[1] * o[1]) + (o[2] * o[2] + o[3] * o[3]); }
                if (xb) { ss += __int_as_float(__builtin_amdgcn_ds_bpermute((lane ^ 16) << 2, __float_as_int(ss))); ss += __int_as_float(__builtin_amdgcn_ds_bpermute((lane ^ 32) << 2, __float_as_int(ss)));
                    if (fq == 0) xl[(ai * HALF + wr * 64 + m * 16 + fr) * 4 + wc] = ss; } }
        if (xb) {
            asm volatile("s_waitcnt lgkmcnt(0)" ::: "memory"); __builtin_amdgcn_s_barrier(); asm volatile("" ::: "memory");
            if (tid < BM) { const f32x4 p4 = *(const PG8_LAS f32x4*)(xl + tid * 4); const float t = (p4[0] + p4[1]) + (p4[2] + p4[3]);
                __hip_atomic_store(ssp + (size_t)(u.pm * BM + tid) * 16 + u.pn, t, __ATOMIC_RELAXED, __HIP_MEMORY_SCOPE_AGENT); }
            asm volatile("s_waitcnt vmcnt(0)" ::: "memory");
            __builtin_amdgcn_s_barrier(); asm volatile("" ::: "memory");
            if (tid == 0) { const unsigned old = __hip_atomic_fetch_add(pcnt + 64 * u.pm, 1u, __ATOMIC_RELAXED, __HIP_MEMORY_SCOPE_AGENT); ((PG8_LAS unsigned*)xl)[1024] = (old == (unsigned)(ntn - 1)) ? 1u : 0u; }
            asm volatile("s_waitcnt vmcnt(0) lgkmcnt(0)" ::: "memory"); __builtin_amdgcn_s_barrier(); asm volatile("" ::: "memory");
            if (((volatile PG8_LAS unsigned*)xl)[1024] != 0u && tid < BM) {
                __builtin_amdgcn_fence(__ATOMIC_ACQUIRE, "agent");
                const float* pp = ssp + (size_t)(u.pm * BM + tid) * 16; float t = 0.f;
                for (int j = 0; j < ntn; ++j) t += __hip_atomic_load(pp + j, __ATOMIC_RELAXED, __HIP_MEMORY_SCOPE_AGENT);
                ssq[u.pm * BM + tid] = t; }
        }
    }
};

template <class Epi, class Sched, bool ALIGN_EPI = false, bool SP2 = false, bool TILED = false>
__device__ __forceinline__ void gemm_phase(PG8_LAS unsigned char* lds, const Gemm g, const Sched& S, const Epi& E, int tid_) {
    asm volatile("" : "+v"(tid_));
    const int tid = tid_, wid = __builtin_amdgcn_readfirstlane(tid >> 6), lane = tid & 63, wr = wid >> 2, wc = wid & 3, fr = lane & 15, fq = lane >> 4;
    const int K = g.K, nt = K / BK; const int RP = TILED ? BK : K;
    unsigned voffA[2], voffB[2];
#pragma unroll
    for (int i = 0; i < 2; ++i) { int R, C; stage_rc(tid * 16 + i * 8192, R, C); const int Rb = Epi::PERM ? ((R & ~31) + perm32(R & 31)) : R;
        voffA[i] = (unsigned)(R * RP + C) * 2u; voffB[i] = (unsigned)(Rb * RP + C) * 2u; }
    const size_t kstepA = TILED ? (size_t)g.M * BK * 2 : (size_t)(BK * 2), kstepB = TILED ? (size_t)g.N * BK * 2 : (size_t)(BK * 2);
    const size_t hstep = (size_t)HALF * RP * 2;
    const size_t tstep = 2 * hstep;
    const unsigned ldsw = (unsigned)wid * 1024u;
    const int aoff = lds_byte(wr * 64 + fr, fq * 8), boff = lds_byte(wc * 32 + fr, fq * 8);
#define PG8_SA(b, h) (((b) * 2 + (h)) * HTB)
#define PG8_SB(b, h) ((4 + (b) * 2 + (h)) * HTB)
#define PG8_STAGE(bufoff, gbase, voff) do { _Pragma("unroll") for (int _i = 0; _i < 2; ++_i) \
        __builtin_amdgcn_global_load_lds((const unsigned*)((const char*)(gbase) + (voff)[_i]), (PG8_LAS unsigned*)(lds + (bufoff) + ldsw + _i * 8192), 16, 0, 0); } while (0)
#define PG8_LDA(dst, b, h) do { _Pragma("unroll") for (int m = 0; m < 4; ++m) _Pragma("unroll") for (int k = 0; k < 2; ++k) dst[m][k] = *(const PG8_LAS bf16x8*)(lds + PG8_SA(b, h) + aoff + m * 2048 + k * 1024); } while (0)
#define PG8_LDB(dst, b, h) do { _Pragma("unroll") for (int n = 0; n < 2; ++n) _Pragma("unroll") for (int k = 0; k < 2; ++k) dst[n][k] = *(const PG8_LAS bf16x8*)(lds + PG8_SB(b, h) + boff + n * 2048 + k * 1024); } while (0)
#define PG8_MMA(ai, bj, At, Bt) do { __builtin_amdgcn_s_setprio(1); _Pragma("unroll") for (int m = 0; m < 4; ++m) _Pragma("unroll") for (int n = 0; n < 2; ++n) _Pragma("unroll") for (int k = 0; k < 2; ++k) \
        acc[ai][bj][m][n] = __builtin_amdgcn_mfma_f32_16x16x32_bf16(Bt[n][k], At[m][k], acc[ai][bj][m][n], 0, 0, 0); __builtin_amdgcn_s_setprio(0); } while (0)
#define PG8_WAIT_V(n) asm volatile("s_waitcnt vmcnt(" #n ")" ::: "memory")
#define PG8_WAIT_L(n) asm volatile("s_waitcnt lgkmcnt(" #n ")" ::: "memory")
#define PG8_BAR __builtin_amdgcn_s_barrier()
#define PG8_SCHED __builtin_amdgcn_sched_barrier(0)
    Unit cur, nxt; int ui = 0;
    if (!S.next(0, cur)) return;
    f32x4 acc[2][2][4][2];
#pragma unroll
    for (int a = 0; a < 2; ++a)
#pragma unroll
        for (int b = 0; b < 2; ++b)
#pragma unroll
            for (int m = 0; m < 4; ++m)
#pragma unroll
                for (int n = 0; n < 2; ++n) acc[a][b][m][n] = (f32x4){0.f, 0.f, 0.f, 0.f};
    bf16x8 At[4][2], B0[2][2], B1[2][2];
    const char* cA = (const char*)g.A + (size_t)cur.pm * tstep; const char* cB = (const char*)g.Bt + (size_t)cur.pn * tstep;
    S.a_ready(cur);
    if constexpr (SP2) {
        PG8_STAGE(PG8_SB(0, 0), cB, voffB); PG8_STAGE(PG8_SB(0, 1), cB + hstep, voffB); PG8_STAGE(PG8_SA(0, 0), cA, voffA); PG8_STAGE(PG8_SA(0, 1), cA + hstep, voffA);
        if (wr == 1) PG8_BAR;
        PG8_WAIT_V(2); PG8_BAR;
        PG8_STAGE(PG8_SB(1, 0), cB + kstepB, voffB); PG8_STAGE(PG8_SA(1, 0), cA + kstepA, voffA); PG8_STAGE(PG8_SB(1, 1), cB + hstep + kstepB, voffB);
        PG8_WAIT_V(6); PG8_BAR;
    } else {
        PG8_STAGE(PG8_SB(0, 0), cB, voffB); PG8_STAGE(PG8_SA(0, 0), cA, voffA); PG8_STAGE(PG8_SB(0, 1), cB + hstep, voffB); PG8_STAGE(PG8_SA(0, 1), cA + hstep, voffA);
        if (wr == 1) PG8_BAR;
        PG8_WAIT_V(4); PG8_BAR;
        PG8_STAGE(PG8_SB(1, 0), cB + kstepB, voffB); PG8_STAGE(PG8_SA(1, 0), cA + kstepA, voffA); PG8_STAGE(PG8_SB(1, 1), cB + hstep + kstepB, voffB);
        PG8_WAIT_V(6); PG8_BAR;
    }
    for (;;) {
        const bool has_next = S.next(ui + 1, nxt);
        const char* nA = has_next ? (const char*)g.A + (size_t)nxt.pm * tstep : cA; const char* nB = has_next ? (const char*)g.Bt + (size_t)nxt.pn * tstep : cB;
        for (int t = 0; t < nt; t += 2) {
            const bool last = (t == nt - 2);
            const char* a1 = cA + (size_t)(t + 1) * kstepA;
            const char* a2 = last ? nA : cA + (size_t)(t + 2) * kstepA; const char* b2 = last ? nB : cB + (size_t)(t + 2) * kstepB;
            const char* a3 = a2 + kstepA; const char* b3 = b2 + kstepB;
            if (last && has_next) S.a_ready(nxt);
            if constexpr (SP2) {
            PG8_LDB(B0, 0, 0); PG8_LDB(B1, 0, 1); PG8_SCHED; PG8_LDA(At, 0, 0); PG8_STAGE(PG8_SA(1, 1), a1 + hstep, voffA);
            PG8_WAIT_V(8); PG8_WAIT_L(0); PG8_BAR; PG8_MMA(0, 0, At, B0); PG8_MMA(0, 1, At, B1); PG8_BAR; PG8_SCHED;
            PG8_LDA(At, 0, 1); PG8_STAGE(PG8_SB(0, 0), b2, voffB); PG8_STAGE(PG8_SB(0, 1), b2 + hstep, voffB); PG8_STAGE(PG8_SA(0, 0), a2, voffA);
            PG8_WAIT_V(8); PG8_WAIT_L(0); PG8_BAR; PG8_MMA(1, 0, At, B0); PG8_MMA(1, 1, At, B1); PG8_BAR; PG8_SCHED;
            PG8_LDB(B0, 1, 0); PG8_LDB(B1, 1, 1); PG8_SCHED; PG8_LDA(At, 1, 0); PG8_STAGE(PG8_SA(0, 1), a2 + hstep, voffA);
            PG8_WAIT_V(8); PG8_WAIT_L(0); PG8_BAR; PG8_MMA(0, 0, At, B0); PG8_MMA(0, 1, At, B1); PG8_BAR; PG8_SCHED;
            PG8_LDA(At, 1, 1); PG8_STAGE(PG8_SB(1, 0), b3, voffB); PG8_STAGE(PG8_SB(1, 1), b3 + hstep, voffB); PG8_STAGE(PG8_SA(1, 0), a3, voffA);
            PG8_WAIT_V(8); PG8_WAIT_L(0); PG8_BAR; PG8_MMA(1, 0, At, B0); PG8_MMA(1, 1, At, B1); PG8_BAR; PG8_SCHED;
            } else {
            PG8_LDB(B0, 0, 0); PG8_SCHED; PG8_LDA(At, 0, 0); PG8_STAGE(PG8_SA(1, 1), a1 + hstep, voffA);
            PG8_WAIT_L(8); PG8_BAR; PG8_WAIT_L(0); PG8_MMA(0, 0, At, B0); PG8_BAR; PG8_SCHED;
            PG8_LDB(B1, 0, 1); PG8_STAGE(PG8_SB(0, 0), b2, voffB);
            PG8_BAR; PG8_WAIT_L(0); PG8_MMA(0, 1, At, B1); PG8_BAR;
            PG8_LDA(At, 0, 1); PG8_STAGE(PG8_SA(0, 0), a2, voffA);
            PG8_BAR; PG8_WAIT_L(0); PG8_MMA(1, 0, At, B0); PG8_BAR; PG8_SCHED;
            PG8_STAGE(PG8_SB(0, 1), b2 + hstep, voffB);
            PG8_WAIT_V(6); PG8_BAR; PG8_MMA(1, 1, At, B1); PG8_BAR;
            PG8_LDB(B0, 1, 0); PG8_SCHED; PG8_LDA(At, 1, 0); PG8_STAGE(PG8_SA(0, 1), a2 + hstep, voffA);
            PG8_WAIT_L(8); PG8_BAR; PG8_WAIT_L(0); PG8_MMA(0, 0, At, B0); PG8_BAR; PG8_SCHED;
            PG8_LDB(B1, 1, 1); PG8_STAGE(PG8_SB(1, 0), b3, voffB);
            PG8_BAR; PG8_WAIT_L(0); PG8_MMA(0, 1, At, B1); PG8_BAR;
            PG8_LDA(At, 1, 1); PG8_STAGE(PG8_SA(1, 0), a3, voffA);
            PG8_BAR; PG8_WAIT_L(0); PG8_MMA(1, 0, At, B0); PG8_BAR; PG8_SCHED;
            PG8_STAGE(PG8_SB(1, 1), b3 + hstep, voffB);
            PG8_WAIT_V(6); PG8_BAR; PG8_MMA(1, 1, At, B1); PG8_BAR;
            }
        }
        if constexpr (ALIGN_EPI) { if (wr == 0) PG8_BAR; }
        if constexpr (!Epi::AFTER_DRAIN) { E(acc, cur, wr, wc, fr, fq); S.done(cur); }
        if (!has_next) break;
#pragma unroll
        for (int a = 0; a < 2; ++a)
#pragma unroll
            for (int b = 0; b < 2; ++b)
#pragma unroll
                for (int m = 0; m < 4; ++m)
#pragma unroll
                    for (int n = 0; n < 2; ++n) acc[a][b][m][n] = (f32x4){0.f, 0.f, 0.f, 0.f};
        cur = nxt; cA = nA; cB = nB; ++ui;
        if constexpr (ALIGN_EPI) { if (wr == 1) PG8_BAR; }
    }
    PG8_WAIT_V(0);
    if constexpr (!ALIGN_EPI) { if (wr == 0) PG8_BAR; }
    PG8_BAR;
    if constexpr (Epi::AFTER_DRAIN) { E.fused(acc, cur, wr, wc, fr, fq, lds, wid, lane); S.done(cur); }
#undef PG8_SA
#undef PG8_SB
#undef PG8_STAGE
#undef PG8_LDA
#undef PG8_LDB
#undef PG8_MMA
#undef PG8_WAIT_V
#undef PG8_WAIT_L
#undef PG8_BAR
#undef PG8_SCHED
}
}
#ifndef MK_N_LAUNCHES
#define MK_N_LAUNCHES 1
#endif
constexpr int NWAVES = 8;
#ifndef MK_REP_PHASE
#define MK_REP_PHASE -1
#endif
#define REPS(k) (((k) == MK_REP_PHASE) ? 2 : 1)
#ifndef MK_TIME_PHASE
#define MK_TIME_PHASE -1
#endif
constexpr int BATCH = 2, SEQ = 4096, DM = 4096, M = BATCH * SEQ, DEPTH = 2;
constexpr int HD = 128, NH_M = 12, NH_F = 12, NH_D = 4;
constexpr int INW = 12300;
constexpr int PW = 12288;
constexpr int FF = 11008, NGU = 2 * FF;
constexpr int C_QM = 0, C_KM = 1536, C_VM = 3072, C_QF = 4608, C_KF = 6144, C_VF = 7680, C_QD = 9216, C_KD = 10240, C_VD = 11264;
constexpr int NBLK = SEQ / 256;
constexpr int T3A_ROWS = 16, KSUB = 256 / T3A_ROWS;
constexpr float NORM_EPS = 1e-6f;
constexpr int NATT = 40;
constexpr int NPH = 1 + 8 * DEPTH;
constexpr size_t MiB = 1u << 20;
constexpr size_t WS_CTL = 0, CTL_ZERO_BYTES = 400 * 1024;
constexpr size_t WS_ROPE = 1 * MiB;
constexpr size_t WS_WF = 3 * MiB;
constexpr size_t WS_LOGF = 4 * MiB;
constexpr size_t WS_BRAW = 5 * MiB;
constexpr size_t WS_SELM = 6 * MiB;
constexpr size_t WS_SSP = 9 * MiB;
constexpr size_t WS_KPART = 10 * MiB + 512 * 1024;
constexpr size_t WS_WIN = 16 * MiB;
constexpr size_t WS_WOUT = 208 * MiB;
constexpr size_t WS_WGU = 272 * MiB;
constexpr size_t WS_WD = 616 * MiB;
constexpr size_t WS_XN = 788 * MiB;
constexpr size_t WS_PROJ = 852 * MiB;
constexpr size_t WS_HB = 852 * MiB;
constexpr size_t WS_MIX = 1044 * MiB;
constexpr size_t WS_DIFF = 1108 * MiB;
constexpr size_t WS_XB = 1140 * MiB;
constexpr size_t WS_END = 1268 * MiB;
static_assert(WS_WIN + (size_t)DEPTH * PW * DM * 2 <= WS_WOUT && WS_WOUT + (size_t)DEPTH * DM * DM * 2 <= WS_WGU && WS_WGU + (size_t)DEPTH * NGU * DM * 2 <= WS_WD && WS_WD + (size_t)DEPTH * DM * FF * 2 <= WS_XN, "ws map (weights)");
static_assert(WS_XN + (size_t)M * DM * 2 <= WS_PROJ && WS_PROJ + (size_t)M * PW * 2 <= WS_MIX && WS_HB + (size_t)M * FF * 2 <= WS_MIX && WS_MIX + (size_t)M * DM * 2 <= WS_DIFF && WS_DIFF + (size_t)2 * M * 1024 * 2 <= WS_XB && WS_XB + (size_t)M * DM * 4 <= WS_END, "ws map (activations)");
constexpr int CW_TMO = 0, CW_CODE = 1, CW_BAR = 4096;
constexpr int CW_SSQ = 16384;
constexpr int CW_PCNT = 65536;
static_assert((98304 + 16 * 64) * 4 <= 400 * 1024, "control words inside the per-call memset");
constexpr int CW_CONV = 98304;
constexpr int CW_ATTQ = 8192;
constexpr int RING_OFF = 0, RING_BYTES = 131072;
constexpr int LDSCTL_OFF = RING_BYTES, MISC_OFF = LDSCTL_OFF + 320;
constexpr int XL_OFF = RING_BYTES + 4096;
constexpr int LDS_BYTES = 147456;

#define GAS __attribute__((address_space(1)))
#define LAS __attribute__((address_space(3)))
typedef unsigned short bf16;
typedef unsigned v4u __attribute__((ext_vector_type(4)));
typedef unsigned v2u __attribute__((ext_vector_type(2)));
typedef float f32x4 __attribute__((ext_vector_type(4)));
typedef float f32x2 __attribute__((ext_vector_type(2)));
typedef short bf16x8 __attribute__((ext_vector_type(8)));
typedef GAS unsigned gu32;
#define RLX_AGENT __ATOMIC_RELAXED, __HIP_MEMORY_SCOPE_AGENT
#define LDS_WAIT() asm volatile("s_waitcnt lgkmcnt(0)" ::: "memory")
#define VM_WAIT() asm volatile("s_waitcnt vmcnt(0)" ::: "memory")
__device__ __forceinline__ unsigned f2bf(float f) { unsigned u = __builtin_bit_cast(unsigned, f); return (u + 0x7fffu + ((u >> 16) & 1u)) >> 16; }
__device__ __forceinline__ unsigned pk2(float lo, float hi) { return f2bf(lo) | (f2bf(hi) << 16); }
__device__ __forceinline__ float bflo(unsigned w) { return __uint_as_float(w << 16); }
__device__ __forceinline__ float bfhi(unsigned w) { return __uint_as_float(w & 0xffff0000u); }
__device__ __forceinline__ float bf2f(bf16 b) { return __uint_as_float((unsigned)b << 16); }
__device__ __forceinline__ float shx(float v, int o, int lane) { return __int_as_float(__builtin_amdgcn_ds_bpermute((lane ^ o) << 2, __float_as_int(v))); }
__device__ __forceinline__ float wave_sum(float v, int lane) {
#pragma unroll
    for (int o = 1; o < 64; o <<= 1) v += shx(v, o, lane);
    return v;
}
__device__ __forceinline__ float wave_max(float v, int lane) {
#pragma unroll
    for (int o = 1; o < 64; o <<= 1) v = fmaxf(v, shx(v, o, lane));
    return v;
}
__device__ __forceinline__ float dpp_xor1(float v) { return __int_as_float(__builtin_amdgcn_mov_dpp(__float_as_int(v), 0xB1, 0xf, 0xf, true)); }
__device__ __forceinline__ int fresh_tid(int wave0) { int lane; asm volatile("v_mbcnt_lo_u32_b32 %0, -1, 0\n\tv_mbcnt_hi_u32_b32 %0, -1, %0" : "=v"(lane)); return wave0 * 64 + lane; }
#define FRESH_IDS(vcu_) const int tid = fresh_tid(wave0); const int lane = tid & 63, wave = wave0; const int gw = (vcu_) * NWAVES + wave; (void)gw; (void)lane; (void)wave; (void)tid

#define XB_TMO      128
#define XB_XCNT(j)  (256  + 64 * (j))
#define XB_XSUB(j)  (1280 + 64 * (j))
#define XB_XGEN(j)  (2304 + 64 * (j))
#define XB_TOP      3328
#define XB_TOPGEN   3392
#define XCD_BAR_WORDS 3456
#define XB_SPIN_CAP (1u << 18)

__device__ __forceinline__ unsigned xb_ld(unsigned* p)              { return __hip_atomic_load(p, __ATOMIC_RELAXED, __HIP_MEMORY_SCOPE_AGENT); }
__device__ __forceinline__ unsigned xb_add(unsigned* p, unsigned v) { return __hip_atomic_fetch_add(p, v, __ATOMIC_RELAXED, __HIP_MEMORY_SCOPE_AGENT); }
__device__ __forceinline__ unsigned xb_xcc_id() { return (unsigned)__builtin_amdgcn_s_getreg((3 << 11) | 20) & 0xFu; }
#define XB_SPIN(cond, bar) do { unsigned _sp = 0; while (cond) { __builtin_amdgcn_s_sleep(1); \
    if ((++_sp & 255u) == 0u) { if (xb_ld(&(bar)[XB_TMO])) break; if (_sp > XB_SPIN_CAP) { atomicAdd(&(bar)[XB_TMO], 1u); break; } } } } while (0)

struct XcdBarrier {
    unsigned* bar; unsigned x;
    volatile LAS unsigned* st;
};

__device__ __forceinline__ XcdBarrier xcd_barrier_post(unsigned* bar, volatile LAS unsigned* st) {
    XcdBarrier b; b.bar = bar; b.x = xb_xcc_id(); b.st = st;
    if (threadIdx.x == 0) (void)xb_add(&bar[XB_XCNT(b.x)], 1u);
    return b;
}
__device__ __forceinline__ void xcd_barrier_complete(unsigned* bar, unsigned x, unsigned& nloc, unsigned& nx) {
    const unsigned G = gridDim.x * gridDim.y * gridDim.z;
    unsigned sum, cnt, mine, sp = 0u;
    for (;;) {
        sum = 0u; cnt = 0u; mine = 0u;
#pragma unroll
        for (unsigned j = 0; j < 16; ++j) { const unsigned c = xb_ld(&bar[XB_XCNT(j)]); sum += c; cnt += (c > 0u) ? 1u : 0u; mine = (j == x) ? c : mine; }
        if (sum == G) break;
        __builtin_amdgcn_s_sleep(1);
        if ((++sp & 255u) == 0u) { if (xb_ld(&bar[XB_TMO])) break; if (sp > XB_SPIN_CAP) { atomicAdd(&bar[XB_TMO], 1u); break; } }
    }
    nloc = mine > 0u ? mine : 1u; nx = cnt > 0u ? cnt : 1u;
}

__device__ __forceinline__ void xcd_barrier(const XcdBarrier& b) {
    asm volatile("s_waitcnt vmcnt(0)" ::: "memory");
    __syncthreads();
    if (threadIdx.x == 0) {
        unsigned* bar = b.bar;
        __builtin_amdgcn_s_waitcnt(0);
        unsigned nloc = b.st[0], nx = b.st[1];
        if (nloc == 0u) { xcd_barrier_complete(bar, b.x, nloc, nx); b.st[0] = nloc; b.st[1] = nx; }
        const unsigned old = xb_add(&bar[XB_XSUB(b.x)], 1u);
        const unsigned gen = old / nloc;
        if (old + 1u == (gen + 1u) * nloc) {
            __builtin_amdgcn_fence(__ATOMIC_RELEASE, "agent");
            asm volatile("s_waitcnt vmcnt(0)" ::: "memory");
            const unsigned og = xb_add(&bar[XB_TOP], 1u);
            const unsigned tg = og / nx;
            if (og + 1u == (tg + 1u) * nx) xb_add(&bar[XB_TOPGEN], 1u);
            else XB_SPIN(xb_ld(&bar[XB_TOPGEN]) == tg, bar);
            __builtin_amdgcn_fence(__ATOMIC_ACQUIRE, "agent");
            xb_add(&bar[XB_XGEN(b.x)], 1u);
            asm volatile("s_waitcnt vmcnt(0)" ::: "memory");
        } else {
            XB_SPIN(xb_ld(&bar[XB_XGEN(b.x)]) == gen, bar);
            __builtin_amdgcn_fence(__ATOMIC_ACQUIRE, "agent");
            asm volatile("s_waitcnt vmcnt(0)" ::: "memory");
        }
    }
    __syncthreads();
}


namespace att {
typedef short s16x4 __attribute__((ext_vector_type(4)));
typedef float f32x16 __attribute__((ext_vector_type(16)));
typedef unsigned u32x4 __attribute__((ext_vector_type(4)));
constexpr int NW = 8, QBLK = 32, KVBLK = 64, QB = NW * QBLK, D = 128;
constexpr int SHM_V = KVBLK * D * 2, SHM_K = KVBLK * D * 2;
constexpr int OFF_WS = 2 * SHM_V + 2 * SHM_K, OFF_BIAS = OFF_WS + NW * 64 * 4, OFF_NXT = OFF_BIAS + SEQ * 4, OFF_WT = OFF_NXT + 16, LDS_BYTES = OFF_WT + 64;
constexpr int QITEMS = (BATCH * NATT / 8) * (SEQ / QB);
constexpr float SCALE = 0.08838834764831845f, THR = 8.f;
constexpr int PITCH = PW;
#define KSWZ(row, colB) ((row) * 256 + ((colB) ^ (((row) & 7) << 4)))
#define SBAR() __builtin_amdgcn_sched_barrier(0)
__device__ __forceinline__ int v_st(int k, int c) { const int kk = (k & ~0xC) | ((k & 4) << 1) | ((k & 8) >> 1); return ((kk >> 3) * 4 + (c >> 5)) * 512 + ((kk & 7) * 32 + (c & 31)) * 2; }
__device__ __forceinline__ int v_rd_base(int lane) { return ((lane & 3) << 3) | (((lane >> 2) & 3) << 6) | (((lane >> 4) & 1) << 5) | (((lane >> 5) & 1) << 8); }
constexpr int v_rd_off(int d0, int ks, int half) { return d0 * 512 + ks * 4096 + half * 2048; }
__device__ __forceinline__ int crow(int r, int hi) { return (r & 3) + 8 * (r >> 2) + 4 * hi; }
__device__ __forceinline__ unsigned cvtpk(float lo, float hi) { unsigned r; asm volatile("v_cvt_pk_bf16_f32 %0, %1, %2" : "=v"(r) : "v"(lo), "v"(hi)); return r; }
__device__ __forceinline__ bf16x8 load8(const bf16* p) { return *reinterpret_cast<const bf16x8*>(p); }
__device__ __forceinline__ void mask_tile(f32x16& p0, f32x16& p1, int dq) {
    const float NEG = -__builtin_inff();
#pragma unroll
    for (int r = 0; r < 16; ++r) { const int c = (r & 3) + 8 * (r >> 2); if (dq - c < 0) p0[r] = NEG; if (dq - c - 32 < 0) p1[r] = NEG; }
}
__device__ __forceinline__ void partialSM(f32x16& p0, f32x16& p1, float& m_reg, float& mn, float& alpha) {
    float pmax = p0[0];
#pragma unroll
    for (int r = 1; r < 16; ++r) pmax = fmaxf(pmax, p0[r]);
#pragma unroll
    for (int r = 0; r < 16; ++r) pmax = fmaxf(pmax, p1[r]);
    { auto rr = __builtin_amdgcn_permlane32_swap(__float_as_uint(pmax), __float_as_uint(pmax), false, false); pmax = fmaxf(__uint_as_float(rr[0]), __uint_as_float(rr[1])); }
    constexpr float C2 = 1.4426950408889634f * SCALE;
    if (__builtin_expect(__all((pmax - m_reg) * SCALE <= THR), 1)) { mn = m_reg; alpha = 1.f; }
    else { mn = fmaxf(m_reg, pmax); alpha = __builtin_amdgcn_exp2f((m_reg - mn) * C2); m_reg = mn; }
    const float mnL = -mn * C2;
#pragma unroll
    for (int r = 0; r < 16; ++r) p0[r] = fmaf(p0[r], C2, mnL);
#pragma unroll
    for (int r = 0; r < 16; ++r) p1[r] = fmaf(p1[r], C2, mnL);
#pragma unroll
    for (int r = 0; r < 16; ++r) p0[r] = __builtin_amdgcn_exp2f(p0[r]);
}
__device__ __forceinline__ void finishSM(f32x16& p0, f32x16& p1, float alpha, float& l_reg, bf16x8& pa0, bf16x8& pa1, bf16x8& pa2, bf16x8& pa3) {
#pragma unroll
    for (int r = 0; r < 16; ++r) p1[r] = __builtin_amdgcn_exp2f(p1[r]);
    float ps = 0;
#pragma unroll
    for (int r = 0; r < 16; ++r) ps += p0[r];
#pragma unroll
    for (int r = 0; r < 16; ++r) ps += p1[r];
    { auto rr = __builtin_amdgcn_permlane32_swap(__float_as_uint(ps), __float_as_uint(ps), false, false); ps = __uint_as_float(rr[0]) + __uint_as_float(rr[1]); }
    l_reg = l_reg * alpha + ps;
#define PK4(P, B_, OUT) do { unsigned a0 = cvtpk(P[B_+0], P[B_+1]), a1 = cvtpk(P[B_+2], P[B_+3]);                          \
        unsigned b0 = cvtpk(P[B_+4], P[B_+5]), b1 = cvtpk(P[B_+6], P[B_+7]);                                             \
        auto r0 = __builtin_amdgcn_permlane32_swap(a0, b0, false, false); auto r1 = __builtin_amdgcn_permlane32_swap(a1, b1, false, false); \
        u32x4 w = {r0[0], r1[0], r0[1], r1[1]}; OUT = *reinterpret_cast<bf16x8*>(&w); } while (0)
    PK4(p0, 0, pa0); PK4(p0, 8, pa1); PK4(p1, 0, pa2); PK4(p1, 8, pa3);
#undef PK4
}
template <int KB>
__device__ __forceinline__ void qkt(f32x16& p0, f32x16& p1, const char* K_lds, int r32, int hi, const bf16x8* qr, const float* bt, float rowinit) {
    if (bt) { const f32x4* bp = (const f32x4*)(bt + 4 * hi);
#pragma unroll
        for (int g = 0; g < 4; ++g) { const f32x4 a = bp[2 * g], b = bp[2 * g + 8];
            p0[4 * g] = a[0]; p0[4 * g + 1] = a[1]; p0[4 * g + 2] = a[2]; p0[4 * g + 3] = a[3]; p1[4 * g] = b[0]; p1[4 * g + 1] = b[1]; p1[4 * g + 2] = b[2]; p1[4 * g + 3] = b[3]; } }
    else {
#pragma unroll
        for (int r = 0; r < 16; ++r) { p0[r] = rowinit; p1[r] = rowinit; } }
    const char* kb[4];
#pragma unroll
    for (int dd = 0; dd < 4; ++dd) kb[dd] = K_lds + KB * SHM_K + KSWZ(r32, (dd * 16 + hi * 8) * 2);
#pragma unroll
    for (int d0 = 0; d0 < 8; ++d0) { const char* a = kb[d0 & 3] + (d0 >> 2) * 128;
        bf16x8 b0 = *reinterpret_cast<const bf16x8*>(a);
        bf16x8 b1 = *reinterpret_cast<const bf16x8*>(a + 32 * 256);
        p0 = __builtin_amdgcn_mfma_f32_32x32x16_bf16(b0, qr[d0], p0, 0, 0, 0);
        p1 = __builtin_amdgcn_mfma_f32_32x32x16_bf16(b1, qr[d0], p1, 0, 0, 0); }
}
template <int VB>
__device__ __forceinline__ void pv_tile(f32x16* o, int vb0, bf16x8 pa0, bf16x8 pa1, bf16x8 pa2, bf16x8 pa3) {
#define TRRD(dst, off) asm volatile("ds_read_b64_tr_b16 %0, %1 offset:%2" : "=&v"(dst) : "v"(vb0), "i"(off) : "memory")
#define PV_D0(d0) do { s16x4 l0, l1, l2, l3, h0, h1, h2, h3; constexpr int b_ = VB * SHM_V + v_rd_off(d0, 0, 0); \
        TRRD(l0, b_); TRRD(h0, b_ + 2048); TRRD(l1, b_ + 4096); TRRD(h1, b_ + 6144); TRRD(l2, b_ + 8192); TRRD(h2, b_ + 10240); TRRD(l3, b_ + 12288); TRRD(h3, b_ + 14336); \
        asm volatile("s_waitcnt lgkmcnt(0)" ::: "memory"); SBAR();   \
        o[d0] = __builtin_amdgcn_mfma_f32_32x32x16_bf16(pa0, (bf16x8){l0[0], l0[1], l0[2], l0[3], h0[0], h0[1], h0[2], h0[3]}, o[d0], 0, 0, 0);   \
        o[d0] = __builtin_amdgcn_mfma_f32_32x32x16_bf16(pa1, (bf16x8){l1[0], l1[1], l1[2], l1[3], h1[0], h1[1], h1[2], h1[3]}, o[d0], 0, 0, 0);   \
        o[d0] = __builtin_amdgcn_mfma_f32_32x32x16_bf16(pa2, (bf16x8){l2[0], l2[1], l2[2], l2[3], h2[0], h2[1], h2[2], h2[3]}, o[d0], 0, 0, 0);   \
        o[d0] = __builtin_amdgcn_mfma_f32_32x32x16_bf16(pa3, (bf16x8){l3[0], l3[1], l3[2], l3[3], h3[0], h3[1], h3[2], h3[3]}, o[d0], 0, 0, 0); } while (0)
    PV_D0(0); PV_D0(1); PV_D0(2); PV_D0(3);
#undef PV_D0
#undef TRRD
}
struct BlockRef { int bh, qb; };
struct HeadCols { int qcol, kcol, vcol, type, ocol, opitch, ohstep; size_t obase_off; };
__device__ __forceinline__ HeadCols head_cols(int hidx) {
    HeadCols d;
    if (hidx < 12) { d.type = 0; d.qcol = C_QM + hidx * HD; d.kcol = C_KM + hidx * HD; d.vcol = C_VM + hidx * HD; d.obase_off = WS_MIX + (size_t)((hidx * HD) >> 6) * M * 64 * 2; d.opitch = 64; d.ohstep = M * 64; d.ocol = 0; }
    else if (hidx < 24) { const int h = hidx - 12; d.type = 1; d.qcol = C_QF + h * HD; d.kcol = C_KF + h * HD; d.vcol = C_VF + h * HD; d.obase_off = WS_MIX + (size_t)((1536 + h * HD) >> 6) * M * 64 * 2; d.opitch = 64; d.ohstep = M * 64; d.ocol = 0; }
    else { const int x = hidx - 24, h = x >> 2, mp = (x >> 1) & 1, e = x & 1; d.type = 2; d.qcol = C_QD + h * 256 + mp * HD; d.kcol = C_KD + h * 256 + mp * HD; d.vcol = C_VD + h * 256 + e * HD;
        d.obase_off = WS_DIFF + (size_t)mp * M * 1024 * 2; d.opitch = 1024; d.ohstep = 64; d.ocol = h * 256 + e * HD; }
    return d;
}
#define LAUNDER_S(x) asm volatile("" : "+s"(x))
__device__ __forceinline__ BlockRef q_item(int qx, int k) { const int kk = k / 10, ui = k - kk * 10, q4 = qx & 3; BlockRef r;
    const int hidx = ui < 3 ? 3 * q4 + ui : (ui < 6 ? 12 + 3 * q4 + (ui - 3) : 24 + 4 * q4 + (ui - 6));
    r.bh = (qx >> 2) * NATT + hidx; r.qb = 15 - kk; return r; }
struct Seam { bf16x8 qr[8]; bf16x8 st_v0, st_v1, st_k0, st_k1; };
#define ROW(p, k0, rr) ((p) + (size_t)((k0) + (rr)) * PITCH + sc)
#define VMW() asm volatile("s_waitcnt vmcnt(0)" ::: "memory")
#define VMWN(n) asm volatile("s_waitcnt vmcnt(%0)" :: "i"(n) : "memory")
#define SLOAD_H(Kp, Vp, k0) do { S.st_v0 = load8(ROW(Vp, k0, sr)); S.st_v1 = load8(ROW(Vp, k0, 32 + sr)); S.st_k0 = load8(ROW(Kp, k0, sr)); S.st_k1 = load8(ROW(Kp, k0, 32 + sr)); } while (0)
#define SWRITE_HK(bf) do { *(bf16x8*)(K_lds + (bf) * SHM_K + kws) = S.st_k0; *(bf16x8*)(K_lds + (bf) * SHM_K + kws + 32 * 256) = S.st_k1; } while (0)
#define SWRITE_HV(bf) do { *(bf16x8*)(V_lds + (bf) * SHM_V + vst0) = S.st_v0; *(bf16x8*)(V_lds + (bf) * SHM_V + vst1) = S.st_v1; } while (0)
#define SWRITE_H(bf) do { SWRITE_HV(bf); SWRITE_HK(bf); } while (0)
__device__ __forceinline__ void prime(BlockRef cur, unsigned char* wsb, char* lds, Seam& S, int tid) {
    const int wid = __builtin_amdgcn_readfirstlane(tid >> 6), lane = tid & 63, r32 = lane & 31, hi = lane >> 5;
    const int sr = tid >> 4, sc = (tid & 15) * 8, kws = KSWZ(sr, sc * 2); char* K_lds = lds + 2 * SHM_V;
    const int b = cur.bh / NATT; const HeadCols hc = head_cols(cur.bh - b * NATT);
    const bf16* PROJ = (const bf16*)(wsb + WS_PROJ); const size_t rowb = (size_t)b * SEQ;
    const bf16* Qp = PROJ + (rowb + (size_t)cur.qb * QB) * PITCH + hc.qcol; const bf16* Kp = PROJ + rowb * PITCH + hc.kcol; const bf16* Vp = PROJ + rowb * PITCH + hc.vcol;
#pragma unroll
    for (int d0 = 0; d0 < 8; ++d0) S.qr[d0] = load8(Qp + (size_t)(wid * QBLK + r32) * PITCH + d0 * 16 + hi * 8);
    SLOAD_H(Kp, Vp, cur.qb * QB + QB - KVBLK); VMW(); SWRITE_HK(0);
    __syncthreads();
}
__device__ __forceinline__ int block(BlockRef cur, unsigned* qctr, int qx, unsigned char* wsb, char* lds, Seam& S, int tid, float fox_thr) {
    const int wid = __builtin_amdgcn_readfirstlane(tid >> 6), lane = tid & 63, r32 = lane & 31, hi = lane >> 5;
    const int P0 = cur.qb * QB;
    const int NT = (P0 + QB) / KVBLK;
    int NS = NT;
    const int qlo = P0 + wid * QBLK, qm = qlo + r32 - 4 * hi;
    char* V_lds = lds; char* K_lds = lds + 2 * SHM_V;
    float* ws = (float*)(lds + OFF_WS) + wid * 64; float* li_l = ws, * al_l = ws + 32;
    float* blds = (float*)(lds + OFF_BIAS);
    float m_reg = -1e30f, l_reg = 0; f32x16 o[4] = {};
    const int sr = tid >> 4, sc = (tid & 15) * 8, vst0 = v_st(sr, sc), vst1 = v_st(32 + sr, sc), kws = KSWZ(sr, sc * 2);
    const int vb0 = (int)(uintptr_t)V_lds + v_rd_base(lane);
    const int cb = cur.bh / NATT, chx = cur.bh - cb * NATT; const HeadCols hc = head_cols(chx);
    const bf16* Kh = (const bf16*)(wsb + WS_PROJ) + (size_t)cb * SEQ * PITCH + hc.kcol; const bf16* Vh = (const bf16*)(wsb + WS_PROJ) + (size_t)cb * SEQ * PITCH + hc.vcol;
    const bool hb = hc.type == 1;
    unsigned nfetch = 0u; if (tid == 0) nfetch = __hip_atomic_fetch_add(qctr, 1u, __ATOMIC_RELAXED, __HIP_MEMORY_SCOPE_AGENT);
    unsigned selm = 0xffffffffu;
    int tid_h = tid; asm volatile("" : "+v"(tid_h)); const int lane_h = tid_h & 63;
    unsigned char* wsh = wsb; asm volatile("" : "+s"(wsh));
    if (hc.type == 0) {
        const int j = cur.qb; selm = 1u << j;
        if (j > 0) {
            const float* kp = (const float*)(wsh + WS_KPART) + (size_t)(cb * 12 + chx) * NBLK * KSUB * HD;
            for (int idx = tid_h; idx < j * HD; idx += NW * 64) { const int n = idx >> 7, d = idx & 127; const float* q_ = kp + (size_t)n * KSUB * HD + d; float a = 0.f;
#pragma unroll
                for (int sub = 0; sub < KSUB; ++sub) a += q_[sub * HD];
                blds[idx] = a * (1.0f / 256.0f); }
            __syncthreads();
            float b0 = -__builtin_inff(), b1 = b0, b2 = b0; int i0 = -1, i1 = -1, i2 = -1;
            for (int n = 0; n < j; ++n) { const float* km = blds + n * HD + 8 * (lane_h >> 5); float a = 0.f;
#pragma unroll
                for (int d0 = 0; d0 < 8; ++d0) { const f32x4 k0 = *(const f32x4*)(km + 16 * d0), k1 = *(const f32x4*)(km + 16 * d0 + 4); const bf16x8 qv = S.qr[d0];
                    a += bf2f((bf16)qv[0]) * k0[0] + bf2f((bf16)qv[1]) * k0[1] + bf2f((bf16)qv[2]) * k0[2] + bf2f((bf16)qv[3]) * k0[3] + bf2f((bf16)qv[4]) * k1[0] + bf2f((bf16)qv[5]) * k1[1] + bf2f((bf16)qv[6]) * k1[2] + bf2f((bf16)qv[7]) * k1[3]; }
                { auto rr = __builtin_amdgcn_permlane32_swap(__float_as_uint(a), __float_as_uint(a), false, false); a = __uint_as_float(rr[0]) + __uint_as_float(rr[1]); }
                if (a > b0) { b2 = b1; i2 = i1; b1 = b0; i1 = i0; b0 = a; i0 = n; } else if (a > b1) { b2 = b1; i2 = i1; b1 = a; i1 = n; } else if (a > b2) { b2 = a; i2 = n; } }
            if (i0 >= 0) selm |= 1u << i0; if (i1 >= 0) selm |= 1u << i1; if (i2 >= 0) selm |= 1u << i2;
        }
    }
    if (hb) { const float* lf = (const float*)(wsh + WS_LOGF) + (size_t)(cb * 12 + (chx - 12)) * SEQ; const int nk = P0 + QB;
        float v[8]; float tot = 0.f; const bool act = tid_h * 8 < nk;
        if (act) { const f32x4 a = *(const f32x4*)(lf + 8 * tid_h), b = *(const f32x4*)(lf + 8 * tid_h + 4);
            v[0] = a[0]; v[1] = v[0] + a[1]; v[2] = v[1] + a[2]; v[3] = v[2] + a[3]; v[4] = v[3] + b[0]; v[5] = v[4] + b[1]; v[6] = v[5] + b[2]; v[7] = v[6] + b[3]; tot = v[7]; }
        else {
#pragma unroll
            for (int i = 0; i < 8; ++i) v[i] = 0.f; }
        float inc = tot;
#pragma unroll
        for (int o_ = 1; o_ < 64; o_ <<= 1) { const float t_ = __int_as_float(__builtin_amdgcn_ds_bpermute((lane_h >= o_ ? lane_h - o_ : lane_h) << 2, __float_as_int(inc))); if (lane_h >= o_) inc += t_; }
        float* wt = (float*)(lds + OFF_WT);
        if (lane_h == 63) wt[wid] = inc;
        __syncthreads();
        float off = inc - tot;
        for (int w_ = 0; w_ < wid; ++w_) off += wt[w_];
        if (act) { f32x4 a, b; a[0] = (off + v[0]) * -11.313708498984761f; a[1] = (off + v[1]) * -11.313708498984761f; a[2] = (off + v[2]) * -11.313708498984761f; a[3] = (off + v[3]) * -11.313708498984761f;
            b[0] = (off + v[4]) * -11.313708498984761f; b[1] = (off + v[5]) * -11.313708498984761f; b[2] = (off + v[6]) * -11.313708498984761f; b[3] = (off + v[7]) * -11.313708498984761f;
            *(f32x4*)(blds + 8 * tid_h) = a; *(f32x4*)(blds + 8 * tid_h + 4) = b; }
        __syncthreads();
        if (wid == 0) { const float thr = fox_thr;
            const int ti = NT - 1 - lane_h; bool dead = false;
            if (lane_h >= 4 && ti >= 0) dead = (blds[P0] - blds[64 * ti + 63]) > thr;
            const unsigned long long bm = __ballot(dead);
            int ns = NT; if (bm != 0ull) { ns = __builtin_ctzll(bm); ns = (ns + 1) & ~1; if (ns > NT) ns = NT; }
            if (lane_h == 0) *(volatile int*)(lds + OFF_WT + 32) = ns; }
        __syncthreads();
        NS = __builtin_amdgcn_readfirstlane(*(volatile int*)(lds + OFF_WT + 32)); }
#define RESC(a) do { if (__any((a) < 1.f)) { if (hi == 0) al_l[r32] = (a); asm volatile("s_waitcnt lgkmcnt(0)" ::: "memory");              \
                     for (int d_ = 0; d_ < 4; ++d_) for (int r = 0; r < 16; ++r) o[d_][r] *= al_l[crow(r, hi)]; } } while (0)
#define KBASE(i) ((NT - 1 - (i)) * KVBLK)
#define BT(i) (hb ? blds + KBASE(i) : (const float*)nullptr)
#define RI(i) ((((selm >> ((NT - 1 - (i)) >> 2)) & 1u) != 0u) ? 0.f : -__builtin_inff())
#define MASKT(P0_, P1_, t) do { const int kb_ = KBASE(t); if (kb_ + KVBLK - 1 > qlo) mask_tile(P0_, P1_, qm - kb_); } while (0)
#define SEAM_K0() do { VMWN(8); SWRITE_HK(0); SBAR(); } while (0)
    f32x16 pA0, pA1, pB0, pB1; float mnA, mnB, alA, alB; bf16x8 pa0, pa1, pa2, pa3;
    SWRITE_HV(0); SBAR();
    SLOAD_H(Kh, Vh, KBASE(1));
    SBAR(); qkt<0>(pA0, pA1, K_lds, r32, hi, S.qr, BT(0), RI(0));
    MASKT(pA0, pA1, 0); partialSM(pA0, pA1, m_reg, mnA, alA);
    VMW(); SWRITE_H(1);
    if (tid == 0) *(volatile unsigned*)(lds + OFF_NXT) = nfetch;
    __syncthreads();
    const int nk = __builtin_amdgcn_readfirstlane((int)*(volatile unsigned*)(lds + OFF_NXT));
#define HALF_STEP(PX0, PX1, mnX, alX, PY0, PY1, alY, t, KB, VB, SB) do {                                                      \
        SBAR(); qkt<KB>(PX0, PX1, K_lds, r32, hi, S.qr, BT(t), RI(t));                                                        \
        finishSM(PY0, PY1, alY, l_reg, pa0, pa1, pa2, pa3); SBAR();                                                           \
        if ((t) + 1 < NS) { SLOAD_H(Kh, Vh, KBASE((t) + 1)); SBAR(); }                                                        \
        pv_tile<VB>(o, vb0, pa0, pa1, pa2, pa3); MASKT(PX0, PX1, (t)); partialSM(PX0, PX1, m_reg, mnX, alX);                  \
        __syncthreads();                                                                                                      \
        if ((t) + 1 < NS) { VMW(); SWRITE_H(SB); }                                                                            \
        RESC(alX); __syncthreads(); } while (0)
    for (int t = 1; t + 1 < NS; t += 2) {
        HALF_STEP(pB0, pB1, mnB, alB, pA0, pA1, alA, t, 1, 0, 0);
        HALF_STEP(pA0, pA1, mnA, alA, pB0, pB1, alB, t + 1, 0, 1, 1);
    }
    SBAR(); qkt<1>(pB0, pB1, K_lds, r32, hi, S.qr, BT(NS - 1), RI(NS - 1)); SBAR();
    { const BlockRef nxt = (nk < QITEMS) ? q_item(qx, nk) : cur; int nbh = nxt.bh, nqb = nxt.qb; LAUNDER_S(nbh); LAUNDER_S(nqb);
      const int nb = nbh / NATT; const HeadCols nh = head_cols(nbh - nb * NATT); const bf16* PROJ = (const bf16*)(wsb + WS_PROJ); const size_t rowb = (size_t)nb * SEQ;
      const bf16* nK = PROJ + rowb * PITCH + nh.kcol; const bf16* nV = PROJ + rowb * PITCH + nh.vcol; const bf16* nQ = PROJ + (rowb + (size_t)nqb * QB) * PITCH + nh.qcol;
      SLOAD_H(nK, nV, nqb * QB + QB - KVBLK); SBAR();
#pragma unroll
      for (int d0 = 0; d0 < 8; ++d0) S.qr[d0] = load8(nQ + (size_t)(wid * QBLK + r32) * PITCH + d0 * 16 + hi * 8); }
    SBAR();
    finishSM(pA0, pA1, alA, l_reg, pa0, pa1, pa2, pa3); SBAR();
    pv_tile<0>(o, vb0, pa0, pa1, pa2, pa3);
    MASKT(pB0, pB1, NS - 1); partialSM(pB0, pB1, m_reg, mnB, alB); __syncthreads(); RESC(alB);
    finishSM(pB0, pB1, alB, l_reg, pa0, pa1, pa2, pa3); SBAR(); pv_tile<1>(o, vb0, pa0, pa1, pa2, pa3);
    SBAR(); SEAM_K0();
    if (hi == 0) li_l[r32] = l_reg; asm volatile("s_waitcnt lgkmcnt(0)" ::: "memory");
    float rli[16];
#pragma unroll
    for (int r = 0; r < 16; ++r) rli[r] = __builtin_amdgcn_rcpf(li_l[crow(r, hi)]);
    { int obh = cur.bh, oqb = cur.qb; LAUNDER_S(obh); LAUNDER_S(oqb);
      const int ob = obh / NATT; const HeadCols oh = head_cols(obh - ob * NATT); const int opitch = oh.opitch, ohstep = oh.ohstep;
      bf16* Ow = (bf16*)(wsb + oh.obase_off) + ((size_t)ob * SEQ + (size_t)oqb * QB + wid * QBLK) * opitch + oh.ocol;
      int hi_e = hi; asm volatile("" : "+v"(hi_e));
      bf16* Ol = Ow + (size_t)(4 * hi_e) * opitch + r32;
#pragma unroll
      for (int r = 0; r < 16; ++r) { const int orow = (r & 3) + 8 * (r >> 2);
#pragma unroll
        for (int d0 = 0; d0 < 4; ++d0) { const float v = o[d0][r] * rli[r]; const float vn = __int_as_float(__builtin_amdgcn_mov_dpp(__float_as_int(v), 0xB1, 0xf, 0xf, true));
            if ((r32 & 1) == 0) *(unsigned*)(Ol + (size_t)orow * opitch + (size_t)(d0 >> 1) * ohstep + (d0 & 1) * 32) = cvtpk(v, vn); } } }
    __syncthreads();
    return nk;
#undef RESC
#undef KBASE
#undef BT
#undef RI
#undef MASKT
#undef SEAM_K0
#undef HALF_STEP
}
#undef ROW
#undef VMW
#undef VMWN
#undef SLOAD_H
#undef SWRITE_HK
#undef SWRITE_HV
#undef SWRITE_H
#undef KSWZ
#undef SBAR
}

struct Args { const float* in[20]; float* out; unsigned char* ws; int ph_lo, ph_hi; };
typedef const __attribute__((address_space(4))) Args* KArgs;
__device__ __forceinline__ KArgs kargs() { KArgs k = (KArgs)__builtin_amdgcn_kernarg_segment_ptr(); asm volatile("" : "+s"(k)); return k; }

__device__ __forceinline__ void p0_prologue(unsigned char* ws, LAS unsigned char* lds, int vcu, int NGW, int wave0, int lsel, int part) {
    FRESH_IDS(vcu);
    KArgs ka = kargs(); const float* in2 = ka->in[2]; const float* in15 = ka->in[15]; const float* in17 = ka->in[17]; const float* in18 = ka->in[18]; const float* in19 = ka->in[19]; const float* gA = ka->in[1]; const float* gF = ka->in[16];
    { constexpr int T_IN = (DM / 64) * (PW / 256), T_OUT = (DM / 64) * (DM / 256), T_G = (DM / 64) * (FF / 256), T_D = (FF / 64) * (DM / 256), T_LAYER = T_IN + T_OUT + 2 * T_G + T_D;
      const int G_ = NGW / NWAVES;
      LAS unsigned char* img = lds + RING_OFF;
      f32x4 ld[8];
      const float* W = nullptr; int sstride = 0, scol = 0, k0 = 0, K_ = 0, n0d = 0, mode = 0, nrows = 0; bf16* WT = nullptr; const float* gk = nullptr;
#define P0_DECODE(tl_) do { const int l_ = (tl_) / T_LAYER; int r_ = (tl_) - l_ * T_LAYER; gk = nullptr; mode = 0; \
        if (r_ < T_IN) { const int nb_ = PW / 256, kb_ = r_ / nb_, n0_ = (r_ - kb_ * nb_) * 256; W = in2 + (size_t)l_ * DM * INW; sstride = INW; scol = n0_ + (n0_ >= C_QD ? 12 : 0); k0 = 64 * kb_; WT = (bf16*)(ws + WS_WIN) + (size_t)l_ * PW * DM; K_ = DM; n0d = n0_; nrows = PW; gk = gA + l_ * DM; } \
        else if ((r_ -= T_IN) < T_OUT) { const int nb_ = DM / 256, kb_ = r_ / nb_, n0_ = (r_ - kb_ * nb_) * 256; W = in15 + (size_t)l_ * DM * DM; sstride = DM; scol = n0_; k0 = 64 * kb_; WT = (bf16*)(ws + WS_WOUT) + (size_t)l_ * DM * DM; K_ = DM; n0d = n0_; nrows = DM; } \
        else if ((r_ -= T_OUT) < 2 * T_G) { const int wh_ = r_ >= T_G; if (wh_) r_ -= T_G; const int nb_ = FF / 256, kb_ = r_ / nb_, n0_ = (r_ - kb_ * nb_) * 256; W = (wh_ ? in18 : in17) + (size_t)l_ * DM * FF; sstride = FF; scol = n0_; k0 = 64 * kb_; \
            WT = (bf16*)(ws + WS_WGU) + (size_t)l_ * NGU * DM; K_ = DM; n0d = n0_; nrows = NGU; gk = gF + l_ * DM; mode = 1 + wh_; } \
        else { r_ -= 2 * T_G; const int nb_ = DM / 256, kb_ = r_ / nb_, n0_ = (r_ - kb_ * nb_) * 256; W = in19 + (size_t)l_ * FF * DM; sstride = DM; scol = n0_; k0 = 64 * kb_; WT = (bf16*)(ws + WS_WD) + (size_t)l_ * DM * FF; K_ = FF; n0d = n0_; nrows = DM; } } while (0)
#define P0_LOADS() do { const float* wp_ = W + (size_t)(k0 + 8 * wave) * sstride + scol + 4 * lane; \
        _Pragma("unroll") for (int i_ = 0; i_ < 8; ++i_) ld[i_] = __builtin_nontemporal_load((const f32x4*)(wp_ + (size_t)i_ * sstride)); } while (0)
      const int p_lo = part == 0 ? 0 : (part == 1 ? T_IN : (part == 2 ? T_IN + T_OUT : T_IN + T_OUT + 2 * T_G)), p_hi = part == 0 ? T_IN : (part == 1 ? T_IN + T_OUT : (part == 2 ? T_IN + T_OUT + 2 * T_G : T_LAYER));
      unsigned* cq = (unsigned*)(ws + WS_CTL) + CW_CONV + (lsel * 8 + part) * 64; LAS unsigned* cw = (LAS unsigned*)(lds + RING_OFF + 65536);
      const int tbase = lsel * T_LAYER + p_lo, ntile = p_hi - p_lo;
      if (tid == 0) { const unsigned a0 = __hip_atomic_fetch_add(cq, 2u, __ATOMIC_RELAXED, __HIP_MEMORY_SCOPE_AGENT); cw[0] = a0; }
      __syncthreads();
      int ta = (int)cw[0], tb = ta + 1;
      __syncthreads();
      if (ta < ntile) { P0_DECODE(tbase + ta); P0_LOADS(); }
      while (ta < ntile) {
        unsigned fc = 0u; if (tid == 0) fc = __hip_atomic_fetch_add(cq, 1u, __ATOMIC_RELAXED, __HIP_MEMORY_SCOPE_AGENT);
#pragma unroll
        for (int i_ = 0; i_ < 8; ++i_) *(LAS f32x4*)(img + (8 * wave + i_) * 1024 + ((lane ^ wave) << 4)) = ld[i_];
        bf16* WTc = WT; const int k0c = k0, n0c = n0d, modec = mode, nrc = nrows; const float* gkc = gk; (void)K_;
        __syncthreads();
        if (tb < ntile) { P0_DECODE(tbase + tb); P0_LOADS(); }
        { const int c = tid & 7; f32x4 ga = {1.f, 1.f, 1.f, 1.f}, gb = {1.f, 1.f, 1.f, 1.f};
          if (gkc) { ga = *(const f32x4*)(gkc + k0c + 8 * c); gb = *(const f32x4*)(gkc + k0c + 8 * c + 4); }
#pragma unroll
          for (int j_ = 0; j_ < 4; ++j_) { const int n = (tid >> 3) + 64 * j_;
            const LAS unsigned char* sp = img + (8 * c) * 1024 + ((((n >> 2) ^ c) & 63) << 4) + ((n & 3) << 2);
            float v[8];
#pragma unroll
            for (int i_ = 0; i_ < 8; ++i_) v[i_] = *(const LAS float*)(sp + i_ * 1024);
            v4u o; o.x = pk2(v[0] * ga.x, v[1] * ga.y); o.y = pk2(v[2] * ga.z, v[3] * ga.w); o.z = pk2(v[4] * gb.x, v[5] * gb.y); o.w = pk2(v[6] * gb.z, v[7] * gb.w);
            const int na = n0c + n; const int drow = (modec == 0) ? na : ((na >> 7) * 256 + (modec - 1) * 128 + (na & 127));
            bf16* dp = WTc + ((size_t)(k0c >> 6) * nrc + drow) * 64 + 8 * c;
            *(GAS v4u*)dp = o; } }
        if (tid == 0) cw[0] = fc;
        __syncthreads();
        ta = tb; tb = (int)cw[0];
      }
      __syncthreads();
#undef P0_DECODE
#undef P0_LOADS
    }
    if (lsel != 0 || part != 0) return;
    const int gt = gw * 64 + lane, NGT = NGW * 64;
    for (int i = gt; i < DEPTH * 16 * DM; i += NGT) { const int l = i / (16 * DM), c = (i / DM) & 15, k = i % DM;
        ((bf16*)(ws + WS_WF))[i] = (c < 12) ? (bf16)f2bf(in2[((size_t)l * DM + k) * INW + 9216 + c] * gA[l * DM + k]) : (bf16)0; }
    { const float* x = ka->in[0]; float* ssq0 = (float*)(ws + WS_CTL) + CW_SSQ;
      for (int m = gw; m < M; m += NGW) { const GAS f32x4* xr = (const GAS f32x4*)(x + (size_t)m * DM) + lane; bf16* xa = (bf16*)(ws + WS_XN); float sq = 0.f;
#pragma unroll
        for (int j = 0; j < 16; ++j) { const f32x4 v = xr[64 * j]; sq += (v.x * v.x + v.y * v.y) + (v.z * v.z + v.w * v.w); v2u o; o.x = pk2(v.x, v.y); o.y = pk2(v.z, v.w); const int col = 4 * lane + 256 * j; *(GAS v2u*)(xa + ((size_t)(col >> 6) * M + m) * 64 + (col & 63)) = o; }
        sq = wave_sum(sq, lane); if (lane == 0) ssq0[m] = sq; } }
    for (int i = gt; i < SEQ * 64; i += NGT) { const int pos = i >> 6, fi = i & 63;
        const float invf = 1.0f / powf(10000.0f, (float)fi * (1.0f / 64.0f)); const float ang = (float)pos * invf;
        const double rev = (double)ang * 0.15915494309189533576888; const float fr = (float)(rev - rint(rev));
        ((f32x2*)(ws + WS_ROPE))[i] = (f32x2){__builtin_amdgcn_cosf(fr), __builtin_amdgcn_sinf(fr)}; }
}

constexpr int T3B_TILES = M / 16;
#define DPPF(v, ctrl) __int_as_float(__builtin_amdgcn_mov_dpp(__float_as_int(v), (ctrl), 0xf, 0xf, true))
__device__ __forceinline__ void t3_phase(unsigned char* ws, LAS unsigned char* lds, int l, int vcu, int G, int wave0) {
    FRESH_IDS(vcu);
    KArgs ka = kargs();
    { LAS f32x4* red = (LAS f32x4*)(lds + RING_OFF);
      const int tsel = wave >> 2, kq = wave & 3;
      for (int tb0 = vcu * 2; tb0 < T3B_TILES; tb0 += 2 * G) {
        const int t = tb0 + tsel;
        const bf16* A = (const bf16*)(ws + WS_XN) + ((size_t)(kq * 16) * M + (16 * t + (lane & 15))) * 64 + 8 * (lane >> 4);
        const bf16* B = (const bf16*)(ws + WS_WF) + (size_t)l * 16 * DM + (size_t)(lane & 15) * DM + kq * 1024 + 8 * (lane >> 4);
        f32x4 acc = {0.f, 0.f, 0.f, 0.f};
#pragma unroll 16
        for (int i = 0; i < 32; ++i) { const bf16x8 a = *(const bf16x8*)(A + (size_t)(i >> 1) * M * 64 + 32 * (i & 1)), b = *(const bf16x8*)(B + 32 * i); acc = __builtin_amdgcn_mfma_f32_16x16x32_bf16(a, b, acc, 0, 0, 0); }
        red[(tsel * 4 + kq) * 64 + lane] = acc;
        __syncthreads();
        if (kq == 0) {
            const f32x4 s4 = (red[(tsel * 4 + 0) * 64 + lane] + red[(tsel * 4 + 1) * 64 + lane]) + (red[(tsel * 4 + 2) * 64 + lane] + red[(tsel * 4 + 3) * 64 + lane]);
            const int c = lane & 15;
            if (c < 12) { const float fb = ka->in[7][l * 12 + c]; const float* ssq = (const float*)(ws + WS_CTL) + CW_SSQ + 2 * l * M;
                const int row0 = 16 * t + 4 * (lane >> 4), b = row0 / SEQ, s0 = row0 & (SEQ - 1); f32x4 ls;
#pragma unroll
                for (int r = 0; r < 4; ++r) { const float z = s4[r] * pg8::rs_of(ssq, row0 + r, 1.0f / DM, NORM_EPS) + fb; ls[r] = fminf(z, 0.f) - log1pf(expf(-fabsf(z))); }
                *(f32x4*)((float*)(ws + WS_LOGF) + (size_t)(b * 12 + c) * SEQ + s0) = ls; } }
        __syncthreads();
      } }
    bf16* PROJ = (bf16*)(ws + WS_PROJ);
    const int g = gw & 15; constexpr int NCH = M / T3A_ROWS;
    int col0; const float* gsel; bool rot, km = false;
    if (g < 3) { col0 = C_QM + 512 * g; gsel = ka->in[3]; rot = true; }
    else if (g < 6) { col0 = C_KM + 512 * (g - 3); gsel = ka->in[4]; rot = true; km = true; }
    else if (g < 9) { col0 = C_QF + 512 * (g - 6); gsel = ka->in[5]; rot = false; }
    else if (g < 12) { col0 = C_KF + 512 * (g - 9); gsel = ka->in[6]; rot = false; }
    else if (g < 14) { col0 = C_QD + 512 * (g - 12); gsel = ka->in[8]; rot = true; }
    else { col0 = C_KD + 512 * (g - 14); gsel = ka->in[9]; rot = true; }
    const int hv = lane >> 4, c8 = (lane & 15) * 8, cstep = (G * NWAVES) >> 4;
    float gn[8], dc[8], dsn[8];
    { const float* gp = gsel + l * HD + c8;
#pragma unroll
      for (int e = 0; e < 8; ++e) gn[e] = gp[e];
      const GAS f32x4* r1 = (const GAS f32x4*)((const float*)(ws + WS_ROPE) + ((size_t)1 * 64 + (c8 & 63)) * 2);
#pragma unroll
      for (int q = 0; q < 4; ++q) { const f32x4 b = r1[q]; dc[2 * q] = b.x; dsn[2 * q] = b.y; dc[2 * q + 1] = b.z; dsn[2 * q + 1] = b.w; } }
    const bool up = (lane & 8) != 0;
    const unsigned voff = (unsigned)(col0 + hv * 128 + c8) * 2u;
    for (int chunk = gw >> 4; chunk < NCH; chunk += cstep) {
        v4u w[T3A_ROWS]; float cs[8], sn[8];
        { const int row0_ = chunk * T3A_ROWS; GAS char* ub_ = (GAS char*)PROJ + (size_t)row0_ * PW * 2;
#pragma unroll
          for (int rr = 0; rr < T3A_ROWS; ++rr) w[rr] = *(GAS v4u*)(ub_ + (size_t)rr * PW * 2 + voff);
          const GAS f32x4* rp_ = (const GAS f32x4*)((const float*)(ws + WS_ROPE) + ((size_t)(row0_ & (SEQ - 1)) * 64 + (c8 & 63)) * 2);
#pragma unroll
          for (int q = 0; q < 4; ++q) { const f32x4 a = rp_[q]; cs[2 * q] = a.x; sn[2 * q] = a.y; cs[2 * q + 1] = a.z; sn[2 * q + 1] = a.w; } }
        const int row0 = chunk * T3A_ROWS, pos0 = row0 & (SEQ - 1);
        GAS char* ub0 = (GAS char*)PROJ + (size_t)row0 * PW * 2;
        float ks[8];
#pragma unroll
        for (int e = 0; e < 8; ++e) ks[e] = 0.f;
#pragma unroll
        for (int rr = 0; rr < T3A_ROWS; ++rr) {
            float y[8];
            y[0] = bflo(w[rr].x); y[1] = bfhi(w[rr].x); y[2] = bflo(w[rr].y); y[3] = bfhi(w[rr].y); y[4] = bflo(w[rr].z); y[5] = bfhi(w[rr].z); y[6] = bflo(w[rr].w); y[7] = bfhi(w[rr].w);
            float ss = 0.f;
#pragma unroll
            for (int e = 0; e < 8; ++e) ss += y[e] * y[e];
            ss += DPPF(ss, 0xB1); ss += DPPF(ss, 0x4E); ss += DPPF(ss, 0x141); ss += DPPF(ss, 0x140);
            const float sc = 1.0f / sqrtf(ss * (1.0f / HD) + NORM_EPS);
#pragma unroll
            for (int e = 0; e < 8; ++e) y[e] = y[e] * sc * gn[e];
            if (rot) {
#pragma unroll
                for (int e = 0; e < 8; ++e) { const float o = DPPF(y[e], 0x128);
                    y[e] = up ? (y[e] * cs[e] + o * sn[e]) : (y[e] * cs[e] - o * sn[e]);
                    const float cn = cs[e] * dc[e] - sn[e] * dsn[e]; sn[e] = sn[e] * dc[e] + cs[e] * dsn[e]; cs[e] = cn; }
            }
            v4u o; o.x = pk2(y[0], y[1]); o.y = pk2(y[2], y[3]); o.z = pk2(y[4], y[5]); o.w = pk2(y[6], y[7]);
            *(GAS v4u*)(ub0 + (size_t)rr * PW * 2 + voff) = o;
            if (km) {
#pragma unroll
                for (int e = 0; e < 8; ++e) ks[e] += y[e];
            }
        }
        if (km) {
            const int b = row0 / SEQ, blk = pos0 >> 8, sub = (pos0 & 255) / T3A_ROWS, h = 4 * (g - 3) + hv;
            float* kp = (float*)(ws + WS_KPART) + ((((size_t)(b * 12 + h) * NBLK + blk) * KSUB + sub) * HD) + c8;
            *(f32x4*)kp = (f32x4){ks[0], ks[1], ks[2], ks[3]}; *(f32x4*)(kp + 4) = (f32x4){ks[4], ks[5], ks[6], ks[7]};
        }
    }
}
__device__ __forceinline__ void attn_phase(unsigned char* ws, char* lds, int vcu, int G, int wave0, int layer) {
    const int tid = fresh_tid(wave0);
    int qx = (vcu * 8) / G; if (qx > 7) qx = 7;
    unsigned* qctr = (unsigned*)(ws + WS_CTL) + CW_ATTQ + (layer * 8 + qx) * 64;
    if (tid == 0) *(volatile unsigned*)(lds + att::OFF_NXT) = __hip_atomic_fetch_add(qctr, 1u, __ATOMIC_RELAXED, __HIP_MEMORY_SCOPE_AGENT);
    __syncthreads();
    int k = __builtin_amdgcn_readfirstlane((int)*(volatile unsigned*)(lds + att::OFF_NXT));
    __syncthreads();
    if (k >= att::QITEMS) return;
    float fox_thr;
    { const float* gq = kargs()->in[5] + layer * HD; const float* gk_ = kargs()->in[6] + layer * HD; const int lane = tid & 63;
      float mq = fmaxf(fabsf(gq[lane]), fabsf(gq[lane + 64])), mk = fmaxf(fabsf(gk_[lane]), fabsf(gk_[lane + 64]));
      mq = wave_max(mq, lane); mk = wave_max(mk, lane);
      fox_thr = __int_as_float(__builtin_amdgcn_readfirstlane(__float_as_int(106.0f * 11.313708498984761f + 2.0f * (128.0f * 1.02f) * mq * mk))); }
    att::Seam S;
    att::prime(att::q_item(qx, k), ws, lds, S, tid);
    for (;;) {
        const int nk = att::block(att::q_item(qx, k), qctr, qx, ws, lds, S, tid, fox_thr);
        if (nk >= att::QITEMS) break;
        k = nk;
    }
}
__device__ __forceinline__ void t5_phase(unsigned char* ws, int l, int vcu, int NGW, int wave0) {
    FRESH_IDS(vcu);
    KArgs ka = kargs(); const float* q1 = ka->in[10]; const float* k1 = ka->in[11]; const float* q2 = ka->in[12]; const float* k2 = ka->in[13];
    float s1 = q1[l * HD + lane] * k1[l * HD + lane] + q1[l * HD + 64 + lane] * k1[l * HD + 64 + lane];
    float s2 = q2[l * HD + lane] * k2[l * HD + lane] + q2[l * HD + 64 + lane] * k2[l * HD + 64 + lane];
    const float lam_init = 0.8f - 0.6f * expf(-0.3f * (float)l);
    const float lam = expf(wave_sum(s1, lane)) - expf(wave_sum(s2, lane)) + lam_init;
    const f32x4 gn = *(const f32x4*)(ka->in[14] + l * 256 + 4 * lane);
    const bf16* D0 = (const bf16*)(ws + WS_DIFF); const bf16* D1 = D0 + (size_t)M * 1024; bf16* MIX = (bf16*)(ws + WS_MIX);
    for (int it = gw; it < M * NH_D; it += NGW) {
        const int row = it >> 2, h = it & 3;
        const v2u a = *(const v2u*)(D0 + (size_t)row * 1024 + h * 256 + 4 * lane), b = *(const v2u*)(D1 + (size_t)row * 1024 + h * 256 + 4 * lane);
        const float v0 = bflo(a.x) - lam * bflo(b.x), v1 = bfhi(a.x) - lam * bfhi(b.x), v2 = bflo(a.y) - lam * bflo(b.y), v3 = bfhi(a.y) - lam * bfhi(b.y);
        const float ss = wave_sum((v0 * v0 + v1 * v1) + (v2 * v2 + v3 * v3), lane);
        const float sc = (1.0f / sqrtf(ss * (1.0f / 256.0f) + NORM_EPS)) * (1.0f - lam_init);
        v2u o; o.x = pk2(v0 * sc * gn.x, v1 * sc * gn.y); o.y = pk2(v2 * sc * gn.z, v3 * sc * gn.w);
        { const int col = 3072 + h * 256 + 4 * lane; *(v2u*)(MIX + ((size_t)(col >> 6) * M + row) * 64 + (col & 63)) = o; }
    }
}

__global__ void __launch_bounds__(NWAVES * 64, 2) mk_fwd(Args args_unused) {
    extern __shared__ __attribute__((aligned(16))) unsigned char lds_raw[];
    LAS unsigned char* lds = (LAS unsigned char*)lds_raw;
    volatile LAS unsigned* MISC = (volatile LAS unsigned*)(lds + MISC_OFF);
    const int wave0 = __builtin_amdgcn_readfirstlane((int)threadIdx.x >> 6);
    const int tid = fresh_tid(wave0);
    const int G = gridDim.x; const int bx = blockIdx.x; const int vcu = (G % 8 == 0) ? (bx % 8) * (G / 8) + bx / 8 : bx;
    const int NGW = G * NWAVES;
    for (int u = tid; u < (LDS_BYTES - LDSCTL_OFF) / 4; u += NWAVES * 64) ((LAS unsigned*)(lds + LDSCTL_OFF))[u] = 0u;
    __syncthreads();
    XcdBarrier bar; { unsigned char* ws0 = kargs()->ws; bar.bar = (unsigned*)(ws0 + WS_CTL) + CW_BAR; bar.x = 0; bar.st = nullptr;
        if (MK_N_LAUNCHES == 1) bar = xcd_barrier_post((unsigned*)(ws0 + WS_CTL) + CW_BAR, MISC + 8); }
#define GRID_BAR() do { if (MK_N_LAUNCHES == 1) xcd_barrier(bar); } while (0)
    const int lo = kargs()->ph_lo, hi = kargs()->ph_hi;
#define IN(k) (lo <= (k) && (k) < hi)
    unsigned long long tpA = 0ull, tpD = 0ull;
#define TP_BEGIN(k) do { if (MK_TIME_PHASE >= 0 && (k) == MK_TIME_PHASE) tpA = __builtin_amdgcn_s_memrealtime(); } while (0)
#define TP_END(k) do { if (MK_TIME_PHASE >= 0 && (k) == MK_TIME_PHASE) tpD = __builtin_amdgcn_s_memrealtime() - tpA; } while (0)
#define BOTH(k) (IN(k) && IN((k) + 1))
    if (IN(0)) { TP_BEGIN(0); for (int rep = 0; rep < REPS(100); ++rep) p0_prologue(kargs()->ws, lds, vcu, NGW, wave0, 0, 0); if (BOTH(0)) GRID_BAR(); TP_END(0); }
    for (int l = 0; l < DEPTH; ++l) {
        const int pb = 2 + 8 * l;
        if (l > 0 && IN(pb - 1)) { TP_BEGIN(pb - 1); p0_prologue(kargs()->ws, lds, vcu, NGW, wave0, l, 0); if (BOTH(pb - 1)) GRID_BAR(); TP_END(pb - 1); }
        if (IN(pb + 0)) { TP_BEGIN(pb + 0); unsigned char* ws = kargs()->ws;
            pg8::Gemm g{(const bf16*)(ws + WS_XN), (const bf16*)(ws + WS_WIN) + (size_t)l * PW * DM, M, PW, DM}; pg8::StaticOrder S; S.init(M, PW, G, bx);
            pg8::EpiStoreBf16 E{(bf16*)(ws + WS_PROJ), PW, (const float*)(ws + WS_CTL) + CW_SSQ + 2 * l * M, 1.0f / DM, NORM_EPS};
            for (int rep = 0; rep < REPS(0); ++rep) pg8::gemm_phase<pg8::EpiStoreBf16, pg8::StaticOrder, true, true, true>(lds + RING_OFF, g, S, E, fresh_tid(wave0));
            if (BOTH(pb + 0)) GRID_BAR(); TP_END(pb + 0); }
        if (IN(pb + 1)) { TP_BEGIN(pb + 1); t3_phase(kargs()->ws, lds, l, vcu, G, wave0); p0_prologue(kargs()->ws, lds, vcu, NGW, wave0, l, 1);     if (BOTH(pb + 1)) GRID_BAR(); TP_END(pb + 1); }
        if (IN(pb + 2)) { TP_BEGIN(pb + 2);
            attn_phase(kargs()->ws, (char*)lds_raw + RING_OFF, vcu, G, wave0, l);
            if (BOTH(pb + 2)) GRID_BAR(); TP_END(pb + 2); }
        if (IN(pb + 3)) { TP_BEGIN(pb + 3); for (int rep = 0; rep < REPS(4); ++rep) t5_phase(kargs()->ws, l, vcu, NGW, wave0); if (BOTH(pb + 3)) GRID_BAR(); TP_END(pb + 3); }
        if (IN(pb + 4)) { TP_BEGIN(pb + 4); KArgs ka = kargs(); unsigned char* ws = ka->ws; const float* xin = (l == 0) ? ka->in[0] : (const float*)(ws + WS_XB);
            pg8::Gemm g{(const bf16*)(ws + WS_MIX), (const bf16*)(ws + WS_WOUT) + (size_t)l * DM * DM, M, DM, DM}; pg8::StaticOrder S; S.init(M, DM, G, bx);
            pg8::EpiResid E{xin, ka->out, DM, (bf16*)(ws + WS_XN), (float*)(ws + WS_CTL) + CW_SSQ + (2 * l + 1) * M, (float*)(ws + WS_SSP) + (size_t)(2 * l) * M * 16, (unsigned*)(ws + WS_CTL) + CW_PCNT + (2 * l) * 32 * 64, (LAS float*)(lds + XL_OFF), DM / 256, M};
            pg8::gemm_phase<pg8::EpiResid, pg8::StaticOrder, true, true, true>(lds + RING_OFF, g, S, E, fresh_tid(wave0));
            p0_prologue(ws, lds, vcu, NGW, wave0, l, 2);
            if (BOTH(pb + 4)) GRID_BAR(); TP_END(pb + 4); }
        if (IN(pb + 5)) { TP_BEGIN(pb + 5); unsigned char* ws = kargs()->ws;
            pg8::Gemm g{(const bf16*)(ws + WS_XN), (const bf16*)(ws + WS_WGU) + (size_t)l * NGU * DM, M, NGU, DM}; pg8::StaticOrder S; S.init(M, NGU, G, bx);
            pg8::EpiSwiGLU E{(bf16*)(ws + WS_HB), FF, (const float*)(ws + WS_CTL) + CW_SSQ + (2 * l + 1) * M, 1.0f / DM, NORM_EPS, M};
            for (int rep = 0; rep < REPS(6); ++rep) pg8::gemm_phase<pg8::EpiSwiGLU, pg8::StaticOrder, true, true, true>(lds + RING_OFF, g, S, E, fresh_tid(wave0));
            p0_prologue(ws, lds, vcu, NGW, wave0, l, 3);
            if (BOTH(pb + 5)) GRID_BAR(); TP_END(pb + 5); }
        if (IN(pb + 6)) { TP_BEGIN(pb + 6); KArgs ka = kargs(); unsigned char* ws = ka->ws; const bool lastl = (l == DEPTH - 1); float* x2 = lastl ? ka->out : (float*)(ws + WS_XB);
            pg8::Gemm g{(const bf16*)(ws + WS_HB), (const bf16*)(ws + WS_WD) + (size_t)l * DM * FF, M, DM, FF}; pg8::StaticOrder S; S.init(M, DM, G, bx);
            pg8::EpiResid E{ka->out, x2, DM, lastl ? (bf16*)nullptr : (bf16*)(ws + WS_XN), (float*)(ws + WS_CTL) + CW_SSQ + (2 * l + 2) * M, (float*)(ws + WS_SSP) + (size_t)(2 * l + 1) * M * 16, (unsigned*)(ws + WS_CTL) + CW_PCNT + (2 * l + 1) * 32 * 64, (LAS float*)(lds + XL_OFF), DM / 256, M};
            pg8::gemm_phase<pg8::EpiResid, pg8::StaticOrder, true, true, true>(lds + RING_OFF, g, S, E, fresh_tid(wave0));
              TP_END(pb + 6); }
    }
    if (MK_TIME_PHASE >= 0 && blockIdx.x == 0) { const unsigned long long t0 = __builtin_amdgcn_s_memrealtime(); while (__builtin_amdgcn_s_memrealtime() - t0 < tpD) __builtin_amdgcn_s_sleep(8); }
#undef IN
#undef BOTH
}

extern "C" void kernel_launch(void* const* d_in, const int* in_sizes, int n_in, void* d_out, int out_size, void* d_ws, size_t ws_size, hipStream_t stream) {
    static int grid = 0;
    if (grid == 0) {
        if (n_in != 20 || in_sizes[0] != M * DM || out_size != M * DM || ws_size < WS_END) { fprintf(stderr, "kernel_launch: unexpected shapes (n_in %d, in0 %d, out %d, ws %zu < %zu); nothing launched\n", n_in, n_in > 0 ? in_sizes[0] : -1, out_size, ws_size, (size_t)WS_END); grid = -1; return; }
        int dev = 0, cus = 0, per_cu = 0;
        if (hipGetDevice(&dev) != hipSuccess || hipDeviceGetAttribute(&cus, hipDeviceAttributeMultiprocessorCount, dev) != hipSuccess) { grid = -1; return; }
        if (hipFuncSetAttribute((const void*)mk_fwd, hipFuncAttributeMaxDynamicSharedMemorySize, LDS_BYTES) != hipSuccess) { fprintf(stderr, "kernel_launch: hipFuncSetAttribute failed\n"); grid = -1; return; }
        if (hipOccupancyMaxActiveBlocksPerMultiprocessor(&per_cu, (const void*)mk_fwd, NWAVES * 64, LDS_BYTES) != hipSuccess || per_cu < 1) fprintf(stderr, "kernel_launch: occupancy query says %d\n", per_cu);
        (void)hipGetLastError();
        grid = cus;
    }
    if (grid < 0) return;
    if (hipMemsetAsync((char*)d_ws + WS_CTL, 0, CTL_ZERO_BYTES, stream) != hipSuccess) return;
    Args a{};
    for (int i = 0; i < 20; ++i) a.in[i] = (const float*)d_in[i];
    a.out = (float*)d_out; a.ws = (unsigned char*)d_ws;
    if (MK_N_LAUNCHES == 1) { a.ph_lo = 0; a.ph_hi = NPH; hipLaunchKernelGGL(mk_fwd, dim3(grid), dim3(NWAVES * 64), LDS_BYTES, stream, a); }
    else for (int p = 0; p < NPH; ++p) { a.ph_lo = p; a.ph_hi = p + 1; hipLaunchKernelGGL(mk_fwd, dim3(grid), dim3(NWAVES * 64), LDS_BYTES, stream, a); }
}
```

```cpp
#include <hip/hip_runtime.h>
#include <cstdio>
#include <cstdint>
#include <cmath>
namespace pg8 {
#define PG8_LAS __attribute__((address_space(3)))
typedef unsigned short bf16_t;
typedef short bf16x8 __attribute__((ext_vector_type(8)));
typedef float f32x4 __attribute__((ext_vector_type(4)));
typedef unsigned u32x4 __attribute__((ext_vector_type(4)));
constexpr int BM = 256, BK = 64, HALF = 128, HTB = HALF * BK * 2  , STAGE_BYTES = 8 * HTB, NXCD = 8, WGM = 8;

__host__ __device__ __forceinline__ int lds_byte(int r, int c) { const int st = (r >> 4) * 2 + (c >> 5), rr = r & 15, cc = c & 31, ob = rr * 64 + cc * 2; return st * 1024 + (ob ^ (((ob >> 9) & 1) << 5)); }
__host__ __device__ __forceinline__ void stage_rc(int b, int& R, int& C) { const int st = b / 1024, sb = b % 1024, swz = sb ^ (((sb >> 9) & 1) << 5); R = (st >> 1) * 16 + swz / 64; C = (st & 1) * 32 + (swz % 64) / 2; }
__host__ __device__ __forceinline__ int perm32(int rho) { const int n = rho >> 4, i = rho & 15; return 8 * (i >> 2) + 4 * n + (i & 3); }

struct Unit { int pm, pn; };
struct Gemm { const bf16_t* A; const bf16_t* Bt; int M, N, K; };

struct StaticOrder {
    int nM, nN, nwg, G, c;
    __host__ __device__ void init(int M, int N, int G_, int c_) { nM = M / BM; nN = N / BM; nwg = nM * nN; G = G_; c = c_; }
    __host__ __device__ bool next(int i, Unit& u) const {
        const long L = (long)i * G + c; if (L >= nwg) return false;
        int wgid = (int)L; { const int q = nwg / NXCD, r = nwg % NXCD, xcd = wgid % NXCD, off = wgid / NXCD; wgid = (xcd < r ? xcd * (q + 1) : r * (q + 1) + (xcd - r) * q) + off; }
        const int nig = WGM * nN, gid = wgid / nig, fm = gid * WGM, gsz = (nM - fm) < WGM ? (nM - fm) : WGM;
        u.pm = fm + ((wgid % nig) % gsz); u.pn = (wgid % nig) / gsz; return true;
    }
    __device__ __forceinline__ void a_ready(const Unit&) const {}
    __device__ __forceinline__ void done(const Unit&) const {}
};

__device__ __forceinline__ unsigned cvt_pk_bf16(float lo, float hi) { unsigned r; asm volatile("v_cvt_pk_bf16_f32 %0, %1, %2" : "=v"(r) : "v"(lo), "v"(hi)); return r; }
__device__ __forceinline__ float rs_of(const float* ssq, int row, float inv_k, float eps) { (void)inv_k; (void)eps; return ssq[row]; }
struct EpiStoreBf16 {
    static constexpr bool PERM = true, AFTER_DRAIN = false;
    bf16_t* O; int ldc; const float* ssq; float inv_k, eps;
    __device__ __forceinline__ void prefetch(const Unit& u, int wr, int fr, float (&pre)[8]) const {
#pragma unroll
        for (int i = 0; i < 8; ++i) pre[i] = ssq[u.pm * BM + wr * 64 + fr + (i >> 2) * HALF + (i & 3) * 16]; }
    __device__ __forceinline__ void operator()(const f32x4 (&acc)[2][2][4][2], const Unit& u, int wr, int wc, int fr, int fq, const float (&pre)[8]) const {
        const int row0 = u.pm * BM + wr * 64 + fr, col0 = u.pn * BM + wc * 32 + 8 * fq;
#pragma unroll
        for (int ai = 0; ai < 2; ++ai)
#pragma unroll
            for (int m = 0; m < 4; ++m) { const int row = row0 + ai * HALF + m * 16; bf16_t* rowp = O + (size_t)row * ldc + col0; const float r = pre[ai * 4 + m];
#pragma unroll
                for (int bj = 0; bj < 2; ++bj) { const f32x4 v0 = acc[ai][bj][m][0] * r, v1 = acc[ai][bj][m][1] * r;
                    u32x4 w; w.x = cvt_pk_bf16(v0[0], v0[1]); w.y = cvt_pk_bf16(v0[2], v0[3]); w.z = cvt_pk_bf16(v1[0], v1[1]); w.w = cvt_pk_bf16(v1[2], v1[3]);
                    *(u32x4*)(rowp + bj * HALF) = w; } }
    }
};
__device__ __forceinline__ float silu_mul(float g, float u) { const float e = __builtin_amdgcn_exp2f(-g * 1.4426950408889634f); return g * __builtin_amdgcn_rcpf(1.0f + e) * u; }
struct EpiSwiGLU {
    static constexpr bool PERM = true, AFTER_DRAIN = false;
    bf16_t* O; int ldc; const float* ssq; float inv_k, eps; int tiledM;
    __device__ __forceinline__ void prefetch(const Unit& u, int wr, int fr, float (&pre)[8]) const {
#pragma unroll
        for (int i = 0; i < 8; ++i) pre[i] = ssq[u.pm * BM + wr * 64 + fr + (i >> 2) * HALF + (i & 3) * 16]; }
    __device__ __forceinline__ void operator()(const f32x4 (&acc)[2][2][4][2], const Unit& u, int wr, int wc, int fr, int fq, const float (&pre)[8]) const {
        const int row0 = u.pm * BM + wr * 64 + fr, col0 = u.pn * HALF + wc * 32 + 8 * fq;
#pragma unroll
        for (int ai = 0; ai < 2; ++ai)
#pragma unroll
            for (int m = 0; m < 4; ++m) { const int row = row0 + ai * HALF + m * 16; const float r = pre[ai * 4 + m];
                bf16_t* rowp = tiledM ? O + ((size_t)(col0 >> 6) * tiledM + row) * 64 + (col0 & 63) : O + (size_t)row * ldc + col0;
                const f32x4 g0 = acc[ai][0][m][0] * r, g1 = acc[ai][0][m][1] * r, u0 = acc[ai][1][m][0] * r, u1 = acc[ai][1][m][1] * r;
                u32x4 w; w.x = cvt_pk_bf16(silu_mul(g0[0], u0[0]), silu_mul(g0[1], u0[1])); w.y = cvt_pk_bf16(silu_mul(g0[2], u0[2]), silu_mul(g0[3], u0[3]));
                w.z = cvt_pk_bf16(silu_mul(g1[0], u1[0]), silu_mul(g1[1], u1[1])); w.w = cvt_pk_bf16(silu_mul(g1[2], u1[2]), silu_mul(g1[3], u1[3]));
                *(u32x4*)rowp = w; }
    }
};
struct EpiResid {
    static constexpr bool PERM = false, AFTER_DRAIN = false;
    const float* base; float* out; int ldc; bf16_t* xb; float* ssq; float* ssp; unsigned* pcnt; PG8_LAS float* xl; int ntn; int xbM; float rs_inv_k, rs_eps;
    __device__ __forceinline__ void prefetch(const Unit&, int, int, float (&)[8]) const {}
    __device__ __forceinline__ void operator()(const f32x4 (&acc)[2][2][4][2], const Unit& u, int wr, int wc, int fr, int fq, const float (&)[8]) const {
        const int row0 = u.pm * BM + wr * 64 + fr, col0 = u.pn * BM + wc * 32 + 4 * fq; const int lane = fr + 16 * fq, tid = (wr * 4 + wc) * 64 + lane;
        typedef unsigned u32x2 __attribute__((ext_vector_type(2)));
#pragma unroll
        for (int ai = 0; ai < 2; ++ai)
#pragma unroll
            for (int m = 0; m < 4; ++m) { const int row = row0 + ai * HALF + m * 16; const size_t off = (size_t)row * ldc + col0; float ss = 0.f;
#pragma unroll
                for (int bj = 0; bj < 2; ++bj)
#pragma unroll
                    for (int n = 0; n < 2; ++n) { const f32x4 b = *(const f32x4*)(base + off + bj * HALF + n * 16); const f32x4 o = b + acc[ai][bj][m][n]; *(f32x4*)(out + off + bj * HALF + n * 16) = o;
                        if (xb) { u32x2 w; w.x = cvt_pk_bf16(o[0], o[1]); w.y = cvt_pk_bf16(o[2], o[3]); const int col = col0 + bj * HALF + n * 16; *(u32x2*)(xb + ((size_t)(col >> 6) * xbM + row) * 64 + (col & 63)) = w; }
                        ss += (o[0] * o[0] + o[1] * o[1]) + (o[2] * o[2] + o[3] * o[3]); }
                if (xb) { ss += __int_as_float(__builtin_amdgcn_ds_bpermute((lane ^ 16) << 2, __float_as_int(ss))); ss += __int_as_float(__builtin_amdgcn_ds_bpermute((lane ^ 32) << 2, __float_as_int(ss)));
                    if (fq == 0) xl[(ai * HALF + wr * 64 + m * 16 + fr) * 4 + wc] = ss; } }
        if (xb) {
            asm volatile("s_waitcnt lgkmcnt(0)" ::: "memory"); __builtin_amdgcn_s_barrier(); asm volatile("" ::: "memory");
            if (tid < BM) { const f32x4 p4 = *(const PG8_LAS f32x4*)(xl + tid * 4); const float t = (p4[0] + p4[1]) + (p4[2] + p4[3]);
                __hip_atomic_store(ssp + (size_t)(u.pm * BM + tid) * 16 + u.pn, t, __ATOMIC_RELAXED, __HIP_MEMORY_SCOPE_AGENT); }
            asm volatile("s_waitcnt vmcnt(0)" ::: "memory");
            __builtin_amdgcn_s_barrier(); asm volatile("" ::: "memory");
            if (tid == 0) { const unsigned old = __hip_atomic_fetch_add(pcnt + 64 * u.pm, 1u, __ATOMIC_RELAXED, __HIP_MEMORY_SCOPE_AGENT); ((PG8_LAS unsigned*)xl)[1024] = (old == (unsigned)(ntn - 1)) ? 1u : 0u; }
            asm volatile("s_waitcnt vmcnt(0) lgkmcnt(0)" ::: "memory"); __builtin_amdgcn_s_barrier(); asm volatile("" ::: "memory");
            if (((volatile PG8_LAS unsigned*)xl)[1024] != 0u && tid < BM) {
                __builtin_amdgcn_fence(__ATOMIC_ACQUIRE, "agent");
                const float* pp = ssp + (size_t)(u.pm * BM + tid) * 16; float t = 0.f;
                for (int j = 0; j < ntn; ++j) t += __hip_atomic_load(pp + j, __ATOMIC_RELAXED, __HIP_MEMORY_SCOPE_AGENT);
                ssq[u.pm * BM + tid] = 1.0f / sqrtf(t * rs_inv_k + rs_eps); }
        }
    }
};

template <class Epi, class Sched, bool ALIGN_EPI = false, bool SP2 = false, bool TILED = false>
__device__ __forceinline__ void gemm_phase(PG8_LAS unsigned char* lds, const Gemm g, const Sched& S, const Epi& E, int tid_) {
    asm volatile("" : "+v"(tid_));
    const int tid = tid_, wid = __builtin_amdgcn_readfirstlane(tid >> 6), lane = tid & 63, wr = wid >> 2, wc = wid & 3, fr = lane & 15, fq = lane >> 4;
    const int K = g.K, nt = K / BK; const int RP = TILED ? BK : K;
    unsigned voffA[2], voffB[2];
#pragma unroll
    for (int i = 0; i < 2; ++i) { int R, C; stage_rc(tid * 16 + i * 8192, R, C); const int Rb = Epi::PERM ? ((R & ~31) + perm32(R & 31)) : R;
        voffA[i] = (unsigned)(R * RP + C) * 2u; voffB[i] = (unsigned)(Rb * RP + C) * 2u; }
    const size_t kstepA = TILED ? (size_t)g.M * BK * 2 : (size_t)(BK * 2), kstepB = TILED ? (size_t)g.N * BK * 2 : (size_t)(BK * 2);
    const size_t hstep = (size_t)HALF * RP * 2;
    const size_t tstep = 2 * hstep;
    const unsigned ldsw = (unsigned)wid * 1024u;
    const int aoff = lds_byte(wr * 64 + fr, fq * 8), boff = lds_byte(wc * 32 + fr, fq * 8);
#define PG8_SA(b, h) (((b) * 2 + (h)) * HTB)
#define PG8_SB(b, h) ((4 + (b) * 2 + (h)) * HTB)
#define PG8_STAGE(bufoff, gbase, voff) do { _Pragma("unroll") for (int _i = 0; _i < 2; ++_i) \
        __builtin_amdgcn_global_load_lds((const unsigned*)((const char*)(gbase) + (voff)[_i]), (PG8_LAS unsigned*)(lds + (bufoff) + ldsw + _i * 8192), 16, 0, 0); } while (0)
#define PG8_LDA(dst, b, h) do { _Pragma("unroll") for (int m = 0; m < 4; ++m) _Pragma("unroll") for (int k = 0; k < 2; ++k) dst[m][k] = *(const PG8_LAS bf16x8*)(lds + PG8_SA(b, h) + aoff + m * 2048 + k * 1024); } while (0)
#define PG8_LDB(dst, b, h) do { _Pragma("unroll") for (int n = 0; n < 2; ++n) _Pragma("unroll") for (int k = 0; k < 2; ++k) dst[n][k] = *(const PG8_LAS bf16x8*)(lds + PG8_SB(b, h) + boff + n * 2048 + k * 1024); } while (0)
#define PG8_MMA(ai, bj, At, Bt) do { __builtin_amdgcn_s_setprio(1); _Pragma("unroll") for (int m = 0; m < 4; ++m) _Pragma("unroll") for (int n = 0; n < 2; ++n) _Pragma("unroll") for (int k = 0; k < 2; ++k) \
        acc[ai][bj][m][n] = __builtin_amdgcn_mfma_f32_16x16x32_bf16(Bt[n][k], At[m][k], acc[ai][bj][m][n], 0, 0, 0); __builtin_amdgcn_s_setprio(0); } while (0)
#define PG8_WAIT_V(n) asm volatile("s_waitcnt vmcnt(" #n ")" ::: "memory")
#define PG8_WAIT_L(n) asm volatile("s_waitcnt lgkmcnt(" #n ")" ::: "memory")
#define PG8_BAR __builtin_amdgcn_s_barrier()
#define PG8_SCHED __builtin_amdgcn_sched_barrier(0)
    Unit cur, nxt; int ui = 0;
    if (!S.next(0, cur)) return;
    f32x4 acc[2][2][4][2];
    float pre[8];
#pragma unroll
    for (int i_ = 0; i_ < 8; ++i_) pre[i_] = 0.f;
#pragma unroll
    for (int a = 0; a < 2; ++a)
#pragma unroll
        for (int b = 0; b < 2; ++b)
#pragma unroll
            for (int m = 0; m < 4; ++m)
#pragma unroll
                for (int n = 0; n < 2; ++n) acc[a][b][m][n] = (f32x4){0.f, 0.f, 0.f, 0.f};
    bf16x8 At[4][2], B0[2][2], B1[2][2];
    const char* cA = (const char*)g.A + (size_t)cur.pm * tstep; const char* cB = (const char*)g.Bt + (size_t)cur.pn * tstep;
    S.a_ready(cur);
    if constexpr (SP2) {
        PG8_STAGE(PG8_SB(0, 0), cB, voffB); PG8_STAGE(PG8_SB(0, 1), cB + hstep, voffB); PG8_STAGE(PG8_SA(0, 0), cA, voffA); PG8_STAGE(PG8_SA(0, 1), cA + hstep, voffA);
        if (wr == 1) PG8_BAR;
        PG8_WAIT_V(2); PG8_BAR;
        PG8_STAGE(PG8_SB(1, 0), cB + kstepB, voffB); PG8_STAGE(PG8_SA(1, 0), cA + kstepA, voffA); PG8_STAGE(PG8_SB(1, 1), cB + hstep + kstepB, voffB);
        PG8_WAIT_V(6); PG8_BAR;
    } else {
        PG8_STAGE(PG8_SB(0, 0), cB, voffB); PG8_STAGE(PG8_SA(0, 0), cA, voffA); PG8_STAGE(PG8_SB(0, 1), cB + hstep, voffB); PG8_STAGE(PG8_SA(0, 1), cA + hstep, voffA);
        if (wr == 1) PG8_BAR;
        PG8_WAIT_V(4); PG8_BAR;
        PG8_STAGE(PG8_SB(1, 0), cB + kstepB, voffB); PG8_STAGE(PG8_SA(1, 0), cA + kstepA, voffA); PG8_STAGE(PG8_SB(1, 1), cB + hstep + kstepB, voffB);
        PG8_WAIT_V(6); PG8_BAR;
    }
    for (;;) {
        const bool has_next = S.next(ui + 1, nxt);
        const char* nA = has_next ? (const char*)g.A + (size_t)nxt.pm * tstep : cA; const char* nB = has_next ? (const char*)g.Bt + (size_t)nxt.pn * tstep : cB;
        for (int t = 0; t < nt; t += 2) {
            const bool last = (t == nt - 2);
            if (last) E.prefetch(cur, wr, fr, pre);
            const char* a1 = cA + (size_t)(t + 1) * kstepA;
            const char* a2 = last ? nA : cA + (size_t)(t + 2) * kstepA; const char* b2 = last ? nB : cB + (size_t)(t + 2) * kstepB;
            const char* a3 = a2 + kstepA; const char* b3 = b2 + kstepB;
            if (last && has_next) S.a_ready(nxt);
            if constexpr (SP2) {
            PG8_LDB(B0, 0, 0); PG8_LDB(B1, 0, 1); PG8_SCHED; PG8_LDA(At, 0, 0); PG8_STAGE(PG8_SA(1, 1), a1 + hstep, voffA);
            PG8_WAIT_V(8); PG8_WAIT_L(0); PG8_BAR; PG8_MMA(0, 0, At, B0); PG8_MMA(0, 1, At, B1); PG8_BAR; PG8_SCHED;
            PG8_LDA(At, 0, 1); PG8_STAGE(PG8_SB(0, 0), b2, voffB); PG8_STAGE(PG8_SB(0, 1), b2 + hstep, voffB); PG8_STAGE(PG8_SA(0, 0), a2, voffA);
            PG8_WAIT_V(8); PG8_WAIT_L(0); PG8_BAR; PG8_MMA(1, 0, At, B0); PG8_MMA(1, 1, At, B1); PG8_BAR; PG8_SCHED;
            PG8_LDB(B0, 1, 0); PG8_LDB(B1, 1, 1); PG8_SCHED; PG8_LDA(At, 1, 0); PG8_STAGE(PG8_SA(0, 1), a2 + hstep, voffA);
            PG8_WAIT_V(8); PG8_WAIT_L(0); PG8_BAR; PG8_MMA(0, 0, At, B0); PG8_MMA(0, 1, At, B1); PG8_BAR; PG8_SCHED;
            PG8_LDA(At, 1, 1); PG8_STAGE(PG8_SB(1, 0), b3, voffB); PG8_STAGE(PG8_SB(1, 1), b3 + hstep, voffB); PG8_STAGE(PG8_SA(1, 0), a3, voffA);
            PG8_WAIT_V(8); PG8_WAIT_L(0); PG8_BAR; PG8_MMA(1, 0, At, B0); PG8_MMA(1, 1, At, B1); PG8_BAR; PG8_SCHED;
            } else {
            PG8_LDB(B0, 0, 0); PG8_SCHED; PG8_LDA(At, 0, 0); PG8_STAGE(PG8_SA(1, 1), a1 + hstep, voffA);
            PG8_WAIT_L(8); PG8_BAR; PG8_WAIT_L(0); PG8_MMA(0, 0, At, B0); PG8_BAR; PG8_SCHED;
            PG8_LDB(B1, 0, 1); PG8_STAGE(PG8_SB(0, 0), b2, voffB);
            PG8_BAR; PG8_WAIT_L(0); PG8_MMA(0, 1, At, B1); PG8_BAR;
            PG8_LDA(At, 0, 1); PG8_STAGE(PG8_SA(0, 0), a2, voffA);
            PG8_BAR; PG8_WAIT_L(0); PG8_MMA(1, 0, At, B0); PG8_BAR; PG8_SCHED;
            PG8_STAGE(PG8_SB(0, 1), b2 + hstep, voffB);
            PG8_WAIT_V(6); PG8_BAR; PG8_MMA(1, 1, At, B1); PG8_BAR;
            PG8_LDB(B0, 1, 0); PG8_SCHED; PG8_LDA(At, 1, 0); PG8_STAGE(PG8_SA(0, 1), a2 + hstep, voffA);
            PG8_WAIT_L(8); PG8_BAR; PG8_WAIT_L(0); PG8_MMA(0, 0, At, B0); PG8_BAR; PG8_SCHED;
            PG8_LDB(B1, 1, 1); PG8_STAGE(PG8_SB(1, 0), b3, voffB);
            PG8_BAR; PG8_WAIT_L(0); PG8_MMA(0, 1, At, B1); PG8_BAR;
            PG8_LDA(At, 1, 1); PG8_STAGE(PG8_SA(1, 0), a3, voffA);
            PG8_BAR; PG8_WAIT_L(0); PG8_MMA(1, 0, At, B0); PG8_BAR; PG8_SCHED;
            PG8_STAGE(PG8_SB(1, 1), b3 + hstep, voffB);
            PG8_WAIT_V(6); PG8_BAR; PG8_MMA(1, 1, At, B1); PG8_BAR;
            }
        }
        if constexpr (ALIGN_EPI) { if (wr == 0) PG8_BAR; }
        if constexpr (!Epi::AFTER_DRAIN) { E(acc, cur, wr, wc, fr, fq, pre); S.done(cur); }
        if (!has_next) break;
#pragma unroll
        for (int a = 0; a < 2; ++a)
#pragma unroll
            for (int b = 0; b < 2; ++b)
#pragma unroll
                for (int m = 0; m < 4; ++m)
#pragma unroll
                    for (int n = 0; n < 2; ++n) acc[a][b][m][n] = (f32x4){0.f, 0.f, 0.f, 0.f};
        cur = nxt; cA = nA; cB = nB; ++ui;
        if constexpr (ALIGN_EPI) { if (wr == 1) PG8_BAR; }
    }
    PG8_WAIT_V(0);
    if constexpr (!ALIGN_EPI) { if (wr == 0) PG8_BAR; }
    PG8_BAR;
    if constexpr (Epi::AFTER_DRAIN) { E.fused(acc, cur, wr, wc, fr, fq, lds, wid, lane); S.done(cur); }
#undef PG8_SA
#undef PG8_SB
#undef PG8_STAGE
#undef PG8_LDA
#undef PG8_LDB
#undef PG8_MMA
#undef PG8_WAIT_V
#undef PG8_WAIT_L
#undef PG8_BAR
#undef PG8_SCHED
}
}
#ifndef MK_N_LAUNCHES
#define MK_N_LAUNCHES 1
#endif
constexpr int NWAVES = 8;
#ifndef MK_REP_PHASE
#define MK_REP_PHASE -1
#endif
#define REPS(k) (((k) == MK_REP_PHASE) ? 2 : 1)
#ifndef MK_TIME_PHASE
#define MK_TIME_PHASE -1
#endif
constexpr int BATCH = 2, SEQ = 4096, DM = 4096, M = BATCH * SEQ, DEPTH = 2;
constexpr int HD = 128, NH_M = 12, NH_F = 12, NH_D = 4;
constexpr int INW = 12300;
constexpr int PW = 12288;
constexpr int FF = 11008, NGU = 2 * FF;
constexpr int C_QM = 0, C_KM = 1536, C_VM = 3072, C_QF = 4608, C_KF = 6144, C_VF = 7680, C_QD = 9216, C_KD = 10240, C_VD = 11264;
constexpr int NBLK = SEQ / 256;
constexpr int T3A_ROWS = 16, KSUB = 256 / T3A_ROWS;
constexpr float NORM_EPS = 1e-6f;
constexpr int NATT = 40;
constexpr int NPH = 1 + 8 * DEPTH;
constexpr size_t MiB = 1u << 20;
constexpr size_t WS_CTL = 0, CTL_ZERO_BYTES = 400 * 1024;
constexpr size_t WS_ROPE = 1 * MiB;
constexpr size_t WS_WF = 3 * MiB;
constexpr size_t WS_LOGF = 4 * MiB;
constexpr size_t WS_BRAW = 5 * MiB;
constexpr size_t WS_SELM = 6 * MiB;
constexpr size_t WS_SSP = 9 * MiB;
constexpr size_t WS_KPART = 10 * MiB + 512 * 1024;
constexpr size_t WS_WIN = 16 * MiB;
constexpr size_t WS_WOUT = 208 * MiB;
constexpr size_t WS_WGU = 272 * MiB;
constexpr size_t WS_WD = 616 * MiB;
constexpr size_t WS_XN = 788 * MiB;
constexpr size_t WS_PROJ = 852 * MiB;
constexpr size_t WS_HB = 852 * MiB;
constexpr size_t WS_MIX = 1044 * MiB;
constexpr size_t WS_DIFF = 1108 * MiB;
constexpr size_t WS_XB = 1140 * MiB;
constexpr size_t WS_END = 1268 * MiB;
static_assert(WS_WIN + (size_t)DEPTH * PW * DM * 2 <= WS_WOUT && WS_WOUT + (size_t)DEPTH * DM * DM * 2 <= WS_WGU && WS_WGU + (size_t)DEPTH * NGU * DM * 2 <= WS_WD && WS_WD + (size_t)DEPTH * DM * FF * 2 <= WS_XN, "ws map (weights)");
static_assert(WS_XN + (size_t)M * DM * 2 <= WS_PROJ && WS_PROJ + (size_t)M * PW * 2 <= WS_MIX && WS_HB + (size_t)M * FF * 2 <= WS_MIX && WS_MIX + (size_t)M * DM * 2 <= WS_DIFF && WS_DIFF + (size_t)2 * M * 1024 * 2 <= WS_XB && WS_XB + (size_t)M * DM * 4 <= WS_END, "ws map (activations)");
constexpr int CW_TMO = 0, CW_CODE = 1, CW_BAR = 4096;
constexpr int CW_SSQ = 16384;
constexpr int CW_PCNT = 65536;
static_assert((98304 + 16 * 64) * 4 <= 400 * 1024, "control words inside the per-call memset");
constexpr int CW_CONV = 98304;
constexpr int CW_ATTQ = 8192;
constexpr int RING_OFF = 0, RING_BYTES = 131072;
constexpr int LDSCTL_OFF = RING_BYTES, MISC_OFF = LDSCTL_OFF + 320;
constexpr int XL_OFF = RING_BYTES + 4096;
constexpr int LDS_BYTES = 147456;

#define GAS __attribute__((address_space(1)))
#define LAS __attribute__((address_space(3)))
typedef unsigned short bf16;
typedef unsigned v4u __attribute__((ext_vector_type(4)));
typedef unsigned v2u __attribute__((ext_vector_type(2)));
typedef float f32x4 __attribute__((ext_vector_type(4)));
typedef float f32x2 __attribute__((ext_vector_type(2)));
typedef short bf16x8 __attribute__((ext_vector_type(8)));
typedef GAS unsigned gu32;
#define RLX_AGENT __ATOMIC_RELAXED, __HIP_MEMORY_SCOPE_AGENT
#define LDS_WAIT() asm volatile("s_waitcnt lgkmcnt(0)" ::: "memory")
#define VM_WAIT() asm volatile("s_waitcnt vmcnt(0)" ::: "memory")
__device__ __forceinline__ unsigned f2bf(float f) { unsigned u = __builtin_bit_cast(unsigned, f); return (u + 0x7fffu + ((u >> 16) & 1u)) >> 16; }
__device__ __forceinline__ unsigned pk2(float lo, float hi) { return f2bf(lo) | (f2bf(hi) << 16); }
__device__ __forceinline__ float bflo(unsigned w) { return __uint_as_float(w << 16); }
__device__ __forceinline__ float bfhi(unsigned w) { return __uint_as_float(w & 0xffff0000u); }
__device__ __forceinline__ float bf2f(bf16 b) { return __uint_as_float((unsigned)b << 16); }
__device__ __forceinline__ float shx(float v, int o, int lane) { return __int_as_float(__builtin_amdgcn_ds_bpermute((lane ^ o) << 2, __float_as_int(v))); }
__device__ __forceinline__ float wave_sum(float v, int lane) {
#pragma unroll
    for (int o = 1; o < 64; o <<= 1) v += shx(v, o, lane);
    return v;
}
__device__ __forceinline__ float wave_max(float v, int lane) {
#pragma unroll
    for (int o = 1; o < 64; o <<= 1) v = fmaxf(v, shx(v, o, lane));
    return v;
}
__device__ __forceinline__ float dpp_xor1(float v) { return __int_as_float(__builtin_amdgcn_mov_dpp(__float_as_int(v), 0xB1, 0xf, 0xf, true)); }
__device__ __forceinline__ int fresh_tid(int wave0) { int lane; asm volatile("v_mbcnt_lo_u32_b32 %0, -1, 0\n\tv_mbcnt_hi_u32_b32 %0, -1, %0" : "=v"(lane)); return wave0 * 64 + lane; }
#define FRESH_IDS(vcu_) const int tid = fresh_tid(wave0); const int lane = tid & 63, wave = wave0; const int gw = (vcu_) * NWAVES + wave; (void)gw; (void)lane; (void)wave; (void)tid

#define XB_TMO      128
#define XB_XCNT(j)  (256  + 64 * (j))
#define XB_XSUB(j)  (1280 + 64 * (j))
#define XB_XGEN(j)  (2304 + 64 * (j))
#define XB_TOP      3328
#define XB_TOPGEN   3392
#define XCD_BAR_WORDS 3456
#define XB_SPIN_CAP (1u << 18)

__device__ __forceinline__ unsigned xb_ld(unsigned* p)              { return __hip_atomic_load(p, __ATOMIC_RELAXED, __HIP_MEMORY_SCOPE_AGENT); }
__device__ __forceinline__ unsigned xb_add(unsigned* p, unsigned v) { return __hip_atomic_fetch_add(p, v, __ATOMIC_RELAXED, __HIP_MEMORY_SCOPE_AGENT); }
__device__ __forceinline__ unsigned xb_xcc_id() { return (unsigned)__builtin_amdgcn_s_getreg((3 << 11) | 20) & 0xFu; }
#define XB_SPIN(cond, bar) do { unsigned _sp = 0; while (cond) { __builtin_amdgcn_s_sleep(1); \
    if ((++_sp & 255u) == 0u) { if (xb_ld(&(bar)[XB_TMO])) break; if (_sp > XB_SPIN_CAP) { atomicAdd(&(bar)[XB_TMO], 1u); break; } } } } while (0)

struct XcdBarrier {
    unsigned* bar; unsigned x;
    volatile LAS unsigned* st;
};

__device__ __forceinline__ XcdBarrier xcd_barrier_post(unsigned* bar, volatile LAS unsigned* st) {
    XcdBarrier b; b.bar = bar; b.x = xb_xcc_id(); b.st = st;
    if (threadIdx.x == 0) (void)xb_add(&bar[XB_XCNT(b.x)], 1u);
    return b;
}
__device__ __forceinline__ void xcd_barrier_complete(unsigned* bar, unsigned x, unsigned& nloc, unsigned& nx) {
    const unsigned G = gridDim.x * gridDim.y * gridDim.z;
    unsigned sum, cnt, mine, sp = 0u;
    for (;;) {
        sum = 0u; cnt = 0u; mine = 0u;
#pragma unroll
        for (unsigned j = 0; j < 16; ++j) { const unsigned c = xb_ld(&bar[XB_XCNT(j)]); sum += c; cnt += (c > 0u) ? 1u : 0u; mine = (j == x) ? c : mine; }
        if (sum == G) break;
        __builtin_amdgcn_s_sleep(1);
        if ((++sp & 255u) == 0u) { if (xb_ld(&bar[XB_TMO])) break; if (sp > XB_SPIN_CAP) { atomicAdd(&bar[XB_TMO], 1u); break; } }
    }
    nloc = mine > 0u ? mine : 1u; nx = cnt > 0u ? cnt : 1u;
}

__device__ __forceinline__ void xcd_barrier(const XcdBarrier& b) {
    asm volatile("s_waitcnt vmcnt(0)" ::: "memory");
    __syncthreads();
    if (threadIdx.x == 0) {
        unsigned* bar = b.bar;
        __builtin_amdgcn_s_waitcnt(0);
        unsigned nloc = b.st[0], nx = b.st[1];
        if (nloc == 0u) { xcd_barrier_complete(bar, b.x, nloc, nx); b.st[0] = nloc; b.st[1] = nx; }
        const unsigned old = xb_add(&bar[XB_XSUB(b.x)], 1u);
        const unsigned gen = old / nloc;
        if (old + 1u == (gen + 1u) * nloc) {
            __builtin_amdgcn_fence(__ATOMIC_RELEASE, "agent");
            asm volatile("s_waitcnt vmcnt(0)" ::: "memory");
            const unsigned og = xb_add(&bar[XB_TOP], 1u);
            const unsigned tg = og / nx;
            if (og + 1u == (tg + 1u) * nx) xb_add(&bar[XB_TOPGEN], 1u);
            else XB_SPIN(xb_ld(&bar[XB_TOPGEN]) == tg, bar);
            __builtin_amdgcn_fence(__ATOMIC_ACQUIRE, "agent");
            xb_add(&bar[XB_XGEN(b.x)], 1u);
            asm volatile("s_waitcnt vmcnt(0)" ::: "memory");
        } else {
            XB_SPIN(xb_ld(&bar[XB_XGEN(b.x)]) == gen, bar);
            __builtin_amdgcn_fence(__ATOMIC_ACQUIRE, "agent");
            asm volatile("s_waitcnt vmcnt(0)" ::: "memory");
        }
    }
    __syncthreads();
}


namespace att {
typedef short s16x4 __attribute__((ext_vector_type(4)));
typedef float f32x16 __attribute__((ext_vector_type(16)));
typedef unsigned u32x4 __attribute__((ext_vector_type(4)));
constexpr int NW = 8, QBLK = 32, KVBLK = 64, QB = NW * QBLK, D = 128;
constexpr int SHM_V = KVBLK * D * 2, SHM_K = KVBLK * D * 2;
constexpr int OFF_WS = 2 * SHM_V + 2 * SHM_K, OFF_BIAS = OFF_WS + NW * 64 * 4, OFF_NXT = OFF_BIAS + SEQ * 4, OFF_WT = OFF_NXT + 16, LDS_BYTES = OFF_WT + 64;
constexpr int QITEMS = (BATCH * NATT / 8) * (SEQ / QB);
constexpr float SCALE = 0.08838834764831845f, THR = 8.f;
constexpr int PITCH = PW;
#define KSWZ(row, colB) ((row) * 256 + ((colB) ^ (((row) & 7) << 4)))
#define SBAR() __builtin_amdgcn_sched_barrier(0)
__device__ __forceinline__ int v_st(int k, int c) { const int kk = (k & ~0xC) | ((k & 4) << 1) | ((k & 8) >> 1); return ((kk >> 3) * 4 + (c >> 5)) * 512 + ((kk & 7) * 32 + (c & 31)) * 2; }
__device__ __forceinline__ int v_rd_base(int lane) { return ((lane & 3) << 3) | (((lane >> 2) & 3) << 6) | (((lane >> 4) & 1) << 5) | (((lane >> 5) & 1) << 8); }
constexpr int v_rd_off(int d0, int ks, int half) { return d0 * 512 + ks * 4096 + half * 2048; }
__device__ __forceinline__ int crow(int r, int hi) { return (r & 3) + 8 * (r >> 2) + 4 * hi; }
__device__ __forceinline__ unsigned cvtpk(float lo, float hi) { unsigned r; asm volatile("v_cvt_pk_bf16_f32 %0, %1, %2" : "=v"(r) : "v"(lo), "v"(hi)); return r; }
__device__ __forceinline__ bf16x8 load8(const bf16* p) { return *reinterpret_cast<const bf16x8*>(p); }
__device__ __forceinline__ void mask_tile(f32x16& p0, f32x16& p1, int dq) {
    const float NEG = -__builtin_inff();
#pragma unroll
    for (int r = 0; r < 16; ++r) { const int c = (r & 3) + 8 * (r >> 2); if (dq - c < 0) p0[r] = NEG; if (dq - c - 32 < 0) p1[r] = NEG; }
}
__device__ __forceinline__ void partialSM(f32x16& p0, f32x16& p1, float& m_reg, float& mn, float& alpha) {
    float pmax = p0[0];
#pragma unroll
    for (int r = 1; r < 16; ++r) pmax = fmaxf(pmax, p0[r]);
#pragma unroll
    for (int r = 0; r < 16; ++r) pmax = fmaxf(pmax, p1[r]);
    { auto rr = __builtin_amdgcn_permlane32_swap(__float_as_uint(pmax), __float_as_uint(pmax), false, false); pmax = fmaxf(__uint_as_float(rr[0]), __uint_as_float(rr[1])); }
    constexpr float C2 = 1.4426950408889634f * SCALE;
    if (__builtin_expect(__all((pmax - m_reg) * SCALE <= THR), 1)) { mn = m_reg; alpha = 1.f; }
    else { mn = fmaxf(m_reg, pmax); alpha = __builtin_amdgcn_exp2f((m_reg - mn) * C2); m_reg = mn; }
    const float mnL = -mn * C2;
#pragma unroll
    for (int r = 0; r < 16; ++r) p0[r] = fmaf(p0[r], C2, mnL);
#pragma unroll
    for (int r = 0; r < 16; ++r) p1[r] = fmaf(p1[r], C2, mnL);
#pragma unroll
    for (int r = 0; r < 16; ++r) p0[r] = __builtin_amdgcn_exp2f(p0[r]);
}
__device__ __forceinline__ void finishSM(f32x16& p0, f32x16& p1, float alpha, float& l_reg, bf16x8& pa0, bf16x8& pa1, bf16x8& pa2, bf16x8& pa3) {
#pragma unroll
    for (int r = 0; r < 16; ++r) p1[r] = __builtin_amdgcn_exp2f(p1[r]);
    float ps = 0;
#pragma unroll
    for (int r = 0; r < 16; ++r) ps += p0[r];
#pragma unroll
    for (int r = 0; r < 16; ++r) ps += p1[r];
    { auto rr = __builtin_amdgcn_permlane32_swap(__float_as_uint(ps), __float_as_uint(ps), false, false); ps = __uint_as_float(rr[0]) + __uint_as_float(rr[1]); }
    l_reg = l_reg * alpha + ps;
#define PK4(P, B_, OUT) do { unsigned a0 = cvtpk(P[B_+0], P[B_+1]), a1 = cvtpk(P[B_+2], P[B_+3]);                          \
        unsigned b0 = cvtpk(P[B_+4], P[B_+5]), b1 = cvtpk(P[B_+6], P[B_+7]);                                             \
        auto r0 = __builtin_amdgcn_permlane32_swap(a0, b0, false, false); auto r1 = __builtin_amdgcn_permlane32_swap(a1, b1, false, false); \
        u32x4 w = {r0[0], r1[0], r0[1], r1[1]}; OUT = *reinterpret_cast<bf16x8*>(&w); } while (0)
    PK4(p0, 0, pa0); PK4(p0, 8, pa1); PK4(p1, 0, pa2); PK4(p1, 8, pa3);
#undef PK4
}
template <int KB>
__device__ __forceinline__ void qkt(f32x16& p0, f32x16& p1, const char* K_lds, int r32, int hi, const bf16x8* qr, const float* bt, float rowinit) {
    if (bt) { const f32x4* bp = (const f32x4*)(bt + 4 * hi);
#pragma unroll
        for (int g = 0; g < 4; ++g) { const f32x4 a = bp[2 * g], b = bp[2 * g + 8];
            p0[4 * g] = a[0]; p0[4 * g + 1] = a[1]; p0[4 * g + 2] = a[2]; p0[4 * g + 3] = a[3]; p1[4 * g] = b[0]; p1[4 * g + 1] = b[1]; p1[4 * g + 2] = b[2]; p1[4 * g + 3] = b[3]; } }
    else {
#pragma unroll
        for (int r = 0; r < 16; ++r) { p0[r] = rowinit; p1[r] = rowinit; } }
    const char* kb[4];
#pragma unroll
    for (int dd = 0; dd < 4; ++dd) kb[dd] = K_lds + KB * SHM_K + KSWZ(r32, (dd * 16 + hi * 8) * 2);
#pragma unroll
    for (int d0 = 0; d0 < 8; ++d0) { const char* a = kb[d0 & 3] + (d0 >> 2) * 128;
        bf16x8 b0 = *reinterpret_cast<const bf16x8*>(a);
        bf16x8 b1 = *reinterpret_cast<const bf16x8*>(a + 32 * 256);
        p0 = __builtin_amdgcn_mfma_f32_32x32x16_bf16(b0, qr[d0], p0, 0, 0, 0);
        p1 = __builtin_amdgcn_mfma_f32_32x32x16_bf16(b1, qr[d0], p1, 0, 0, 0); }
}
template <int VB>
__device__ __forceinline__ void pv_tile(f32x16* o, int vb0, bf16x8 pa0, bf16x8 pa1, bf16x8 pa2, bf16x8 pa3) {
#define TRRD(dst, off) asm volatile("ds_read_b64_tr_b16 %0, %1 offset:%2" : "=&v"(dst) : "v"(vb0), "i"(off) : "memory")
#define PV_D0(d0) do { s16x4 l0, l1, l2, l3, h0, h1, h2, h3; constexpr int b_ = VB * SHM_V + v_rd_off(d0, 0, 0); \
        TRRD(l0, b_); TRRD(h0, b_ + 2048); TRRD(l1, b_ + 4096); TRRD(h1, b_ + 6144); TRRD(l2, b_ + 8192); TRRD(h2, b_ + 10240); TRRD(l3, b_ + 12288); TRRD(h3, b_ + 14336); \
        asm volatile("s_waitcnt lgkmcnt(0)" ::: "memory"); SBAR();   \
        o[d0] = __builtin_amdgcn_mfma_f32_32x32x16_bf16(pa0, (bf16x8){l0[0], l0[1], l0[2], l0[3], h0[0], h0[1], h0[2], h0[3]}, o[d0], 0, 0, 0);   \
        o[d0] = __builtin_amdgcn_mfma_f32_32x32x16_bf16(pa1, (bf16x8){l1[0], l1[1], l1[2], l1[3], h1[0], h1[1], h1[2], h1[3]}, o[d0], 0, 0, 0);   \
        o[d0] = __builtin_amdgcn_mfma_f32_32x32x16_bf16(pa2, (bf16x8){l2[0], l2[1], l2[2], l2[3], h2[0], h2[1], h2[2], h2[3]}, o[d0], 0, 0, 0);   \
        o[d0] = __builtin_amdgcn_mfma_f32_32x32x16_bf16(pa3, (bf16x8){l3[0], l3[1], l3[2], l3[3], h3[0], h3[1], h3[2], h3[3]}, o[d0], 0, 0, 0); } while (0)
    PV_D0(0); PV_D0(1); PV_D0(2); PV_D0(3);
#undef PV_D0
#undef TRRD
}
struct BlockRef { int bh, qb; };
struct HeadCols { int qcol, kcol, vcol, type, ocol, opitch, ohstep; size_t obase_off; };
__device__ __forceinline__ HeadCols head_cols(int hidx) {
    HeadCols d;
    if (hidx < 12) { d.type = 0; d.qcol = C_QM + hidx * HD; d.kcol = C_KM + hidx * HD; d.vcol = C_VM + hidx * HD; d.obase_off = WS_MIX + (size_t)((hidx * HD) >> 6) * M * 64 * 2; d.opitch = 64; d.ohstep = M * 64; d.ocol = 0; }
    else if (hidx < 24) { const int h = hidx - 12; d.type = 1; d.qcol = C_QF + h * HD; d.kcol = C_KF + h * HD; d.vcol = C_VF + h * HD; d.obase_off = WS_MIX + (size_t)((1536 + h * HD) >> 6) * M * 64 * 2; d.opitch = 64; d.ohstep = M * 64; d.ocol = 0; }
    else { const int x = hidx - 24, h = x >> 2, mp = (x >> 1) & 1, e = x & 1; d.type = 2; d.qcol = C_QD + h * 256 + mp * HD; d.kcol = C_KD + h * 256 + mp * HD; d.vcol = C_VD + h * 256 + e * HD;
        d.obase_off = WS_DIFF + (size_t)mp * M * 1024 * 2; d.opitch = 1024; d.ohstep = 64; d.ocol = h * 256 + e * HD; }
    return d;
}
#define LAUNDER_S(x) asm volatile("" : "+s"(x))
__device__ __forceinline__ BlockRef q_item(int qx, int k) { const int kk = k / 10, ui = k - kk * 10, q4 = qx & 3; BlockRef r;
    const int hidx = ui < 3 ? 3 * q4 + ui : (ui < 6 ? 12 + 3 * q4 + (ui - 3) : 24 + 4 * q4 + (ui - 6));
    r.bh = (qx >> 2) * NATT + hidx; r.qb = 15 - kk; return r; }
struct Seam { bf16x8 qr[8]; bf16x8 st_v0, st_v1, st_k0, st_k1; };
#define ROW(p, k0, rr) ((p) + (size_t)((k0) + (rr)) * PITCH + sc)
#define VMW() asm volatile("s_waitcnt vmcnt(0)" ::: "memory")
#define VMWN(n) asm volatile("s_waitcnt vmcnt(%0)" :: "i"(n) : "memory")
#define SLOAD_H(Kp, Vp, k0) do { S.st_v0 = load8(ROW(Vp, k0, sr)); S.st_v1 = load8(ROW(Vp, k0, 32 + sr)); S.st_k0 = load8(ROW(Kp, k0, sr)); S.st_k1 = load8(ROW(Kp, k0, 32 + sr)); } while (0)
#define SWRITE_HK(bf) do { *(bf16x8*)(K_lds + (bf) * SHM_K + kws) = S.st_k0; *(bf16x8*)(K_lds + (bf) * SHM_K + kws + 32 * 256) = S.st_k1; } while (0)
#define SWRITE_HV(bf) do { *(bf16x8*)(V_lds + (bf) * SHM_V + vst0) = S.st_v0; *(bf16x8*)(V_lds + (bf) * SHM_V + vst1) = S.st_v1; } while (0)
#define SWRITE_H(bf) do { SWRITE_HV(bf); SWRITE_HK(bf); } while (0)
__device__ __forceinline__ void prime(BlockRef cur, unsigned char* wsb, char* lds, Seam& S, int tid) {
    const int wid = __builtin_amdgcn_readfirstlane(tid >> 6), lane = tid & 63, r32 = lane & 31, hi = lane >> 5;
    const int sr = tid >> 4, sc = (tid & 15) * 8, kws = KSWZ(sr, sc * 2); char* K_lds = lds + 2 * SHM_V;
    const int b = cur.bh / NATT; const HeadCols hc = head_cols(cur.bh - b * NATT);
    const bf16* PROJ = (const bf16*)(wsb + WS_PROJ); const size_t rowb = (size_t)b * SEQ;
    const bf16* Qp = PROJ + (rowb + (size_t)cur.qb * QB) * PITCH + hc.qcol; const bf16* Kp = PROJ + rowb * PITCH + hc.kcol; const bf16* Vp = PROJ + rowb * PITCH + hc.vcol;
#pragma unroll
    for (int d0 = 0; d0 < 8; ++d0) S.qr[d0] = load8(Qp + (size_t)(wid * QBLK + r32) * PITCH + d0 * 16 + hi * 8);
    SLOAD_H(Kp, Vp, cur.qb * QB + QB - KVBLK); VMW(); SWRITE_HK(0);
    __syncthreads();
}
__device__ __forceinline__ int block(BlockRef cur, unsigned* qctr, int qx, unsigned char* wsb, char* lds, Seam& S, int tid, float fox_thr) {
    const int wid = __builtin_amdgcn_readfirstlane(tid >> 6), lane = tid & 63, r32 = lane & 31, hi = lane >> 5;
    const int P0 = cur.qb * QB;
    const int NT = (P0 + QB) / KVBLK;
    int NS = NT;
    const int qlo = P0 + wid * QBLK, qm = qlo + r32 - 4 * hi;
    char* V_lds = lds; char* K_lds = lds + 2 * SHM_V;
    float* ws = (float*)(lds + OFF_WS) + wid * 64; float* li_l = ws, * al_l = ws + 32;
    float* blds = (float*)(lds + OFF_BIAS);
    float m_reg = -1e30f, l_reg = 0; f32x16 o[4] = {};
    const int sr = tid >> 4, sc = (tid & 15) * 8, vst0 = v_st(sr, sc), vst1 = v_st(32 + sr, sc), kws = KSWZ(sr, sc * 2);
    const int vb0 = (int)(uintptr_t)V_lds + v_rd_base(lane);
    const int cb = cur.bh / NATT, chx = cur.bh - cb * NATT; const HeadCols hc = head_cols(chx);
    const bf16* Kh = (const bf16*)(wsb + WS_PROJ) + (size_t)cb * SEQ * PITCH + hc.kcol; const bf16* Vh = (const bf16*)(wsb + WS_PROJ) + (size_t)cb * SEQ * PITCH + hc.vcol;
    const bool hb = hc.type == 1;
    unsigned nfetch = 0u; if (tid == 0) nfetch = __hip_atomic_fetch_add(qctr, 1u, __ATOMIC_RELAXED, __HIP_MEMORY_SCOPE_AGENT);
    unsigned selm = 0xffffffffu;
    int tid_h = tid; asm volatile("" : "+v"(tid_h)); const int lane_h = tid_h & 63;
    unsigned char* wsh = wsb; asm volatile("" : "+s"(wsh));
    if (hc.type == 0) {
        const int j = cur.qb; selm = 1u << j;
        if (j > 0) {
            const float* kp = (const float*)(wsh + WS_KPART) + (size_t)(cb * 12 + chx) * NBLK * KSUB * HD;
            for (int idx = tid_h; idx < j * HD; idx += NW * 64) { const int n = idx >> 7, d = idx & 127; const float* q_ = kp + (size_t)n * KSUB * HD + d; float a = 0.f;
#pragma unroll
                for (int sub = 0; sub < KSUB; ++sub) a += q_[sub * HD];
                blds[idx] = a * (1.0f / 256.0f); }
            __syncthreads();
            float b0 = -__builtin_inff(), b1 = b0, b2 = b0; int i0 = -1, i1 = -1, i2 = -1;
            for (int n = 0; n < j; ++n) { const float* km = blds + n * HD + 8 * (lane_h >> 5); float a = 0.f;
#pragma unroll
                for (int d0 = 0; d0 < 8; ++d0) { const f32x4 k0 = *(const f32x4*)(km + 16 * d0), k1 = *(const f32x4*)(km + 16 * d0 + 4); const bf16x8 qv = S.qr[d0];
                    a += bf2f((bf16)qv[0]) * k0[0] + bf2f((bf16)qv[1]) * k0[1] + bf2f((bf16)qv[2]) * k0[2] + bf2f((bf16)qv[3]) * k0[3] + bf2f((bf16)qv[4]) * k1[0] + bf2f((bf16)qv[5]) * k1[1] + bf2f((bf16)qv[6]) * k1[2] + bf2f((bf16)qv[7]) * k1[3]; }
                { auto rr = __builtin_amdgcn_permlane32_swap(__float_as_uint(a), __float_as_uint(a), false, false); a = __uint_as_float(rr[0]) + __uint_as_float(rr[1]); }
                if (a > b0) { b2 = b1; i2 = i1; b1 = b0; i1 = i0; b0 = a; i0 = n; } else if (a > b1) { b2 = b1; i2 = i1; b1 = a; i1 = n; } else if (a > b2) { b2 = a; i2 = n; } }
            if (i0 >= 0) selm |= 1u << i0; if (i1 >= 0) selm |= 1u << i1; if (i2 >= 0) selm |= 1u << i2;
        }
    }
    if (hb) { const float* lf = (const float*)(wsh + WS_LOGF) + (size_t)(cb * 12 + (chx - 12)) * SEQ; const int nk = P0 + QB;
        float v[8]; float tot = 0.f; const bool act = tid_h * 8 < nk;
        if (act) { const f32x4 a = *(const f32x4*)(lf + 8 * tid_h), b = *(const f32x4*)(lf + 8 * tid_h + 4);
            v[0] = a[0]; v[1] = v[0] + a[1]; v[2] = v[1] + a[2]; v[3] = v[2] + a[3]; v[4] = v[3] + b[0]; v[5] = v[4] + b[1]; v[6] = v[5] + b[2]; v[7] = v[6] + b[3]; tot = v[7]; }
        else {
#pragma unroll
            for (int i = 0; i < 8; ++i) v[i] = 0.f; }
        float inc = tot;
#pragma unroll
        for (int o_ = 1; o_ < 64; o_ <<= 1) { const float t_ = __int_as_float(__builtin_amdgcn_ds_bpermute((lane_h >= o_ ? lane_h - o_ : lane_h) << 2, __float_as_int(inc))); if (lane_h >= o_) inc += t_; }
        float* wt = (float*)(lds + OFF_WT);
        if (lane_h == 63) wt[wid] = inc;
        __syncthreads();
        float off = inc - tot;
        for (int w_ = 0; w_ < wid; ++w_) off += wt[w_];
        if (act) { f32x4 a, b; a[0] = (off + v[0]) * -11.313708498984761f; a[1] = (off + v[1]) * -11.313708498984761f; a[2] = (off + v[2]) * -11.313708498984761f; a[3] = (off + v[3]) * -11.313708498984761f;
            b[0] = (off + v[4]) * -11.313708498984761f; b[1] = (off + v[5]) * -11.313708498984761f; b[2] = (off + v[6]) * -11.313708498984761f; b[3] = (off + v[7]) * -11.313708498984761f;
            *(f32x4*)(blds + 8 * tid_h) = a; *(f32x4*)(blds + 8 * tid_h + 4) = b; }
        __syncthreads();
        if (wid == 0) { const float thr = fox_thr;
            const int ti = NT - 1 - lane_h; bool dead = false;
            if (lane_h >= 4 && ti >= 0) dead = (blds[P0] - blds[64 * ti + 63]) > thr;
            const unsigned long long bm = __ballot(dead);
            int ns = NT; if (bm != 0ull) { ns = __builtin_ctzll(bm); ns = (ns + 1) & ~1; if (ns > NT) ns = NT; }
            if (lane_h == 0) *(volatile int*)(lds + OFF_WT + 32) = ns; }
        __syncthreads();
        NS = __builtin_amdgcn_readfirstlane(*(volatile int*)(lds + OFF_WT + 32)); }
#define RESC(a) do { if (__any((a) < 1.f)) { if (hi == 0) al_l[r32] = (a); asm volatile("s_waitcnt lgkmcnt(0)" ::: "memory");              \
                     for (int d_ = 0; d_ < 4; ++d_) for (int r = 0; r < 16; ++r) o[d_][r] *= al_l[crow(r, hi)]; } } while (0)
#define KBASE(i) ((NT - 1 - (i)) * KVBLK)
#define BT(i) (hb ? blds + KBASE(i) : (const float*)nullptr)
#define RI(i) ((((selm >> ((NT - 1 - (i)) >> 2)) & 1u) != 0u) ? 0.f : -__builtin_inff())
#define MASKT(P0_, P1_, t) do { const int kb_ = KBASE(t); if (kb_ + KVBLK - 1 > qlo) mask_tile(P0_, P1_, qm - kb_); } while (0)
#define SEAM_K0() do { VMWN(8); SWRITE_HK(0); SBAR(); } while (0)
    f32x16 pA0, pA1, pB0, pB1; float mnA, mnB, alA, alB; bf16x8 pa0, pa1, pa2, pa3;
    SWRITE_HV(0); SBAR();
    SLOAD_H(Kh, Vh, KBASE(1));
    SBAR(); qkt<0>(pA0, pA1, K_lds, r32, hi, S.qr, BT(0), RI(0));
    MASKT(pA0, pA1, 0); partialSM(pA0, pA1, m_reg, mnA, alA);
    VMW(); SWRITE_H(1);
    if (tid == 0) *(volatile unsigned*)(lds + OFF_NXT) = nfetch;
    __syncthreads();
    const int nk = __builtin_amdgcn_readfirstlane((int)*(volatile unsigned*)(lds + OFF_NXT));
#define HALF_STEP(PX0, PX1, mnX, alX, PY0, PY1, alY, t, KB, VB, SB) do {                                                      \
        SBAR(); qkt<KB>(PX0, PX1, K_lds, r32, hi, S.qr, BT(t), RI(t));                                                        \
        finishSM(PY0, PY1, alY, l_reg, pa0, pa1, pa2, pa3); SBAR();                                                           \
        if ((t) + 1 < NS) { SLOAD_H(Kh, Vh, KBASE((t) + 1)); SBAR(); }                                                        \
        pv_tile<VB>(o, vb0, pa0, pa1, pa2, pa3); MASKT(PX0, PX1, (t)); partialSM(PX0, PX1, m_reg, mnX, alX);                  \
        __syncthreads();                                                                                                      \
        if ((t) + 1 < NS) { VMW(); SWRITE_H(SB); }                                                                            \
        RESC(alX); __syncthreads(); } while (0)
    for (int t = 1; t + 1 < NS; t += 2) {
        HALF_STEP(pB0, pB1, mnB, alB, pA0, pA1, alA, t, 1, 0, 0);
        HALF_STEP(pA0, pA1, mnA, alA, pB0, pB1, alB, t + 1, 0, 1, 1);
    }
    SBAR(); qkt<1>(pB0, pB1, K_lds, r32, hi, S.qr, BT(NS - 1), RI(NS - 1)); SBAR();
    { const BlockRef nxt = (nk < QITEMS) ? q_item(qx, nk) : cur; int nbh = nxt.bh, nqb = nxt.qb; LAUNDER_S(nbh); LAUNDER_S(nqb);
      const int nb = nbh / NATT; const HeadCols nh = head_cols(nbh - nb * NATT); const bf16* PROJ = (const bf16*)(wsb + WS_PROJ); const size_t rowb = (size_t)nb * SEQ;
      const bf16* nK = PROJ + rowb * PITCH + nh.kcol; const bf16* nV = PROJ + rowb * PITCH + nh.vcol; const bf16* nQ = PROJ + (rowb + (size_t)nqb * QB) * PITCH + nh.qcol;
      SLOAD_H(nK, nV, nqb * QB + QB - KVBLK); SBAR();
#pragma unroll
      for (int d0 = 0; d0 < 8; ++d0) S.qr[d0] = load8(nQ + (size_t)(wid * QBLK + r32) * PITCH + d0 * 16 + hi * 8); }
    SBAR();
    finishSM(pA0, pA1, alA, l_reg, pa0, pa1, pa2, pa3); SBAR();
    pv_tile<0>(o, vb0, pa0, pa1, pa2, pa3);
    MASKT(pB0, pB1, NS - 1); partialSM(pB0, pB1, m_reg, mnB, alB); __syncthreads(); RESC(alB);
    finishSM(pB0, pB1, alB, l_reg, pa0, pa1, pa2, pa3); SBAR(); pv_tile<1>(o, vb0, pa0, pa1, pa2, pa3);
    SBAR(); SEAM_K0();
    if (hi == 0) li_l[r32] = l_reg; asm volatile("s_waitcnt lgkmcnt(0)" ::: "memory");
    float rli[16];
#pragma unroll
    for (int r = 0; r < 16; ++r) rli[r] = __builtin_amdgcn_rcpf(li_l[crow(r, hi)]);
    { int obh = cur.bh, oqb = cur.qb; LAUNDER_S(obh); LAUNDER_S(oqb);
      const int ob = obh / NATT; const HeadCols oh = head_cols(obh - ob * NATT); const int opitch = oh.opitch, ohstep = oh.ohstep;
      bf16* Ow = (bf16*)(wsb + oh.obase_off) + ((size_t)ob * SEQ + (size_t)oqb * QB + wid * QBLK) * opitch + oh.ocol;
      int hi_e = hi; asm volatile("" : "+v"(hi_e));
      bf16* Ol = Ow + (size_t)(4 * hi_e) * opitch + r32;
#pragma unroll
      for (int r = 0; r < 16; ++r) { const int orow = (r & 3) + 8 * (r >> 2);
#pragma unroll
        for (int d0 = 0; d0 < 4; ++d0) { const float v = o[d0][r] * rli[r]; const float vn = __int_as_float(__builtin_amdgcn_mov_dpp(__float_as_int(v), 0xB1, 0xf, 0xf, true));
            if ((r32 & 1) == 0) *(unsigned*)(Ol + (size_t)orow * opitch + (size_t)(d0 >> 1) * ohstep + (d0 & 1) * 32) = cvtpk(v, vn); } } }
    __syncthreads();
    return nk;
#undef RESC
#undef KBASE
#undef BT
#undef RI
#undef MASKT
#undef SEAM_K0
#undef HALF_STEP
}
#undef ROW
#undef VMW
#undef VMWN
#undef SLOAD_H
#undef SWRITE_HK
#undef SWRITE_HV
#undef SWRITE_H
#undef KSWZ
#undef SBAR
}

struct Args { const float* in[20]; float* out; unsigned char* ws; int ph_lo, ph_hi; };
typedef const __attribute__((address_space(4))) Args* KArgs;
__device__ __forceinline__ KArgs kargs() { KArgs k = (KArgs)__builtin_amdgcn_kernarg_segment_ptr(); asm volatile("" : "+s"(k)); return k; }

__device__ __forceinline__ void p0_prologue(unsigned char* ws, LAS unsigned char* lds, int vcu, int NGW, int wave0, int lsel, int part) {
    FRESH_IDS(vcu);
    KArgs ka = kargs(); const float* in2 = ka->in[2]; const float* in15 = ka->in[15]; const float* in17 = ka->in[17]; const float* in18 = ka->in[18]; const float* in19 = ka->in[19]; const float* gA = ka->in[1]; const float* gF = ka->in[16];
    { constexpr int T_IN = (DM / 64) * (PW / 256), T_OUT = (DM / 64) * (DM / 256), T_G = (DM / 64) * (FF / 256), T_D = (FF / 64) * (DM / 256), T_LAYER = T_IN + T_OUT + 2 * T_G + T_D;
      const int G_ = NGW / NWAVES;
      LAS unsigned char* img = lds + RING_OFF;
      f32x4 ld[8];
      const float* W = nullptr; int sstride = 0, scol = 0, k0 = 0, K_ = 0, n0d = 0, mode = 0, nrows = 0; bf16* WT = nullptr; const float* gk = nullptr;
#define P0_DECODE(tl_) do { const int l_ = (tl_) / T_LAYER; int r_ = (tl_) - l_ * T_LAYER; gk = nullptr; mode = 0; \
        if (r_ < T_IN) { const int nb_ = PW / 256, kb_ = r_ / nb_, n0_ = (r_ - kb_ * nb_) * 256; W = in2 + (size_t)l_ * DM * INW; sstride = INW; scol = n0_ + (n0_ >= C_QD ? 12 : 0); k0 = 64 * kb_; WT = (bf16*)(ws + WS_WIN) + (size_t)l_ * PW * DM; K_ = DM; n0d = n0_; nrows = PW; gk = gA + l_ * DM; } \
        else if ((r_ -= T_IN) < T_OUT) { const int nb_ = DM / 256, kb_ = r_ / nb_, n0_ = (r_ - kb_ * nb_) * 256; W = in15 + (size_t)l_ * DM * DM; sstride = DM; scol = n0_; k0 = 64 * kb_; WT = (bf16*)(ws + WS_WOUT) + (size_t)l_ * DM * DM; K_ = DM; n0d = n0_; nrows = DM; } \
        else if ((r_ -= T_OUT) < 2 * T_G) { const int wh_ = r_ >= T_G; if (wh_) r_ -= T_G; const int nb_ = FF / 256, kb_ = r_ / nb_, n0_ = (r_ - kb_ * nb_) * 256; W = (wh_ ? in18 : in17) + (size_t)l_ * DM * FF; sstride = FF; scol = n0_; k0 = 64 * kb_; \
            WT = (bf16*)(ws + WS_WGU) + (size_t)l_ * NGU * DM; K_ = DM; n0d = n0_; nrows = NGU; gk = gF + l_ * DM; mode = 1 + wh_; } \
        else { r_ -= 2 * T_G; const int nb_ = DM / 256, kb_ = r_ / nb_, n0_ = (r_ - kb_ * nb_) * 256; W = in19 + (size_t)l_ * FF * DM; sstride = DM; scol = n0_; k0 = 64 * kb_; WT = (bf16*)(ws + WS_WD) + (size_t)l_ * DM * FF; K_ = FF; n0d = n0_; nrows = DM; } } while (0)
#define P0_LOADS() do { const float* wp_ = W + (size_t)(k0 + 8 * wave) * sstride + scol + 4 * lane; \
        _Pragma("unroll") for (int i_ = 0; i_ < 8; ++i_) ld[i_] = __builtin_nontemporal_load((const f32x4*)(wp_ + (size_t)i_ * sstride)); } while (0)
      const int p_lo = part == 0 ? 0 : (part == 1 ? T_IN : (part == 2 ? T_IN + T_OUT : T_IN + T_OUT + 2 * T_G)), p_hi = part == 0 ? T_IN : (part == 1 ? T_IN + T_OUT : (part == 2 ? T_IN + T_OUT + 2 * T_G : T_LAYER));
      unsigned* cq = (unsigned*)(ws + WS_CTL) + CW_CONV + (lsel * 8 + part) * 64; LAS unsigned* cw = (LAS unsigned*)(lds + RING_OFF + 65536);
      const int tbase = lsel * T_LAYER + p_lo, ntile = p_hi - p_lo;
      if (tid == 0) { const unsigned a0 = __hip_atomic_fetch_add(cq, 2u, __ATOMIC_RELAXED, __HIP_MEMORY_SCOPE_AGENT); cw[0] = a0; }
      __syncthreads();
      int ta = (int)cw[0], tb = ta + 1;
      __syncthreads();
      if (ta < ntile) { P0_DECODE(tbase + ta); P0_LOADS(); }
      while (ta < ntile) {
        unsigned fc = 0u; if (tid == 0) fc = __hip_atomic_fetch_add(cq, 1u, __ATOMIC_RELAXED, __HIP_MEMORY_SCOPE_AGENT);
#pragma unroll
        for (int i_ = 0; i_ < 8; ++i_) *(LAS f32x4*)(img + (8 * wave + i_) * 1024 + ((lane ^ wave) << 4)) = ld[i_];
        bf16* WTc = WT; const int k0c = k0, n0c = n0d, modec = mode, nrc = nrows; const float* gkc = gk; (void)K_;
        __syncthreads();
        if (tb < ntile) { P0_DECODE(tbase + tb); P0_LOADS(); }
        { const int c = tid & 7; f32x4 ga = {1.f, 1.f, 1.f, 1.f}, gb = {1.f, 1.f, 1.f, 1.f};
          if (gkc) { ga = *(const f32x4*)(gkc + k0c + 8 * c); gb = *(const f32x4*)(gkc + k0c + 8 * c + 4); }
#pragma unroll
          for (int j_ = 0; j_ < 4; ++j_) { const int n = (tid >> 3) + 64 * j_;
            const LAS unsigned char* sp = img + (8 * c) * 1024 + ((((n >> 2) ^ c) & 63) << 4) + ((n & 3) << 2);
            float v[8];
#pragma unroll
            for (int i_ = 0; i_ < 8; ++i_) v[i_] = *(const LAS float*)(sp + i_ * 1024);
            v4u o; o.x = pk2(v[0] * ga.x, v[1] * ga.y); o.y = pk2(v[2] * ga.z, v[3] * ga.w); o.z = pk2(v[4] * gb.x, v[5] * gb.y); o.w = pk2(v[6] * gb.z, v[7] * gb.w);
            const int na = n0c + n; const int drow = (modec == 0) ? na : ((na >> 7) * 256 + (modec - 1) * 128 + (na & 127));
            bf16* dp = WTc + ((size_t)(k0c >> 6) * nrc + drow) * 64 + 8 * c;
            *(GAS v4u*)dp = o; } }
        if (tid == 0) cw[0] = fc;
        __syncthreads();
        ta = tb; tb = (int)cw[0];
      }
      __syncthreads();
#undef P0_DECODE
#undef P0_LOADS
    }
    if (lsel != 0 || part != 0) return;
    const int gt = gw * 64 + lane, NGT = NGW * 64;
    for (int i = gt; i < DEPTH * 16 * DM; i += NGT) { const int l = i / (16 * DM), c = (i / DM) & 15, k = i % DM;
        ((bf16*)(ws + WS_WF))[i] = (c < 12) ? (bf16)f2bf(in2[((size_t)l * DM + k) * INW + 9216 + c] * gA[l * DM + k]) : (bf16)0; }
    { const float* x = ka->in[0]; float* ssq0 = (float*)(ws + WS_CTL) + CW_SSQ;
      for (int m = gw; m < M; m += NGW) { const GAS f32x4* xr = (const GAS f32x4*)(x + (size_t)m * DM) + lane; bf16* xa = (bf16*)(ws + WS_XN); float sq = 0.f;
#pragma unroll
        for (int j = 0; j < 16; ++j) { const f32x4 v = xr[64 * j]; sq += (v.x * v.x + v.y * v.y) + (v.z * v.z + v.w * v.w); v2u o; o.x = pk2(v.x, v.y); o.y = pk2(v.z, v.w); const int col = 4 * lane + 256 * j; *(GAS v2u*)(xa + ((size_t)(col >> 6) * M + m) * 64 + (col & 63)) = o; }
        sq = wave_sum(sq, lane); if (lane == 0) ssq0[m] = 1.0f / sqrtf(sq * (1.0f / DM) + NORM_EPS); } }
    for (int i = gt; i < SEQ * 64; i += NGT) { const int pos = i >> 6, fi = i & 63;
        const float invf = 1.0f / powf(10000.0f, (float)fi * (1.0f / 64.0f)); const float ang = (float)pos * invf;
        const double rev = (double)ang * 0.15915494309189533576888; const float fr = (float)(rev - rint(rev));
        ((f32x2*)(ws + WS_ROPE))[i] = (f32x2){__builtin_amdgcn_cosf(fr), __builtin_amdgcn_sinf(fr)}; }
}

constexpr int T3B_TILES = M / 16;
#define DPPF(v, ctrl) __int_as_float(__builtin_amdgcn_mov_dpp(__float_as_int(v), (ctrl), 0xf, 0xf, true))
__device__ __forceinline__ void t3_phase(unsigned char* ws, LAS unsigned char* lds, int l, int vcu, int G, int wave0) {
    FRESH_IDS(vcu);
    KArgs ka = kargs();
    { LAS f32x4* red = (LAS f32x4*)(lds + RING_OFF);
      const int tsel = wave >> 2, kq = wave & 3;
      for (int tb0 = vcu * 2; tb0 < T3B_TILES; tb0 += 2 * G) {
        const int t = tb0 + tsel;
        const bf16* A = (const bf16*)(ws + WS_XN) + ((size_t)(kq * 16) * M + (16 * t + (lane & 15))) * 64 + 8 * (lane >> 4);
        const bf16* B = (const bf16*)(ws + WS_WF) + (size_t)l * 16 * DM + (size_t)(lane & 15) * DM + kq * 1024 + 8 * (lane >> 4);
        f32x4 acc = {0.f, 0.f, 0.f, 0.f};
#pragma unroll 16
        for (int i = 0; i < 32; ++i) { const bf16x8 a = *(const bf16x8*)(A + (size_t)(i >> 1) * M * 64 + 32 * (i & 1)), b = *(const bf16x8*)(B + 32 * i); acc = __builtin_amdgcn_mfma_f32_16x16x32_bf16(a, b, acc, 0, 0, 0); }
        red[(tsel * 4 + kq) * 64 + lane] = acc;
        __syncthreads();
        if (kq == 0) {
            const f32x4 s4 = (red[(tsel * 4 + 0) * 64 + lane] + red[(tsel * 4 + 1) * 64 + lane]) + (red[(tsel * 4 + 2) * 64 + lane] + red[(tsel * 4 + 3) * 64 + lane]);
            const int c = lane & 15;
            if (c < 12) { const float fb = ka->in[7][l * 12 + c]; const float* ssq = (const float*)(ws + WS_CTL) + CW_SSQ + 2 * l * M;
                const int row0 = 16 * t + 4 * (lane >> 4), b = row0 / SEQ, s0 = row0 & (SEQ - 1); f32x4 ls;
#pragma unroll
                for (int r = 0; r < 4; ++r) { const float z = s4[r] * pg8::rs_of(ssq, row0 + r, 1.0f / DM, NORM_EPS) + fb; ls[r] = fminf(z, 0.f) - log1pf(expf(-fabsf(z))); }
                *(f32x4*)((float*)(ws + WS_LOGF) + (size_t)(b * 12 + c) * SEQ + s0) = ls; } }
        __syncthreads();
      } }
    bf16* PROJ = (bf16*)(ws + WS_PROJ);
    const int g = gw & 15; constexpr int NCH = M / T3A_ROWS;
    int col0; const float* gsel; bool rot, km = false;
    if (g < 3) { col0 = C_QM + 512 * g; gsel = ka->in[3]; rot = true; }
    else if (g < 6) { col0 = C_KM + 512 * (g - 3); gsel = ka->in[4]; rot = true; km = true; }
    else if (g < 9) { col0 = C_QF + 512 * (g - 6); gsel = ka->in[5]; rot = false; }
    else if (g < 12) { col0 = C_KF + 512 * (g - 9); gsel = ka->in[6]; rot = false; }
    else if (g < 14) { col0 = C_QD + 512 * (g - 12); gsel = ka->in[8]; rot = true; }
    else { col0 = C_KD + 512 * (g - 14); gsel = ka->in[9]; rot = true; }
    const int hv = lane >> 4, c8 = (lane & 15) * 8, cstep = (G * NWAVES) >> 4;
    float gn[8], dc[8], dsn[8];
    { const float* gp = gsel + l * HD + c8;
#pragma unroll
      for (int e = 0; e < 8; ++e) gn[e] = gp[e];
      const GAS f32x4* r1 = (const GAS f32x4*)((const float*)(ws + WS_ROPE) + ((size_t)1 * 64 + (c8 & 63)) * 2);
#pragma unroll
      for (int q = 0; q < 4; ++q) { const f32x4 b = r1[q]; dc[2 * q] = b.x; dsn[2 * q] = b.y; dc[2 * q + 1] = b.z; dsn[2 * q + 1] = b.w; } }
    const bool up = (lane & 8) != 0;
    const unsigned voff = (unsigned)(col0 + hv * 128 + c8) * 2u;
    for (int chunk = gw >> 4; chunk < NCH; chunk += cstep) {
        v4u w[T3A_ROWS]; float cs[8], sn[8];
        { const int row0_ = chunk * T3A_ROWS; GAS char* ub_ = (GAS char*)PROJ + (size_t)row0_ * PW * 2;
#pragma unroll
          for (int rr = 0; rr < T3A_ROWS; ++rr) w[rr] = *(GAS v4u*)(ub_ + (size_t)rr * PW * 2 + voff);
          const GAS f32x4* rp_ = (const GAS f32x4*)((const float*)(ws + WS_ROPE) + ((size_t)(row0_ & (SEQ - 1)) * 64 + (c8 & 63)) * 2);
#pragma unroll
          for (int q = 0; q < 4; ++q) { const f32x4 a = rp_[q]; cs[2 * q] = a.x; sn[2 * q] = a.y; cs[2 * q + 1] = a.z; sn[2 * q + 1] = a.w; } }
        const int row0 = chunk * T3A_ROWS, pos0 = row0 & (SEQ - 1);
        GAS char* ub0 = (GAS char*)PROJ + (size_t)row0 * PW * 2;
        float ks[8];
#pragma unroll
        for (int e = 0; e < 8; ++e) ks[e] = 0.f;
#pragma unroll
        for (int rr = 0; rr < T3A_ROWS; ++rr) {
            float y[8];
            y[0] = bflo(w[rr].x); y[1] = bfhi(w[rr].x); y[2] = bflo(w[rr].y); y[3] = bfhi(w[rr].y); y[4] = bflo(w[rr].z); y[5] = bfhi(w[rr].z); y[6] = bflo(w[rr].w); y[7] = bfhi(w[rr].w);
            float ss = 0.f;
#pragma unroll
            for (int e = 0; e < 8; ++e) ss += y[e] * y[e];
            ss += DPPF(ss, 0xB1); ss += DPPF(ss, 0x4E); ss += DPPF(ss, 0x141); ss += DPPF(ss, 0x140);
            const float sc = 1.0f / sqrtf(ss * (1.0f / HD) + NORM_EPS);
#pragma unroll
            for (int e = 0; e < 8; ++e) y[e] = y[e] * sc * gn[e];
            if (rot) {
#pragma unroll
                for (int e = 0; e < 8; ++e) { const float o = DPPF(y[e], 0x128);
                    y[e] = up ? (y[e] * cs[e] + o * sn[e]) : (y[e] * cs[e] - o * sn[e]);
                    const float cn = cs[e] * dc[e] - sn[e] * dsn[e]; sn[e] = sn[e] * dc[e] + cs[e] * dsn[e]; cs[e] = cn; }
            }
            v4u o; o.x = pk2(y[0], y[1]); o.y = pk2(y[2], y[3]); o.z = pk2(y[4], y[5]); o.w = pk2(y[6], y[7]);
            *(GAS v4u*)(ub0 + (size_t)rr * PW * 2 + voff) = o;
            if (km) {
#pragma unroll
                for (int e = 0; e < 8; ++e) ks[e] += y[e];
            }
        }
        if (km) {
            const int b = row0 / SEQ, blk = pos0 >> 8, sub = (pos0 & 255) / T3A_ROWS, h = 4 * (g - 3) + hv;
            float* kp = (float*)(ws + WS_KPART) + ((((size_t)(b * 12 + h) * NBLK + blk) * KSUB + sub) * HD) + c8;
            *(f32x4*)kp = (f32x4){ks[0], ks[1], ks[2], ks[3]}; *(f32x4*)(kp + 4) = (f32x4){ks[4], ks[5], ks[6], ks[7]};
        }
    }
}
__device__ __forceinline__ void attn_phase(unsigned char* ws, char* lds, int vcu, int G, int wave0, int layer) {
    const int tid = fresh_tid(wave0);
    int qx = (vcu * 8) / G; if (qx > 7) qx = 7;
    unsigned* qctr = (unsigned*)(ws + WS_CTL) + CW_ATTQ + (layer * 8 + qx) * 64;
    if (tid == 0) *(volatile unsigned*)(lds + att::OFF_NXT) = __hip_atomic_fetch_add(qctr, 1u, __ATOMIC_RELAXED, __HIP_MEMORY_SCOPE_AGENT);
    __syncthreads();
    int k = __builtin_amdgcn_readfirstlane((int)*(volatile unsigned*)(lds + att::OFF_NXT));
    __syncthreads();
    if (k >= att::QITEMS) return;
    float fox_thr;
    { const float* gq = kargs()->in[5] + layer * HD; const float* gk_ = kargs()->in[6] + layer * HD; const int lane = tid & 63;
      float mq = fmaxf(fabsf(gq[lane]), fabsf(gq[lane + 64])), mk = fmaxf(fabsf(gk_[lane]), fabsf(gk_[lane + 64]));
      mq = wave_max(mq, lane); mk = wave_max(mk, lane);
      fox_thr = __int_as_float(__builtin_amdgcn_readfirstlane(__float_as_int(106.0f * 11.313708498984761f + 2.0f * (128.0f * 1.02f) * mq * mk))); }
    att::Seam S;
    att::prime(att::q_item(qx, k), ws, lds, S, tid);
    for (;;) {
        const int nk = att::block(att::q_item(qx, k), qctr, qx, ws, lds, S, tid, fox_thr);
        if (nk >= att::QITEMS) break;
        k = nk;
    }
}
__device__ __forceinline__ void t5_phase(unsigned char* ws, int l, int vcu, int NGW, int wave0) {
    FRESH_IDS(vcu);
    KArgs ka = kargs(); const float* q1 = ka->in[10]; const float* k1 = ka->in[11]; const float* q2 = ka->in[12]; const float* k2 = ka->in[13];
    float s1 = q1[l * HD + lane] * k1[l * HD + lane] + q1[l * HD + 64 + lane] * k1[l * HD + 64 + lane];
    float s2 = q2[l * HD + lane] * k2[l * HD + lane] + q2[l * HD + 64 + lane] * k2[l * HD + 64 + lane];
    const float lam_init = 0.8f - 0.6f * expf(-0.3f * (float)l);
    const float lam = expf(wave_sum(s1, lane)) - expf(wave_sum(s2, lane)) + lam_init;
    const f32x4 gn = *(const f32x4*)(ka->in[14] + l * 256 + 4 * lane);
    const bf16* D0 = (const bf16*)(ws + WS_DIFF); const bf16* D1 = D0 + (size_t)M * 1024; bf16* MIX = (bf16*)(ws + WS_MIX);
    for (int it = gw; it < M * NH_D; it += NGW) {
        const int row = it >> 2, h = it & 3;
        const v2u a = *(const v2u*)(D0 + (size_t)row * 1024 + h * 256 + 4 * lane), b = *(const v2u*)(D1 + (size_t)row * 1024 + h * 256 + 4 * lane);
        const float v0 = bflo(a.x) - lam * bflo(b.x), v1 = bfhi(a.x) - lam * bfhi(b.x), v2 = bflo(a.y) - lam * bflo(b.y), v3 = bfhi(a.y) - lam * bfhi(b.y);
        const float ss = wave_sum((v0 * v0 + v1 * v1) + (v2 * v2 + v3 * v3), lane);
        const float sc = (1.0f / sqrtf(ss * (1.0f / 256.0f) + NORM_EPS)) * (1.0f - lam_init);
        v2u o; o.x = pk2(v0 * sc * gn.x, v1 * sc * gn.y); o.y = pk2(v2 * sc * gn.z, v3 * sc * gn.w);
        { const int col = 3072 + h * 256 + 4 * lane; *(v2u*)(MIX + ((size_t)(col >> 6) * M + row) * 64 + (col & 63)) = o; }
    }
}

__global__ void __launch_bounds__(NWAVES * 64, 2) mk_fwd(Args args_unused) {
    extern __shared__ __attribute__((aligned(16))) unsigned char lds_raw[];
    LAS unsigned char* lds = (LAS unsigned char*)lds_raw;
    volatile LAS unsigned* MISC = (volatile LAS unsigned*)(lds + MISC_OFF);
    const int wave0 = __builtin_amdgcn_readfirstlane((int)threadIdx.x >> 6);
    const int tid = fresh_tid(wave0);
    const int G = gridDim.x; const int bx = blockIdx.x; const int vcu = (G % 8 == 0) ? (bx % 8) * (G / 8) + bx / 8 : bx;
    const int NGW = G * NWAVES;
    for (int u = tid; u < (LDS_BYTES - LDSCTL_OFF) / 4; u += NWAVES * 64) ((LAS unsigned*)(lds + LDSCTL_OFF))[u] = 0u;
    __syncthreads();
    XcdBarrier bar; { unsigned char* ws0 = kargs()->ws; bar.bar = (unsigned*)(ws0 + WS_CTL) + CW_BAR; bar.x = 0; bar.st = nullptr;
        if (MK_N_LAUNCHES == 1) bar = xcd_barrier_post((unsigned*)(ws0 + WS_CTL) + CW_BAR, MISC + 8); }
#define GRID_BAR() do { if (MK_N_LAUNCHES == 1) xcd_barrier(bar); } while (0)
    const int lo = kargs()->ph_lo, hi = kargs()->ph_hi;
#define IN(k) (lo <= (k) && (k) < hi)
    unsigned long long tpA = 0ull, tpD = 0ull;
#define TP_BEGIN(k) do { if (MK_TIME_PHASE >= 0 && (k) == MK_TIME_PHASE) tpA = __builtin_amdgcn_s_memrealtime(); } while (0)
#define TP_END(k) do { if (MK_TIME_PHASE >= 0 && (k) == MK_TIME_PHASE) tpD = __builtin_amdgcn_s_memrealtime() - tpA; } while (0)
#define BOTH(k) (IN(k) && IN((k) + 1))
    if (IN(0)) { TP_BEGIN(0); for (int rep = 0; rep < REPS(100); ++rep) p0_prologue(kargs()->ws, lds, vcu, NGW, wave0, 0, 0); if (BOTH(0)) GRID_BAR(); TP_END(0); }
    for (int l = 0; l < DEPTH; ++l) {
        const int pb = 2 + 8 * l;
        if (l > 0 && IN(pb - 1)) { TP_BEGIN(pb - 1); p0_prologue(kargs()->ws, lds, vcu, NGW, wave0, l, 0); if (BOTH(pb - 1)) GRID_BAR(); TP_END(pb - 1); }
        if (IN(pb + 0)) { TP_BEGIN(pb + 0); unsigned char* ws = kargs()->ws;
            pg8::Gemm g{(const bf16*)(ws + WS_XN), (const bf16*)(ws + WS_WIN) + (size_t)l * PW * DM, M, PW, DM}; pg8::StaticOrder S; S.init(M, PW, G, bx);
            pg8::EpiStoreBf16 E{(bf16*)(ws + WS_PROJ), PW, (const float*)(ws + WS_CTL) + CW_SSQ + 2 * l * M, 1.0f / DM, NORM_EPS};
            for (int rep = 0; rep < REPS(0); ++rep) pg8::gemm_phase<pg8::EpiStoreBf16, pg8::StaticOrder, true, true, true>(lds + RING_OFF, g, S, E, fresh_tid(wave0));
            if (BOTH(pb + 0)) GRID_BAR(); TP_END(pb + 0); }
        if (IN(pb + 1)) { TP_BEGIN(pb + 1); t3_phase(kargs()->ws, lds, l, vcu, G, wave0); p0_prologue(kargs()->ws, lds, vcu, NGW, wave0, l, 1);     if (BOTH(pb + 1)) GRID_BAR(); TP_END(pb + 1); }
        if (IN(pb + 2)) { TP_BEGIN(pb + 2);
            attn_phase(kargs()->ws, (char*)lds_raw + RING_OFF, vcu, G, wave0, l);
            if (BOTH(pb + 2)) GRID_BAR(); TP_END(pb + 2); }
        if (IN(pb + 3)) { TP_BEGIN(pb + 3); for (int rep = 0; rep < REPS(4); ++rep) t5_phase(kargs()->ws, l, vcu, NGW, wave0); if (BOTH(pb + 3)) GRID_BAR(); TP_END(pb + 3); }
        if (IN(pb + 4)) { TP_BEGIN(pb + 4); KArgs ka = kargs(); unsigned char* ws = ka->ws; const float* xin = (l == 0) ? ka->in[0] : (const float*)(ws + WS_XB);
            pg8::Gemm g{(const bf16*)(ws + WS_MIX), (const bf16*)(ws + WS_WOUT) + (size_t)l * DM * DM, M, DM, DM}; pg8::StaticOrder S; S.init(M, DM, G, bx);
            pg8::EpiResid E{xin, ka->out, DM, (bf16*)(ws + WS_XN), (float*)(ws + WS_CTL) + CW_SSQ + (2 * l + 1) * M, (float*)(ws + WS_SSP) + (size_t)(2 * l) * M * 16, (unsigned*)(ws + WS_CTL) + CW_PCNT + (2 * l) * 32 * 64, (LAS float*)(lds + XL_OFF), DM / 256, M, 1.0f / DM, NORM_EPS};
            pg8::gemm_phase<pg8::EpiResid, pg8::StaticOrder, true, true, true>(lds + RING_OFF, g, S, E, fresh_tid(wave0));
            p0_prologue(ws, lds, vcu, NGW, wave0, l, 2);
            if (BOTH(pb + 4)) GRID_BAR(); TP_END(pb + 4); }
        if (IN(pb + 5)) { TP_BEGIN(pb + 5); unsigned char* ws = kargs()->ws;
            pg8::Gemm g{(const bf16*)(ws + WS_XN), (const bf16*)(ws + WS_WGU) + (size_t)l * NGU * DM, M, NGU, DM}; pg8::StaticOrder S; S.init(M, NGU, G, bx);
            pg8::EpiSwiGLU E{(bf16*)(ws + WS_HB), FF, (const float*)(ws + WS_CTL) + CW_SSQ + (2 * l + 1) * M, 1.0f / DM, NORM_EPS, M};
            for (int rep = 0; rep < REPS(6); ++rep) pg8::gemm_phase<pg8::EpiSwiGLU, pg8::StaticOrder, true, true, true>(lds + RING_OFF, g, S, E, fresh_tid(wave0));
            p0_prologue(ws, lds, vcu, NGW, wave0, l, 3);
            if (BOTH(pb + 5)) GRID_BAR(); TP_END(pb + 5); }
        if (IN(pb + 6)) { TP_BEGIN(pb + 6); KArgs ka = kargs(); unsigned char* ws = ka->ws; const bool lastl = (l == DEPTH - 1); float* x2 = lastl ? ka->out : (float*)(ws + WS_XB);
            pg8::Gemm g{(const bf16*)(ws + WS_HB), (const bf16*)(ws + WS_WD) + (size_t)l * DM * FF, M, DM, FF}; pg8::StaticOrder S; S.init(M, DM, G, bx);
            pg8::EpiResid E{ka->out, x2, DM, lastl ? (bf16*)nullptr : (bf16*)(ws + WS_XN), (float*)(ws + WS_CTL) + CW_SSQ + (2 * l + 2) * M, (float*)(ws + WS_SSP) + (size_t)(2 * l + 1) * M * 16, (unsigned*)(ws + WS_CTL) + CW_PCNT + (2 * l + 1) * 32 * 64, (LAS float*)(lds + XL_OFF), DM / 256, M, 1.0f / DM, NORM_EPS};
            pg8::gemm_phase<pg8::EpiResid, pg8::StaticOrder, true, true, true>(lds + RING_OFF, g, S, E, fresh_tid(wave0));
              TP_END(pb + 6); }
    }
    if (MK_TIME_PHASE >= 0 && blockIdx.x == 0) { const unsigned long long t0 = __builtin_amdgcn_s_memrealtime(); while (__builtin_amdgcn_s_memrealtime() - t0 < tpD) __builtin_amdgcn_s_sleep(8); }
#undef IN
#undef BOTH
}

extern "C" void kernel_launch(void* const* d_in, const int* in_sizes, int n_in, void* d_out, int out_size, void* d_ws, size_t ws_size, hipStream_t stream) {
    static int grid = 0;
    if (grid == 0) {
        if (n_in != 20 || in_sizes[0] != M * DM || out_size != M * DM || ws_size < WS_END) { fprintf(stderr, "kernel_launch: unexpected shapes (n_in %d, in0 %d, out %d, ws %zu < %zu); nothing launched\n", n_in, n_in > 0 ? in_sizes[0] : -1, out_size, ws_size, (size_t)WS_END); grid = -1; return; }
        int dev = 0, cus = 0, per_cu = 0;
        if (hipGetDevice(&dev) != hipSuccess || hipDeviceGetAttribute(&cus, hipDeviceAttributeMultiprocessorCount, dev) != hipSuccess) { grid = -1; return; }
        if (hipFuncSetAttribute((const void*)mk_fwd, hipFuncAttributeMaxDynamicSharedMemorySize, LDS_BYTES) != hipSuccess) { fprintf(stderr, "kernel_launch: hipFuncSetAttribute failed\n"); grid = -1; return; }
        if (hipOccupancyMaxActiveBlocksPerMultiprocessor(&per_cu, (const void*)mk_fwd, NWAVES * 64, LDS_BYTES) != hipSuccess || per_cu < 1) fprintf(stderr, "kernel_launch: occupancy query says %d\n", per_cu);
        (void)hipGetLastError();
        grid = cus;
    }
    if (grid < 0) return;
    if (hipMemsetAsync((char*)d_ws + WS_CTL, 0, CTL_ZERO_BYTES, stream) != hipSuccess) return;
    Args a{};
    for (int i = 0; i < 20; ++i) a.in[i] = (const float*)d_in[i];
    a.out = (float*)d_out; a.ws = (unsigned char*)d_ws;
    if (MK_N_LAUNCHES == 1) { a.ph_lo = 0; a.ph_hi = NPH; hipLaunchKernelGGL(mk_fwd, dim3(grid), dim3(NWAVES * 64), LDS_BYTES, stream, a); }
    else for (int p = 0; p < NPH; ++p) { a.ph_lo = p; a.ph_hi = p + 1; hipLaunchKernelGGL(mk_fwd, dim3(grid), dim3(NWAVES * 64), LDS_BYTES, stream, a); }
}
```

```cpp
#include <hip/hip_runtime.h>
#include <cstdio>
#include <cstdint>
#include <cmath>
namespace pg8 {
#define PG8_LAS __attribute__((address_space(3)))
typedef unsigned short bf16_t;
typedef short bf16x8 __attribute__((ext_vector_type(8)));
typedef float f32x4 __attribute__((ext_vector_type(4)));
typedef unsigned u32x4 __attribute__((ext_vector_type(4)));
constexpr int BM = 256, BK = 64, HALF = 128, HTB = HALF * BK * 2  , STAGE_BYTES = 8 * HTB, NXCD = 8, WGM = 8;

__host__ __device__ __forceinline__ int lds_byte(int r, int c) { const int st = (r >> 4) * 2 + (c >> 5), rr = r & 15, cc = c & 31, ob = rr * 64 + cc * 2; return st * 1024 + (ob ^ (((ob >> 9) & 1) << 5)); }
__host__ __device__ __forceinline__ void stage_rc(int b, int& R, int& C) { const int st = b / 1024, sb = b % 1024, swz = sb ^ (((sb >> 9) & 1) << 5); R = (st >> 1) * 16 + swz / 64; C = (st & 1) * 32 + (swz % 64) / 2; }
__host__ __device__ __forceinline__ int perm32(int rho) { const int n = rho >> 4, i = rho & 15; return 8 * (i >> 2) + 4 * n + (i & 3); }

struct Unit { int pm, pn; };
struct Gemm { const bf16_t* A; const bf16_t* Bt; int M, N, K; };

struct StaticOrder {
    int nM, nN, nwg, G, c;
    __host__ __device__ void init(int M, int N, int G_, int c_) { nM = M / BM; nN = N / BM; nwg = nM * nN; G = G_; c = c_; }
    __host__ __device__ bool next(int i, Unit& u) const {
        const long L = (long)i * G + c; if (L >= nwg) return false;
        int wgid = (int)L; { const int q = nwg / NXCD, r = nwg % NXCD, xcd = wgid % NXCD, off = wgid / NXCD; wgid = (xcd < r ? xcd * (q + 1) : r * (q + 1) + (xcd - r) * q) + off; }
        const int nig = WGM * nN, gid = wgid / nig, fm = gid * WGM, gsz = (nM - fm) < WGM ? (nM - fm) : WGM;
        u.pm = fm + ((wgid % nig) % gsz); u.pn = (wgid % nig) / gsz; return true;
    }
    __device__ __forceinline__ void a_ready(const Unit&) const {}
    __device__ __forceinline__ void done(const Unit&) const {}
};

__device__ __forceinline__ unsigned cvt_pk_bf16(float lo, float hi) { unsigned r; asm volatile("v_cvt_pk_bf16_f32 %0, %1, %2" : "=v"(r) : "v"(lo), "v"(hi)); return r; }
__device__ __forceinline__ float rs_of(const float* ssq, int row, float inv_k, float eps) { (void)inv_k; (void)eps; return ssq[row]; }
struct EpiStoreBf16 {
    static constexpr bool PERM = true, AFTER_DRAIN = false;
    bf16_t* O; int ldc; const float* ssq; float inv_k, eps;
    __device__ __forceinline__ void prefetch(const Unit& u, int wr, int fr, float (&pre)[8]) const {
#pragma unroll
        for (int i = 0; i < 8; ++i) pre[i] = ssq[u.pm * BM + wr * 64 + fr + (i >> 2) * HALF + (i & 3) * 16]; }
    __device__ __forceinline__ void operator()(const f32x4 (&acc)[2][2][4][2], const Unit& u, int wr, int wc, int fr, int fq, const float (&pre)[8]) const {
        const int row0 = u.pm * BM + wr * 64 + fr, col0 = u.pn * BM + wc * 32 + 8 * fq;
#pragma unroll
        for (int ai = 0; ai < 2; ++ai)
#pragma unroll
            for (int m = 0; m < 4; ++m) { const int row = row0 + ai * HALF + m * 16; bf16_t* rowp = O + (size_t)row * ldc + col0; const float r = pre[ai * 4 + m];
#pragma unroll
                for (int bj = 0; bj < 2; ++bj) { const f32x4 v0 = acc[ai][bj][m][0] * r, v1 = acc[ai][bj][m][1] * r;
                    u32x4 w; w.x = cvt_pk_bf16(v0[0], v0[1]); w.y = cvt_pk_bf16(v0[2], v0[3]); w.z = cvt_pk_bf16(v1[0], v1[1]); w.w = cvt_pk_bf16(v1[2], v1[3]);
                    *(u32x4*)(rowp + bj * HALF) = w; } }
    }
};
__device__ __forceinline__ float silu_mul(float g, float u) { const float e = __builtin_amdgcn_exp2f(-g * 1.4426950408889634f); return g * __builtin_amdgcn_rcpf(1.0f + e) * u; }
struct EpiSwiGLU {
    static constexpr bool PERM = true, AFTER_DRAIN = false;
    bf16_t* O; int ldc; const float* ssq; float inv_k, eps; int tiledM;
    __device__ __forceinline__ void prefetch(const Unit& u, int wr, int fr, float (&pre)[8]) const {
#pragma unroll
        for (int i = 0; i < 8; ++i) pre[i] = ssq[u.pm * BM + wr * 64 + fr + (i >> 2) * HALF + (i & 3) * 16]; }
    __device__ __forceinline__ void operator()(const f32x4 (&acc)[2][2][4][2], const Unit& u, int wr, int wc, int fr, int fq, const float (&pre)[8]) const {
        const int row0 = u.pm * BM + wr * 64 + fr, col0 = u.pn * HALF + wc * 32 + 8 * fq;
#pragma unroll
        for (int ai = 0; ai < 2; ++ai)
#pragma unroll
            for (int m = 0; m < 4; ++m) { const int row = row0 + ai * HALF + m * 16; const float r = pre[ai * 4 + m];
                bf16_t* rowp = tiledM ? O + ((size_t)(col0 >> 6) * tiledM + row) * 64 + (col0 & 63) : O + (size_t)row * ldc + col0;
                const f32x4 g0 = acc[ai][0][m][0] * r, g1 = acc[ai][0][m][1] * r, u0 = acc[ai][1][m][0] * r, u1 = acc[ai][1][m][1] * r;
                u32x4 w; w.x = cvt_pk_bf16(silu_mul(g0[0], u0[0]), silu_mul(g0[1], u0[1])); w.y = cvt_pk_bf16(silu_mul(g0[2], u0[2]), silu_mul(g0[3], u0[3]));
                w.z = cvt_pk_bf16(silu_mul(g1[0], u1[0]), silu_mul(g1[1], u1[1])); w.w = cvt_pk_bf16(silu_mul(g1[2], u1[2]), silu_mul(g1[3], u1[3]));
                *(u32x4*)rowp = w; }
    }
};
struct EpiResid {
    static constexpr bool PERM = false, AFTER_DRAIN = false;
    const float* base; float* out; int ldc; bf16_t* xb; float* ssq; float* ssp; unsigned* pcnt; PG8_LAS float* xl; int ntn; int xbM; float rs_inv_k, rs_eps;
    __device__ __forceinline__ void prefetch(const Unit&, int, int, float (&)[8]) const {}
    __device__ __forceinline__ void operator()(const f32x4 (&acc)[2][2][4][2], const Unit& u, int wr, int wc, int fr, int fq, const float (&)[8]) const {
        const int row0 = u.pm * BM + wr * 64 + fr, col0 = u.pn * BM + wc * 32 + 4 * fq; const int lane = fr + 16 * fq, tid = (wr * 4 + wc) * 64 + lane;
        typedef unsigned u32x2 __attribute__((ext_vector_type(2)));
#pragma unroll
        for (int ai = 0; ai < 2; ++ai)
#pragma unroll
            for (int m = 0; m < 4; ++m) { const int row = row0 + ai * HALF + m * 16; const size_t off = (size_t)row * ldc + col0; float ss = 0.f;
#pragma unroll
                for (int bj = 0; bj < 2; ++bj)
#pragma unroll
                    for (int n = 0; n < 2; ++n) { const f32x4 b = *(const f32x4*)(base + off + bj * HALF + n * 16); const f32x4 o = b + acc[ai][bj][m][n]; *(f32x4*)(out + off + bj * HALF + n * 16) = o;
                        if (xb) { u32x2 w; w.x = cvt_pk_bf16(o[0], o[1]); w.y = cvt_pk_bf16(o[2], o[3]); const int col = col0 + bj * HALF + n * 16; *(u32x2*)(xb + ((size_t)(col >> 6) * xbM + row) * 64 + (col & 63)) = w; }
                        ss += (o[0] * o[0] + o[1] * o[1]) + (o[2] * o[2] + o[3] * o[3]); }
                if (xb) { ss += __int_as_float(__builtin_amdgcn_ds_bpermute((lane ^ 16) << 2, __float_as_int(ss))); ss += __int_as_float(__builtin_amdgcn_ds_bpermute((lane ^ 32) << 2, __float_as_int(ss)));
                    if (fq == 0) xl[(ai * HALF + wr * 64 + m * 16 + fr) * 4 + wc] = ss; } }
        if (xb) {
            asm volatile("s_waitcnt lgkmcnt(0)" ::: "memory"); __builtin_amdgcn_s_barrier(); asm volatile("" ::: "memory");
            if (tid < BM) { const f32x4 p4 = *(const PG8_LAS f32x4*)(xl + tid * 4); const float t = (p4[0] + p4[1]) + (p4[2] + p4[3]);
                __hip_atomic_store(ssp + (size_t)(u.pm * BM + tid) * 16 + u.pn, t, __ATOMIC_RELAXED, __HIP_MEMORY_SCOPE_AGENT); }
            asm volatile("s_waitcnt vmcnt(0)" ::: "memory");
            __builtin_amdgcn_s_barrier(); asm volatile("" ::: "memory");
            if (tid == 0) { const unsigned old = __hip_atomic_fetch_add(pcnt + 64 * u.pm, 1u, __ATOMIC_RELAXED, __HIP_MEMORY_SCOPE_AGENT); ((PG8_LAS unsigned*)xl)[1024] = (old == (unsigned)(ntn - 1)) ? 1u : 0u; }
            asm volatile("s_waitcnt vmcnt(0) lgkmcnt(0)" ::: "memory"); __builtin_amdgcn_s_barrier(); asm volatile("" ::: "memory");
            if (((volatile PG8_LAS unsigned*)xl)[1024] != 0u && tid < BM) {
                __builtin_amdgcn_fence(__ATOMIC_ACQUIRE, "agent");
                const float* pp = ssp + (size_t)(u.pm * BM + tid) * 16; float t = 0.f;
                for (int j = 0; j < ntn; ++j) t += __hip_atomic_load(pp + j, __ATOMIC_RELAXED, __HIP_MEMORY_SCOPE_AGENT);
                ssq[u.pm * BM + tid] = 1.0f / sqrtf(t * rs_inv_k + rs_eps); }
        }
    }
};

template <class Epi, class Sched, bool ALIGN_EPI = false, bool SP2 = false, bool TILED = false>
__device__ __forceinline__ void gemm_phase(PG8_LAS unsigned char* lds, const Gemm g, const Sched& S, const Epi& E, int tid_) {
    asm volatile("" : "+v"(tid_));
    const int tid = tid_, wid = __builtin_amdgcn_readfirstlane(tid >> 6), lane = tid & 63, wr = wid >> 2, wc = wid & 3, fr = lane & 15, fq = lane >> 4;
    const int K = g.K, nt = K / BK; const int RP = TILED ? BK : K;
    unsigned voffA[2], voffB[2];
#pragma unroll
    for (int i = 0; i < 2; ++i) { int R, C; stage_rc(tid * 16 + i * 8192, R, C); const int Rb = Epi::PERM ? ((R & ~31) + perm32(R & 31)) : R;
        voffA[i] = (unsigned)(R * RP + C) * 2u; voffB[i] = (unsigned)(Rb * RP + C) * 2u; }
    const size_t kstepA = TILED ? (size_t)g.M * BK * 2 : (size_t)(BK * 2), kstepB = TILED ? (size_t)g.N * BK * 2 : (size_t)(BK * 2);
    const size_t hstep = (size_t)HALF * RP * 2;
    const size_t tstep = 2 * hstep;
    const unsigned ldsw = (unsigned)wid * 1024u;
    const int aoff = lds_byte(wr * 64 + fr, fq * 8), boff = lds_byte(wc * 32 + fr, fq * 8);
#define PG8_SA(b, h) (((b) * 2 + (h)) * HTB)
#define PG8_SB(b, h) ((4 + (b) * 2 + (h)) * HTB)
#define PG8_STAGE(bufoff, gbase, voff) do { _Pragma("unroll") for (int _i = 0; _i < 2; ++_i) \
        __builtin_amdgcn_global_load_lds((const unsigned*)((const char*)(gbase) + (voff)[_i]), (PG8_LAS unsigned*)(lds + (bufoff) + ldsw + _i * 8192), 16, 0, 0); } while (0)
#define PG8_LDA(dst, b, h) do { _Pragma("unroll") for (int m = 0; m < 4; ++m) _Pragma("unroll") for (int k = 0; k < 2; ++k) dst[m][k] = *(const PG8_LAS bf16x8*)(lds + PG8_SA(b, h) + aoff + m * 2048 + k * 1024); } while (0)
#define PG8_LDB(dst, b, h) do { _Pragma("unroll") for (int n = 0; n < 2; ++n) _Pragma("unroll") for (int k = 0; k < 2; ++k) dst[n][k] = *(const PG8_LAS bf16x8*)(lds + PG8_SB(b, h) + boff + n * 2048 + k * 1024); } while (0)
#define PG8_MMA(ai, bj, At, Bt) do { __builtin_amdgcn_s_setprio(1); _Pragma("unroll") for (int m = 0; m < 4; ++m) _Pragma("unroll") for (int n = 0; n < 2; ++n) _Pragma("unroll") for (int k = 0; k < 2; ++k) \
        acc[ai][bj][m][n] = __builtin_amdgcn_mfma_f32_16x16x32_bf16(Bt[n][k], At[m][k], acc[ai][bj][m][n], 0, 0, 0); __builtin_amdgcn_s_setprio(0); } while (0)
#define PG8_WAIT_V(n) asm volatile("s_waitcnt vmcnt(" #n ")" ::: "memory")
#define PG8_WAIT_L(n) asm volatile("s_waitcnt lgkmcnt(" #n ")" ::: "memory")
#define PG8_BAR __builtin_amdgcn_s_barrier()
#define PG8_SCHED __builtin_amdgcn_sched_barrier(0)
    Unit cur, nxt; int ui = 0;
    if (!S.next(0, cur)) return;
    f32x4 acc[2][2][4][2];
    float pre[8];
#pragma unroll
    for (int i_ = 0; i_ < 8; ++i_) pre[i_] = 0.f;
#pragma unroll
    for (int a = 0; a < 2; ++a)
#pragma unroll
        for (int b = 0; b < 2; ++b)
#pragma unroll
            for (int m = 0; m < 4; ++m)
#pragma unroll
                for (int n = 0; n < 2; ++n) acc[a][b][m][n] = (f32x4){0.f, 0.f, 0.f, 0.f};
    bf16x8 At[4][2], B0[2][2], B1[2][2];
    const char* cA = (const char*)g.A + (size_t)cur.pm * tstep; const char* cB = (const char*)g.Bt + (size_t)cur.pn * tstep;
    S.a_ready(cur);
    if constexpr (SP2) {
        PG8_STAGE(PG8_SB(0, 0), cB, voffB); PG8_STAGE(PG8_SB(0, 1), cB + hstep, voffB); PG8_STAGE(PG8_SA(0, 0), cA, voffA); PG8_STAGE(PG8_SA(0, 1), cA + hstep, voffA);
        if (wr == 1) PG8_BAR;
        PG8_WAIT_V(2); PG8_BAR;
        PG8_STAGE(PG8_SB(1, 0), cB + kstepB, voffB); PG8_STAGE(PG8_SA(1, 0), cA + kstepA, voffA); PG8_STAGE(PG8_SB(1, 1), cB + hstep + kstepB, voffB);
        PG8_WAIT_V(6); PG8_BAR;
    } else {
        PG8_STAGE(PG8_SB(0, 0), cB, voffB); PG8_STAGE(PG8_SA(0, 0), cA, voffA); PG8_STAGE(PG8_SB(0, 1), cB + hstep, voffB); PG8_STAGE(PG8_SA(0, 1), cA + hstep, voffA);
        if (wr == 1) PG8_BAR;
        PG8_WAIT_V(4); PG8_BAR;
        PG8_STAGE(PG8_SB(1, 0), cB + kstepB, voffB); PG8_STAGE(PG8_SA(1, 0), cA + kstepA, voffA); PG8_STAGE(PG8_SB(1, 1), cB + hstep + kstepB, voffB);
        PG8_WAIT_V(6); PG8_BAR;
    }
    for (;;) {
        const bool has_next = S.next(ui + 1, nxt);
        const char* nA = has_next ? (const char*)g.A + (size_t)nxt.pm * tstep : cA; const char* nB = has_next ? (const char*)g.Bt + (size_t)nxt.pn * tstep : cB;
        for (int t = 0; t < nt; t += 2) {
            const bool last = (t == nt - 2);
            if (last) E.prefetch(cur, wr, fr, pre);
            const char* a1 = cA + (size_t)(t + 1) * kstepA;
            const char* a2 = last ? nA : cA + (size_t)(t + 2) * kstepA; const char* b2 = last ? nB : cB + (size_t)(t + 2) * kstepB;
            const char* a3 = a2 + kstepA; const char* b3 = b2 + kstepB;
            if (last && has_next) S.a_ready(nxt);
            if constexpr (SP2) {
            PG8_LDB(B0, 0, 0); PG8_LDB(B1, 0, 1); PG8_SCHED; PG8_LDA(At, 0, 0); PG8_STAGE(PG8_SA(1, 1), a1 + hstep, voffA);
            PG8_WAIT_V(8); PG8_WAIT_L(0); PG8_BAR; PG8_MMA(0, 0, At, B0); PG8_MMA(0, 1, At, B1); PG8_BAR; PG8_SCHED;
            PG8_LDA(At, 0, 1); PG8_STAGE(PG8_SB(0, 0), b2, voffB); PG8_STAGE(PG8_SB(0, 1), b2 + hstep, voffB); PG8_STAGE(PG8_SA(0, 0), a2, voffA);
            PG8_WAIT_V(8); PG8_WAIT_L(0); PG8_BAR; PG8_MMA(1, 0, At, B0); PG8_MMA(1, 1, At, B1); PG8_BAR; PG8_SCHED;
            PG8_LDB(B0, 1, 0); PG8_LDB(B1, 1, 1); PG8_SCHED; PG8_LDA(At, 1, 0); PG8_STAGE(PG8_SA(0, 1), a2 + hstep, voffA);
            PG8_WAIT_V(8); PG8_WAIT_L(0); PG8_BAR; PG8_MMA(0, 0, At, B0); PG8_MMA(0, 1, At, B1); PG8_BAR; PG8_SCHED;
            PG8_LDA(At, 1, 1); PG8_STAGE(PG8_SB(1, 0), b3, voffB); PG8_STAGE(PG8_SB(1, 1), b3 + hstep, voffB); PG8_STAGE(PG8_SA(1, 0), a3, voffA);
            PG8_WAIT_V(8); PG8_WAIT_L(0); PG8_BAR; PG8_MMA(1, 0, At, B0); PG8_MMA(1, 1, At, B1); PG8_BAR; PG8_SCHED;
            } else {
            PG8_LDB(B0, 0, 0); PG8_SCHED; PG8_LDA(At, 0, 0); PG8_STAGE(PG8_SA(1, 1), a1 + hstep, voffA);
            PG8_WAIT_L(8); PG8_BAR; PG8_WAIT_L(0); PG8_MMA(0, 0, At, B0); PG8_BAR; PG8_SCHED;
            PG8_LDB(B1, 0, 1); PG8_STAGE(PG8_SB(0, 0), b2, voffB);
            PG8_BAR; PG8_WAIT_L(0); PG8_MMA(0, 1, At, B1); PG8_BAR;
            PG8_LDA(At, 0, 1); PG8_STAGE(PG8_SA(0, 0), a2, voffA);
            PG8_BAR; PG8_WAIT_L(0); PG8_MMA(1, 0, At, B0); PG8_BAR; PG8_SCHED;
            PG8_STAGE(PG8_SB(0, 1), b2 + hstep, voffB);
            PG8_WAIT_V(6); PG8_BAR; PG8_MMA(1, 1, At, B1); PG8_BAR;
            PG8_LDB(B0, 1, 0); PG8_SCHED; PG8_LDA(At, 1, 0); PG8_STAGE(PG8_SA(0, 1), a2 + hstep, voffA);
            PG8_WAIT_L(8); PG8_BAR; PG8_WAIT_L(0); PG8_MMA(0, 0, At, B0); PG8_BAR; PG8_SCHED;
            PG8_LDB(B1, 1, 1); PG8_STAGE(PG8_SB(1, 0), b3, voffB);
            PG8_BAR; PG8_WAIT_L(0); PG8_MMA(0, 1, At, B1); PG8_BAR;
            PG8_LDA(At, 1, 1); PG8_STAGE(PG8_SA(1, 0), a3, voffA);
            PG8_BAR; PG8_WAIT_L(0); PG8_MMA(1, 0, At, B0); PG8_BAR; PG8_SCHED;
            PG8_STAGE(PG8_SB(1, 1), b3 + hstep, voffB);
            PG8_WAIT_V(6); PG8_BAR; PG8_MMA(1, 1, At, B1); PG8_BAR;
            }
        }
        if constexpr (ALIGN_EPI) { if (wr == 0) PG8_BAR; }
        if constexpr (!Epi::AFTER_DRAIN) { E(acc, cur, wr, wc, fr, fq, pre); S.done(cur); }
        if (!has_next) break;
#pragma unroll
        for (int a = 0; a < 2; ++a)
#pragma unroll
            for (int b = 0; b < 2; ++b)
#pragma unroll
                for (int m = 0; m < 4; ++m)
#pragma unroll
                    for (int n = 0; n < 2; ++n) acc[a][b][m][n] = (f32x4){0.f, 0.f, 0.f, 0.f};
        cur = nxt; cA = nA; cB = nB; ++ui;
        if constexpr (ALIGN_EPI) { if (wr == 1) PG8_BAR; }
    }
    PG8_WAIT_V(0);
    if constexpr (!ALIGN_EPI) { if (wr == 0) PG8_BAR; }
    PG8_BAR;
    if constexpr (Epi::AFTER_DRAIN) { E.fused(acc, cur, wr, wc, fr, fq, lds, wid, lane); S.done(cur); }
#undef PG8_SA
#undef PG8_SB
#undef PG8_STAGE
#undef PG8_LDA
#undef PG8_LDB
#undef PG8_MMA
#undef PG8_WAIT_V
#undef PG8_WAIT_L
#undef PG8_BAR
#undef PG8_SCHED
}
}
#ifndef MK_N_LAUNCHES
#define MK_N_LAUNCHES 1
#endif
constexpr int NWAVES = 8;
#ifndef MK_REP_PHASE
#define MK_REP_PHASE -1
#endif
#define REPS(k) (((k) == MK_REP_PHASE) ? 2 : 1)
#ifndef MK_TIME_PHASE
#define MK_TIME_PHASE -1
#endif
constexpr int BATCH = 2, SEQ = 4096, DM = 4096, M = BATCH * SEQ, DEPTH = 2;
constexpr int HD = 128, NH_M = 12, NH_F = 12, NH_D = 4;
constexpr int INW = 12300;
constexpr int PW = 12288;
constexpr int FF = 11008, NGU = 2 * FF;
constexpr int C_QM = 0, C_KM = 1536, C_VM = 3072, C_QF = 4608, C_KF = 6144, C_VF = 7680, C_QD = 9216, C_KD = 10240, C_VD = 11264;
constexpr int NBLK = SEQ / 256;
constexpr int T3A_ROWS = 16, KSUB = 256 / T3A_ROWS;
constexpr float NORM_EPS = 1e-6f;
constexpr int NATT = 40;
constexpr int NPH = 1 + 8 * DEPTH;
constexpr size_t MiB = 1u << 20;
constexpr size_t WS_CTL = 0, CTL_ZERO_BYTES = 400 * 1024;
constexpr size_t WS_ROPE = 1 * MiB;
constexpr size_t WS_WF = 3 * MiB;
constexpr size_t WS_LOGF = 4 * MiB;
constexpr size_t WS_BRAW = 5 * MiB;
constexpr size_t WS_SELM = 6 * MiB;
constexpr size_t WS_SSP = 9 * MiB;
constexpr size_t WS_KPART = 10 * MiB + 512 * 1024;
constexpr size_t WS_WIN = 16 * MiB;
constexpr size_t WS_WOUT = 208 * MiB;
constexpr size_t WS_WGU = 272 * MiB;
constexpr size_t WS_WD = 616 * MiB;
constexpr size_t WS_XN = 788 * MiB;
constexpr size_t WS_PROJ = 852 * MiB;
constexpr size_t WS_HB = 852 * MiB;
constexpr size_t WS_MIX = 1044 * MiB;
constexpr size_t WS_DIFF = 1108 * MiB;
constexpr size_t WS_XB = 1140 * MiB;
constexpr size_t WS_END = 1268 * MiB;
static_assert(WS_WIN + (size_t)DEPTH * PW * DM * 2 <= WS_WOUT && WS_WOUT + (size_t)DEPTH * DM * DM * 2 <= WS_WGU && WS_WGU + (size_t)DEPTH * NGU * DM * 2 <= WS_WD && WS_WD + (size_t)DEPTH * DM * FF * 2 <= WS_XN, "ws map (weights)");
static_assert(WS_XN + (size_t)M * DM * 2 <= WS_PROJ && WS_PROJ + (size_t)M * PW * 2 <= WS_MIX && WS_HB + (size_t)M * FF * 2 <= WS_MIX && WS_MIX + (size_t)M * DM * 2 <= WS_DIFF && WS_DIFF + (size_t)2 * M * 1024 * 2 <= WS_XB && WS_XB + (size_t)M * DM * 4 <= WS_END, "ws map (activations)");
constexpr int CW_TMO = 0, CW_CODE = 1, CW_BAR = 4096;
constexpr int CW_SSQ = 16384;
constexpr int CW_PCNT = 65536;
static_assert((98304 + 16 * 64) * 4 <= 400 * 1024, "control words inside the per-call memset");
constexpr int CW_CONV = 98304;
constexpr int CW_ATTQ = 8192;
constexpr int RING_OFF = 0, RING_BYTES = 131072;
constexpr int LDSCTL_OFF = RING_BYTES, MISC_OFF = LDSCTL_OFF + 320;
constexpr int XL_OFF = RING_BYTES + 4096;
constexpr int LDS_BYTES = 147456;

#define GAS __attribute__((address_space(1)))
#define LAS __attribute__((address_space(3)))
typedef unsigned short bf16;
typedef unsigned v4u __attribute__((ext_vector_type(4)));
typedef unsigned v2u __attribute__((ext_vector_type(2)));
typedef float f32x4 __attribute__((ext_vector_type(4)));
typedef float f32x2 __attribute__((ext_vector_type(2)));
typedef short bf16x8 __attribute__((ext_vector_type(8)));
typedef GAS unsigned gu32;
#define RLX_AGENT __ATOMIC_RELAXED, __HIP_MEMORY_SCOPE_AGENT
#define LDS_WAIT() asm volatile("s_waitcnt lgkmcnt(0)" ::: "memory")
#define VM_WAIT() asm volatile("s_waitcnt vmcnt(0)" ::: "memory")
__device__ __forceinline__ unsigned f2bf(float f) { unsigned u = __builtin_bit_cast(unsigned, f); return (u + 0x7fffu + ((u >> 16) & 1u)) >> 16; }
__device__ __forceinline__ unsigned pk2(float lo, float hi) { return f2bf(lo) | (f2bf(hi) << 16); }
__device__ __forceinline__ float bflo(unsigned w) { return __uint_as_float(w << 16); }
__device__ __forceinline__ float bfhi(unsigned w) { return __uint_as_float(w & 0xffff0000u); }
__device__ __forceinline__ float bf2f(bf16 b) { return __uint_as_float((unsigned)b << 16); }
__device__ __forceinline__ float shx(float v, int o, int lane) { return __int_as_float(__builtin_amdgcn_ds_bpermute((lane ^ o) << 2, __float_as_int(v))); }
__device__ __forceinline__ float wave_sum(float v, int lane) {
#pragma unroll
    for (int o = 1; o < 64; o <<= 1) v += shx(v, o, lane);
    return v;
}
__device__ __forceinline__ float wave_max(float v, int lane) {
#pragma unroll
    for (int o = 1; o < 64; o <<= 1) v = fmaxf(v, shx(v, o, lane));
    return v;
}
__device__ __forceinline__ float dpp_xor1(float v) { return __int_as_float(__builtin_amdgcn_mov_dpp(__float_as_int(v), 0xB1, 0xf, 0xf, true)); }
__device__ __forceinline__ int fresh_tid(int wave0) { int lane; asm volatile("v_mbcnt_lo_u32_b32 %0, -1, 0\n\tv_mbcnt_hi_u32_b32 %0, -1, %0" : "=v"(lane)); return wave0 * 64 + lane; }
#define FRESH_IDS(vcu_) const int tid = fresh_tid(wave0); const int lane = tid & 63, wave = wave0; const int gw = (vcu_) * NWAVES + wave; (void)gw; (void)lane; (void)wave; (void)tid

#define XB_TMO      128
#define XB_XCNT(j)  (256  + 64 * (j))
#define XB_XSUB(j)  (1280 + 64 * (j))
#define XB_XGEN(j)  (2304 + 64 * (j))
#define XB_TOP      3328
#define XB_TOPGEN   3392
#define XCD_BAR_WORDS 3456
#define XB_SPIN_CAP (1u << 18)

__device__ __forceinline__ unsigned xb_ld(unsigned* p)              { return __hip_atomic_load(p, __ATOMIC_RELAXED, __HIP_MEMORY_SCOPE_AGENT); }
__device__ __forceinline__ unsigned xb_add(unsigned* p, unsigned v) { return __hip_atomic_fetch_add(p, v, __ATOMIC_RELAXED, __HIP_MEMORY_SCOPE_AGENT); }
__device__ __forceinline__ unsigned xb_xcc_id() { return (unsigned)__builtin_amdgcn_s_getreg((3 << 11) | 20) & 0xFu; }
#define XB_SPIN(cond, bar) do { unsigned _sp = 0; while (cond) { __builtin_amdgcn_s_sleep(1); \
    if ((++_sp & 255u) == 0u) { if (xb_ld(&(bar)[XB_TMO])) break; if (_sp > XB_SPIN_CAP) { atomicAdd(&(bar)[XB_TMO], 1u); break; } } } } while (0)

struct XcdBarrier {
    unsigned* bar; unsigned x;
    volatile LAS unsigned* st;
};

__device__ __forceinline__ XcdBarrier xcd_barrier_post(unsigned* bar, volatile LAS unsigned* st) {
    XcdBarrier b; b.bar = bar; b.x = xb_xcc_id(); b.st = st;
    if (threadIdx.x == 0) (void)xb_add(&bar[XB_XCNT(b.x)], 1u);
    return b;
}
__device__ __forceinline__ void xcd_barrier_complete(unsigned* bar, unsigned x, unsigned& nloc, unsigned& nx) {
    const unsigned G = gridDim.x * gridDim.y * gridDim.z;
    unsigned sum, cnt, mine, sp = 0u;
    for (;;) {
        sum = 0u; cnt = 0u; mine = 0u;
#pragma unroll
        for (unsigned j = 0; j < 16; ++j) { const unsigned c = xb_ld(&bar[XB_XCNT(j)]); sum += c; cnt += (c > 0u) ? 1u : 0u; mine = (j == x) ? c : mine; }
        if (sum == G) break;
        __builtin_amdgcn_s_sleep(1);
        if ((++sp & 255u) == 0u) { if (xb_ld(&bar[XB_TMO])) break; if (sp > XB_SPIN_CAP) { atomicAdd(&bar[XB_TMO], 1u); break; } }
    }
    nloc = mine > 0u ? mine : 1u; nx = cnt > 0u ? cnt : 1u;
}

__device__ __forceinline__ void xcd_barrier(const XcdBarrier& b) {
    asm volatile("s_waitcnt vmcnt(0)" ::: "memory");
    __syncthreads();
    if (threadIdx.x == 0) {
        unsigned* bar = b.bar;
        __builtin_amdgcn_s_waitcnt(0);
        unsigned nloc = b.st[0], nx = b.st[1];
        if (nloc == 0u) { xcd_barrier_complete(bar, b.x, nloc, nx); b.st[0] = nloc; b.st[1] = nx; }
        const unsigned old = xb_add(&bar[XB_XSUB(b.x)], 1u);
        const unsigned gen = old / nloc;
        if (old + 1u == (gen + 1u) * nloc) {
            __builtin_amdgcn_fence(__ATOMIC_RELEASE, "agent");
            asm volatile("s_waitcnt vmcnt(0)" ::: "memory");
            const unsigned og = xb_add(&bar[XB_TOP], 1u);
            const unsigned tg = og / nx;
            if (og + 1u == (tg + 1u) * nx) xb_add(&bar[XB_TOPGEN], 1u);
            else XB_SPIN(xb_ld(&bar[XB_TOPGEN]) == tg, bar);
            __builtin_amdgcn_fence(__ATOMIC_ACQUIRE, "agent");
            xb_add(&bar[XB_XGEN(b.x)], 1u);
            asm volatile("s_waitcnt vmcnt(0)" ::: "memory");
        } else {
            XB_SPIN(xb_ld(&bar[XB_XGEN(b.x)]) == gen, bar);
            __builtin_amdgcn_fence(__ATOMIC_ACQUIRE, "agent");
            asm volatile("s_waitcnt vmcnt(0)" ::: "memory");
        }
    }
    __syncthreads();
}


namespace att {
typedef short s16x4 __attribute__((ext_vector_type(4)));
typedef float f32x16 __attribute__((ext_vector_type(16)));
typedef unsigned u32x4 __attribute__((ext_vector_type(4)));
constexpr int NW = 8, QBLK = 32, KVBLK = 64, QB = NW * QBLK, D = 128;
constexpr int SHM_V = KVBLK * D * 2, SHM_K = KVBLK * D * 2;
constexpr int OFF_WS = 2 * SHM_V + 2 * SHM_K, OFF_BIAS = OFF_WS + NW * 64 * 4, OFF_NXT = OFF_BIAS + SEQ * 4, OFF_WT = OFF_NXT + 16, LDS_BYTES = OFF_WT + 64;
constexpr int QITEMS = (BATCH * NATT / 8) * (SEQ / QB);
constexpr float SCALE = 0.08838834764831845f, THR = 8.f;
constexpr int PITCH = PW;
#define KSWZ(row, colB) ((row) * 256 + ((colB) ^ (((row) & 7) << 4)))
#define SBAR() __builtin_amdgcn_sched_barrier(0)
__device__ __forceinline__ int v_st(int k, int c) { const int kk = (k & ~0xC) | ((k & 4) << 1) | ((k & 8) >> 1); return ((kk >> 3) * 4 + (c >> 5)) * 512 + ((kk & 7) * 32 + (c & 31)) * 2; }
__device__ __forceinline__ int v_rd_base(int lane) { return ((lane & 3) << 3) | (((lane >> 2) & 3) << 6) | (((lane >> 4) & 1) << 5) | (((lane >> 5) & 1) << 8); }
constexpr int v_rd_off(int d0, int ks, int half) { return d0 * 512 + ks * 4096 + half * 2048; }
__device__ __forceinline__ int crow(int r, int hi) { return (r & 3) + 8 * (r >> 2) + 4 * hi; }
__device__ __forceinline__ unsigned cvtpk(float lo, float hi) { unsigned r; asm volatile("v_cvt_pk_bf16_f32 %0, %1, %2" : "=v"(r) : "v"(lo), "v"(hi)); return r; }
__device__ __forceinline__ bf16x8 load8(const bf16* p) { return *reinterpret_cast<const bf16x8*>(p); }
__device__ __forceinline__ void mask_tile(f32x16& p0, f32x16& p1, int dq) {
    const float NEG = -__builtin_inff();
#pragma unroll
    for (int r = 0; r < 16; ++r) { const int c = (r & 3) + 8 * (r >> 2); if (dq - c < 0) p0[r] = NEG; if (dq - c - 32 < 0) p1[r] = NEG; }
}
__device__ __forceinline__ void partialSM(f32x16& p0, f32x16& p1, float& m_reg, float& mn, float& alpha) {
    float pmax = p0[0];
#pragma unroll
    for (int r = 1; r < 16; ++r) pmax = fmaxf(pmax, p0[r]);
#pragma unroll
    for (int r = 0; r < 16; ++r) pmax = fmaxf(pmax, p1[r]);
    { auto rr = __builtin_amdgcn_permlane32_swap(__float_as_uint(pmax), __float_as_uint(pmax), false, false); pmax = fmaxf(__uint_as_float(rr[0]), __uint_as_float(rr[1])); }
    constexpr float C2 = 1.4426950408889634f * SCALE;
    if (__builtin_expect(__all((pmax - m_reg) * SCALE <= THR), 1)) { mn = m_reg; alpha = 1.f; }
    else { mn = fmaxf(m_reg, pmax); alpha = __builtin_amdgcn_exp2f((m_reg - mn) * C2); m_reg = mn; }
    const float mnL = -mn * C2;
#pragma unroll
    for (int r = 0; r < 16; ++r) p0[r] = fmaf(p0[r], C2, mnL);
#pragma unroll
    for (int r = 0; r < 16; ++r) p1[r] = fmaf(p1[r], C2, mnL);
#pragma unroll
    for (int r = 0; r < 16; ++r) p0[r] = __builtin_amdgcn_exp2f(p0[r]);
}
__device__ __forceinline__ void finishSM(f32x16& p0, f32x16& p1, float alpha, float& l_reg, bf16x8& pa0, bf16x8& pa1, bf16x8& pa2, bf16x8& pa3) {
#pragma unroll
    for (int r = 0; r < 16; ++r) p1[r] = __builtin_amdgcn_exp2f(p1[r]);
    float ps = 0;
#pragma unroll
    for (int r = 0; r < 16; ++r) ps += p0[r];
#pragma unroll
    for (int r = 0; r < 16; ++r) ps += p1[r];
    { auto rr = __builtin_amdgcn_permlane32_swap(__float_as_uint(ps), __float_as_uint(ps), false, false); ps = __uint_as_float(rr[0]) + __uint_as_float(rr[1]); }
    l_reg = l_reg * alpha + ps;
#define PK4(P, B_, OUT) do { unsigned a0 = cvtpk(P[B_+0], P[B_+1]), a1 = cvtpk(P[B_+2], P[B_+3]);                          \
        unsigned b0 = cvtpk(P[B_+4], P[B_+5]), b1 = cvtpk(P[B_+6], P[B_+7]);                                             \
        auto r0 = __builtin_amdgcn_permlane32_swap(a0, b0, false, false); auto r1 = __builtin_amdgcn_permlane32_swap(a1, b1, false, false); \
        u32x4 w = {r0[0], r1[0], r0[1], r1[1]}; OUT = *reinterpret_cast<bf16x8*>(&w); } while (0)
    PK4(p0, 0, pa0); PK4(p0, 8, pa1); PK4(p1, 0, pa2); PK4(p1, 8, pa3);
#undef PK4
}
template <int KB>
__device__ __forceinline__ void qkt(f32x16& p0, f32x16& p1, const char* K_lds, int r32, int hi, const bf16x8* qr, const float* bt, float rowinit) {
    if (bt) { const f32x4* bp = (const f32x4*)(bt + 4 * hi);
#pragma unroll
        for (int g = 0; g < 4; ++g) { const f32x4 a = bp[2 * g], b = bp[2 * g + 8];
            p0[4 * g] = a[0]; p0[4 * g + 1] = a[1]; p0[4 * g + 2] = a[2]; p0[4 * g + 3] = a[3]; p1[4 * g] = b[0]; p1[4 * g + 1] = b[1]; p1[4 * g + 2] = b[2]; p1[4 * g + 3] = b[3]; } }
    else {
#pragma unroll
        for (int r = 0; r < 16; ++r) { p0[r] = rowinit; p1[r] = rowinit; } }
    const char* kb[4];
#pragma unroll
    for (int dd = 0; dd < 4; ++dd) kb[dd] = K_lds + KB * SHM_K + KSWZ(r32, (dd * 16 + hi * 8) * 2);
#pragma unroll
    for (int d0 = 0; d0 < 8; ++d0) { const char* a = kb[d0 & 3] + (d0 >> 2) * 128;
        bf16x8 b0 = *reinterpret_cast<const bf16x8*>(a);
        bf16x8 b1 = *reinterpret_cast<const bf16x8*>(a + 32 * 256);
        p0 = __builtin_amdgcn_mfma_f32_32x32x16_bf16(b0, qr[d0], p0, 0, 0, 0);
        p1 = __builtin_amdgcn_mfma_f32_32x32x16_bf16(b1, qr[d0], p1, 0, 0, 0); }
}
template <int VB>
__device__ __forceinline__ void pv_tile(f32x16* o, int vb0, bf16x8 pa0, bf16x8 pa1, bf16x8 pa2, bf16x8 pa3) {
#define TRRD(dst, off) asm volatile("ds_read_b64_tr_b16 %0, %1 offset:%2" : "=&v"(dst) : "v"(vb0), "i"(off) : "memory")
#define PV_D0(d0) do { s16x4 l0, l1, l2, l3, h0, h1, h2, h3; constexpr int b_ = VB * SHM_V + v_rd_off(d0, 0, 0); \
        TRRD(l0, b_); TRRD(h0, b_ + 2048); TRRD(l1, b_ + 4096); TRRD(h1, b_ + 6144); TRRD(l2, b_ + 8192); TRRD(h2, b_ + 10240); TRRD(l3, b_ + 12288); TRRD(h3, b_ + 14336); \
        asm volatile("s_waitcnt lgkmcnt(0)" ::: "memory"); SBAR();   \
        o[d0] = __builtin_amdgcn_mfma_f32_32x32x16_bf16(pa0, (bf16x8){l0[0], l0[1], l0[2], l0[3], h0[0], h0[1], h0[2], h0[3]}, o[d0], 0, 0, 0);   \
        o[d0] = __builtin_amdgcn_mfma_f32_32x32x16_bf16(pa1, (bf16x8){l1[0], l1[1], l1[2], l1[3], h1[0], h1[1], h1[2], h1[3]}, o[d0], 0, 0, 0);   \
        o[d0] = __builtin_amdgcn_mfma_f32_32x32x16_bf16(pa2, (bf16x8){l2[0], l2[1], l2[2], l2[3], h2[0], h2[1], h2[2], h2[3]}, o[d0], 0, 0, 0);   \
        o[d0] = __builtin_amdgcn_mfma_f32_32x32x16_bf16(pa3, (bf16x8){l3[0], l3[1], l3[2], l3[3], h3[0], h3[1], h3[2], h3[3]}, o[d0], 0, 0, 0); } while (0)
    PV_D0(0); PV_D0(1); PV_D0(2); PV_D0(3);
#undef PV_D0
#undef TRRD
}
struct BlockRef { int bh, qb; };
struct HeadCols { int qcol, kcol, vcol, type, ocol, opitch, ohstep; size_t obase_off; };
__device__ __forceinline__ HeadCols head_cols(int hidx) {
    HeadCols d;
    if (hidx < 12) { d.type = 0; d.qcol = C_QM + hidx * HD; d.kcol = C_KM + hidx * HD; d.vcol = C_VM + hidx * HD; d.obase_off = WS_MIX + (size_t)((hidx * HD) >> 6) * M * 64 * 2; d.opitch = 64; d.ohstep = M * 64; d.ocol = 0; }
    else if (hidx < 24) { const int h = hidx - 12; d.type = 1; d.qcol = C_QF + h * HD; d.kcol = C_KF + h * HD; d.vcol = C_VF + h * HD; d.obase_off = WS_MIX + (size_t)((1536 + h * HD) >> 6) * M * 64 * 2; d.opitch = 64; d.ohstep = M * 64; d.ocol = 0; }
    else { const int x = hidx - 24, h = x >> 2, mp = (x >> 1) & 1, e = x & 1; d.type = 2; d.qcol = C_QD + h * 256 + mp * HD; d.kcol = C_KD + h * 256 + mp * HD; d.vcol = C_VD + h * 256 + e * HD;
        d.obase_off = WS_DIFF + (size_t)mp * M * 1024 * 2; d.opitch = 1024; d.ohstep = 64; d.ocol = h * 256 + e * HD; }
    return d;
}
#define LAUNDER_S(x) asm volatile("" : "+s"(x))
__device__ __forceinline__ BlockRef q_item(int qx, int k) { const int kk = k / 10, ui = k - kk * 10, q4 = qx & 3; BlockRef r;
    const int hidx = ui < 3 ? 3 * q4 + ui : (ui < 6 ? 12 + 3 * q4 + (ui - 3) : 24 + 4 * q4 + (ui - 6));
    r.bh = (qx >> 2) * NATT + hidx; r.qb = 15 - kk; return r; }
struct Seam { bf16x8 qr[8]; bf16x8 st_v0, st_v1, st_k0, st_k1; };
#define ROW(p, k0, rr) ((p) + (size_t)((k0) + (rr)) * PITCH + sc)
#define VMW() asm volatile("s_waitcnt vmcnt(0)" ::: "memory")
#define VMWN(n) asm volatile("s_waitcnt vmcnt(%0)" :: "i"(n) : "memory")
#define SLOAD_H(Kp, Vp, k0) do { S.st_v0 = load8(ROW(Vp, k0, sr)); S.st_v1 = load8(ROW(Vp, k0, 32 + sr)); S.st_k0 = load8(ROW(Kp, k0, sr)); S.st_k1 = load8(ROW(Kp, k0, 32 + sr)); } while (0)
#define SWRITE_HK(bf) do { *(bf16x8*)(K_lds + (bf) * SHM_K + kws) = S.st_k0; *(bf16x8*)(K_lds + (bf) * SHM_K + kws + 32 * 256) = S.st_k1; } while (0)
#define SWRITE_HV(bf) do { *(bf16x8*)(V_lds + (bf) * SHM_V + vst0) = S.st_v0; *(bf16x8*)(V_lds + (bf) * SHM_V + vst1) = S.st_v1; } while (0)
#define SWRITE_H(bf) do { SWRITE_HV(bf); SWRITE_HK(bf); } while (0)
__device__ __forceinline__ void prime(BlockRef cur, unsigned char* wsb, char* lds, Seam& S, int tid) {
    const int wid = __builtin_amdgcn_readfirstlane(tid >> 6), lane = tid & 63, r32 = lane & 31, hi = lane >> 5;
    const int sr = tid >> 4, sc = (tid & 15) * 8, kws = KSWZ(sr, sc * 2); char* K_lds = lds + 2 * SHM_V;
    const int b = cur.bh / NATT; const HeadCols hc = head_cols(cur.bh - b * NATT);
    const bf16* PROJ = (const bf16*)(wsb + WS_PROJ); const size_t rowb = (size_t)b * SEQ;
    const bf16* Qp = PROJ + (rowb + (size_t)cur.qb * QB) * PITCH + hc.qcol; const bf16* Kp = PROJ + rowb * PITCH + hc.kcol; const bf16* Vp = PROJ + rowb * PITCH + hc.vcol;
#pragma unroll
    for (int d0 = 0; d0 < 8; ++d0) S.qr[d0] = load8(Qp + (size_t)(wid * QBLK + r32) * PITCH + d0 * 16 + hi * 8);
    SLOAD_H(Kp, Vp, cur.qb * QB + QB - KVBLK); VMW(); SWRITE_HK(0);
    __syncthreads();
}
__device__ __forceinline__ int block(BlockRef cur, unsigned* qctr, int qx, unsigned char* wsb, char* lds, Seam& S, int tid, float fox_thr) {
    const int wid = __builtin_amdgcn_readfirstlane(tid >> 6), lane = tid & 63, r32 = lane & 31, hi = lane >> 5;
    const int P0 = cur.qb * QB;
    const int NT = (P0 + QB) / KVBLK;
    int NS = NT;
    const int qlo = P0 + wid * QBLK, qm = qlo + r32 - 4 * hi;
    char* V_lds = lds; char* K_lds = lds + 2 * SHM_V;
    float* ws = (float*)(lds + OFF_WS) + wid * 64; float* li_l = ws, * al_l = ws + 32;
    float* blds = (float*)(lds + OFF_BIAS);
    float m_reg = -1e30f, l_reg = 0; f32x16 o[4] = {};
    const int sr = tid >> 4, sc = (tid & 15) * 8, vst0 = v_st(sr, sc), vst1 = v_st(32 + sr, sc), kws = KSWZ(sr, sc * 2);
    const int vb0 = (int)(uintptr_t)V_lds + v_rd_base(lane);
    const int cb = cur.bh / NATT, chx = cur.bh - cb * NATT; const HeadCols hc = head_cols(chx);
    const bf16* Kh = (const bf16*)(wsb + WS_PROJ) + (size_t)cb * SEQ * PITCH + hc.kcol; const bf16* Vh = (const bf16*)(wsb + WS_PROJ) + (size_t)cb * SEQ * PITCH + hc.vcol;
    const bool hb = hc.type == 1;
    unsigned nfetch = 0u; if (tid == 0) nfetch = __hip_atomic_fetch_add(qctr, 1u, __ATOMIC_RELAXED, __HIP_MEMORY_SCOPE_AGENT);
    unsigned selm = 0xffffffffu;
    int tid_h = tid; asm volatile("" : "+v"(tid_h)); const int lane_h = tid_h & 63;
    unsigned char* wsh = wsb; asm volatile("" : "+s"(wsh));
    if (hc.type == 0) {
        const int j = cur.qb; selm = 1u << j;
        if (j > 0) {
            const float* kp = (const float*)(wsh + WS_KPART) + (size_t)(cb * 12 + chx) * NBLK * KSUB * HD;
            for (int idx = tid_h; idx < j * HD; idx += NW * 64) { const int n = idx >> 7, d = idx & 127; const float* q_ = kp + (size_t)n * KSUB * HD + d; float a = 0.f;
#pragma unroll
                for (int sub = 0; sub < KSUB; ++sub) a += q_[sub * HD];
                blds[idx] = a * (1.0f / 256.0f); }
            __syncthreads();
            float b0 = -__builtin_inff(), b1 = b0, b2 = b0; int i0 = -1, i1 = -1, i2 = -1;
            for (int n = 0; n < j; ++n) { const float* km = blds + n * HD + 8 * (lane_h >> 5); float a = 0.f;
#pragma unroll
                for (int d0 = 0; d0 < 8; ++d0) { const f32x4 k0 = *(const f32x4*)(km + 16 * d0), k1 = *(const f32x4*)(km + 16 * d0 + 4); const bf16x8 qv = S.qr[d0];
                    a += bf2f((bf16)qv[0]) * k0[0] + bf2f((bf16)qv[1]) * k0[1] + bf2f((bf16)qv[2]) * k0[2] + bf2f((bf16)qv[3]) * k0[3] + bf2f((bf16)qv[4]) * k1[0] + bf2f((bf16)qv[5]) * k1[1] + bf2f((bf16)qv[6]) * k1[2] + bf2f((bf16)qv[7]) * k1[3]; }
                { auto rr = __builtin_amdgcn_permlane32_swap(__float_as_uint(a), __float_as_uint(a), false, false); a = __uint_as_float(rr[0]) + __uint_as_float(rr[1]); }
                if (a > b0) { b2 = b1; i2 = i1; b1 = b0; i1 = i0; b0 = a; i0 = n; } else if (a > b1) { b2 = b1; i2 = i1; b1 = a; i1 = n; } else if (a > b2) { b2 = a; i2 = n; } }
            if (i0 >= 0) selm |= 1u << i0; if (i1 >= 0) selm |= 1u << i1; if (i2 >= 0) selm |= 1u << i2;
        }
    }
    if (hb) { const float* lf = (const float*)(wsh + WS_LOGF) + (size_t)(cb * 12 + (chx - 12)) * SEQ; const int nk = P0 + QB;
        float v[8]; float tot = 0.f; const bool act = tid_h * 8 < nk;
        if (act) { const f32x4 a = *(const f32x4*)(lf + 8 * tid_h), b = *(const f32x4*)(lf + 8 * tid_h + 4);
            v[0] = a[0]; v[1] = v[0] + a[1]; v[2] = v[1] + a[2]; v[3] = v[2] + a[3]; v[4] = v[3] + b[0]; v[5] = v[4] + b[1]; v[6] = v[5] + b[2]; v[7] = v[6] + b[3]; tot = v[7]; }
        else {
#pragma unroll
            for (int i = 0; i < 8; ++i) v[i] = 0.f; }
        float inc = tot;
#pragma unroll
        for (int o_ = 1; o_ < 64; o_ <<= 1) { const float t_ = __int_as_float(__builtin_amdgcn_ds_bpermute((lane_h >= o_ ? lane_h - o_ : lane_h) << 2, __float_as_int(inc))); if (lane_h >= o_) inc += t_; }
        float* wt = (float*)(lds + OFF_WT);
        if (lane_h == 63) wt[wid] = inc;
        __syncthreads();
        float off = inc - tot;
        for (int w_ = 0; w_ < wid; ++w_) off += wt[w_];
        if (act) { f32x4 a, b; a[0] = (off + v[0]) * -11.313708498984761f; a[1] = (off + v[1]) * -11.313708498984761f; a[2] = (off + v[2]) * -11.313708498984761f; a[3] = (off + v[3]) * -11.313708498984761f;
            b[0] = (off + v[4]) * -11.313708498984761f; b[1] = (off + v[5]) * -11.313708498984761f; b[2] = (off + v[6]) * -11.313708498984761f; b[3] = (off + v[7]) * -11.313708498984761f;
            *(f32x4*)(blds + 8 * tid_h) = a; *(f32x4*)(blds + 8 * tid_h + 4) = b; }
        __syncthreads();
        if (wid == 0) { const float thr = fox_thr;
            const int ti = NT - 1 - lane_h; bool dead = false;
            if (lane_h >= 4 && ti >= 0) dead = (blds[P0] - blds[64 * ti + 63]) > thr;
            const unsigned long long bm = __ballot(dead);
            int ns = NT; if (bm != 0ull) { ns = __builtin_ctzll(bm); ns = (ns + 1) & ~1; if (ns > NT) ns = NT; }
            if (lane_h == 0) *(volatile int*)(lds + OFF_WT + 32) = ns; }
        __syncthreads();
        NS = __builtin_amdgcn_readfirstlane(*(volatile int*)(lds + OFF_WT + 32)); }
#define RESC(a) do { if (__any((a) < 1.f)) { if (hi == 0) al_l[r32] = (a); asm volatile("s_waitcnt lgkmcnt(0)" ::: "memory");              \
                     for (int d_ = 0; d_ < 4; ++d_) for (int r = 0; r < 16; ++r) o[d_][r] *= al_l[crow(r, hi)]; } } while (0)
#define KBASE(i) ((NT - 1 - (i)) * KVBLK)
#define BT(i) (hb ? blds + KBASE(i) : (const float*)nullptr)
#define RI(i) ((((selm >> ((NT - 1 - (i)) >> 2)) & 1u) != 0u) ? 0.f : -__builtin_inff())
#define MASKT(P0_, P1_, t) do { const int kb_ = KBASE(t); if (kb_ + KVBLK - 1 > qlo) mask_tile(P0_, P1_, qm - kb_); } while (0)
#define SEAM_K0() do { VMWN(8); SWRITE_HK(0); SBAR(); } while (0)
    f32x16 pA0, pA1, pB0, pB1; float mnA, mnB, alA, alB; bf16x8 pa0, pa1, pa2, pa3;
    SWRITE_HV(0); SBAR();
    SLOAD_H(Kh, Vh, KBASE(1));
    SBAR(); qkt<0>(pA0, pA1, K_lds, r32, hi, S.qr, BT(0), RI(0));
    MASKT(pA0, pA1, 0); partialSM(pA0, pA1, m_reg, mnA, alA);
    VMW(); SWRITE_H(1);
    if (tid == 0) *(volatile unsigned*)(lds + OFF_NXT) = nfetch;
    __syncthreads();
    const int nk = __builtin_amdgcn_readfirstlane((int)*(volatile unsigned*)(lds + OFF_NXT));
#define HALF_STEP(PX0, PX1, mnX, alX, PY0, PY1, alY, t, KB, VB, SB) do {                                                      \
        SBAR(); qkt<KB>(PX0, PX1, K_lds, r32, hi, S.qr, BT(t), RI(t));                                                        \
        finishSM(PY0, PY1, alY, l_reg, pa0, pa1, pa2, pa3); SBAR();                                                           \
        if ((t) + 1 < NS) { SLOAD_H(Kh, Vh, KBASE((t) + 1)); SBAR(); }                                                        \
        pv_tile<VB>(o, vb0, pa0, pa1, pa2, pa3); MASKT(PX0, PX1, (t)); partialSM(PX0, PX1, m_reg, mnX, alX);                  \
        __syncthreads();                                                                                                      \
        if ((t) + 1 < NS) { VMW(); SWRITE_H(SB); }                                                                            \
        RESC(alX); __syncthreads(); } while (0)
    for (int t = 1; t + 1 < NS; t += 2) {
        HALF_STEP(pB0, pB1, mnB, alB, pA0, pA1, alA, t, 1, 0, 0);
        HALF_STEP(pA0, pA1, mnA, alA, pB0, pB1, alB, t + 1, 0, 1, 1);
    }
    SBAR(); qkt<1>(pB0, pB1, K_lds, r32, hi, S.qr, BT(NS - 1), RI(NS - 1)); SBAR();
    { const BlockRef nxt = (nk < QITEMS) ? q_item(qx, nk) : cur; int nbh = nxt.bh, nqb = nxt.qb; LAUNDER_S(nbh); LAUNDER_S(nqb);
      const int nb = nbh / NATT; const HeadCols nh = head_cols(nbh - nb * NATT); const bf16* PROJ = (const bf16*)(wsb + WS_PROJ); const size_t rowb = (size_t)nb * SEQ;
      const bf16* nK = PROJ + rowb * PITCH + nh.kcol; const bf16* nV = PROJ + rowb * PITCH + nh.vcol; const bf16* nQ = PROJ + (rowb + (size_t)nqb * QB) * PITCH + nh.qcol;
      SLOAD_H(nK, nV, nqb * QB + QB - KVBLK); SBAR();
#pragma unroll
      for (int d0 = 0; d0 < 8; ++d0) S.qr[d0] = load8(nQ + (size_t)(wid * QBLK + r32) * PITCH + d0 * 16 + hi * 8); }
    SBAR();
    finishSM(pA0, pA1, alA, l_reg, pa0, pa1, pa2, pa3); SBAR();
    pv_tile<0>(o, vb0, pa0, pa1, pa2, pa3);
    MASKT(pB0, pB1, NS - 1); partialSM(pB0, pB1, m_reg, mnB, alB); __syncthreads(); RESC(alB);
    finishSM(pB0, pB1, alB, l_reg, pa0, pa1, pa2, pa3); SBAR(); pv_tile<1>(o, vb0, pa0, pa1, pa2, pa3);
    SBAR(); SEAM_K0();
    if (hi == 0) li_l[r32] = l_reg; asm volatile("s_waitcnt lgkmcnt(0)" ::: "memory");
    float rli[16];
#pragma unroll
    for (int r = 0; r < 16; ++r) rli[r] = __builtin_amdgcn_rcpf(li_l[crow(r, hi)]);
    { int obh = cur.bh, oqb = cur.qb; LAUNDER_S(obh); LAUNDER_S(oqb);
      const int ob = obh / NATT; const HeadCols oh = head_cols(obh - ob * NATT); const int opitch = oh.opitch, ohstep = oh.ohstep;
      bf16* Ow = (bf16*)(wsb + oh.obase_off) + ((size_t)ob * SEQ + (size_t)oqb * QB + wid * QBLK) * opitch + oh.ocol;
      int hi_e = hi; asm volatile("" : "+v"(hi_e));
      bf16* Ol = Ow + (size_t)(4 * hi_e) * opitch + r32;
#pragma unroll
      for (int r = 0; r < 16; ++r) { const int orow = (r & 3) + 8 * (r >> 2);
#pragma unroll
        for (int d0 = 0; d0 < 4; ++d0) { const float v = o[d0][r] * rli[r]; const float vn = __int_as_float(__builtin_amdgcn_mov_dpp(__float_as_int(v), 0xB1, 0xf, 0xf, true));
            if ((r32 & 1) == 0) *(unsigned*)(Ol + (size_t)orow * opitch + (size_t)(d0 >> 1) * ohstep + (d0 & 1) * 32) = cvtpk(v, vn); } } }
    __syncthreads();
    return nk;
#undef RESC
#undef KBASE
#undef BT
#undef RI
#undef MASKT
#undef SEAM_K0
#undef HALF_STEP
}
#undef ROW
#undef VMW
#undef VMWN
#undef SLOAD_H
#undef SWRITE_HK
#undef SWRITE_HV
#undef SWRITE_H
#undef KSWZ
#undef SBAR
}

struct Args { const float* in[20]; float* out; unsigned char* ws; int ph_lo, ph_hi; };
typedef const __attribute__((address_space(4))) Args* KArgs;
__device__ __forceinline__ KArgs kargs() { KArgs k = (KArgs)__builtin_amdgcn_kernarg_segment_ptr(); asm volatile("" : "+s"(k)); return k; }

__device__ __forceinline__ void p0_prologue(unsigned char* ws, LAS unsigned char* lds, int vcu, int NGW, int wave0, int lsel, int part) {
    FRESH_IDS(vcu);
    KArgs ka = kargs(); const float* in2 = ka->in[2]; const float* in15 = ka->in[15]; const float* in17 = ka->in[17]; const float* in18 = ka->in[18]; const float* in19 = ka->in[19]; const float* gA = ka->in[1]; const float* gF = ka->in[16];
    { constexpr int T_IN = (DM / 64) * (PW / 256), T_OUT = (DM / 64) * (DM / 256), T_G = (DM / 64) * (FF / 256), T_D = (FF / 64) * (DM / 256), T_LAYER = T_IN + T_OUT + 2 * T_G + T_D;
      const int G_ = NGW / NWAVES;
      LAS unsigned char* img = lds + RING_OFF;
      f32x4 ld[8];
      const float* W = nullptr; int sstride = 0, scol = 0, k0 = 0, K_ = 0, n0d = 0, mode = 0, nrows = 0; bf16* WT = nullptr; const float* gk = nullptr;
#define P0_DECODE(tl_) do { const int l_ = (tl_) / T_LAYER; int r_ = (tl_) - l_ * T_LAYER; gk = nullptr; mode = 0; \
        if (r_ < T_IN) { const int nb_ = PW / 256, kb_ = r_ / nb_, n0_ = (r_ - kb_ * nb_) * 256; W = in2 + (size_t)l_ * DM * INW; sstride = INW; scol = n0_ + (n0_ >= C_QD ? 12 : 0); k0 = 64 * kb_; WT = (bf16*)(ws + WS_WIN) + (size_t)l_ * PW * DM; K_ = DM; n0d = n0_; nrows = PW; gk = gA + l_ * DM; } \
        else if ((r_ -= T_IN) < T_OUT) { const int nb_ = DM / 256, kb_ = r_ / nb_, n0_ = (r_ - kb_ * nb_) * 256; W = in15 + (size_t)l_ * DM * DM; sstride = DM; scol = n0_; k0 = 64 * kb_; WT = (bf16*)(ws + WS_WOUT) + (size_t)l_ * DM * DM; K_ = DM; n0d = n0_; nrows = DM; } \
        else if ((r_ -= T_OUT) < 2 * T_G) { const int wh_ = r_ >= T_G; if (wh_) r_ -= T_G; const int nb_ = FF / 256, kb_ = r_ / nb_, n0_ = (r_ - kb_ * nb_) * 256; W = (wh_ ? in18 : in17) + (size_t)l_ * DM * FF; sstride = FF; scol = n0_; k0 = 64 * kb_; \
            WT = (bf16*)(ws + WS_WGU) + (size_t)l_ * NGU * DM; K_ = DM; n0d = n0_; nrows = NGU; gk = gF + l_ * DM; mode = 1 + wh_; } \
        else { r_ -= 2 * T_G; const int nb_ = DM / 256, kb_ = r_ / nb_, n0_ = (r_ - kb_ * nb_) * 256; W = in19 + (size_t)l_ * FF * DM; sstride = DM; scol = n0_; k0 = 64 * kb_; WT = (bf16*)(ws + WS_WD) + (size_t)l_ * DM * FF; K_ = FF; n0d = n0_; nrows = DM; } } while (0)
#define P0_LOADS() do { const float* wp_ = W + (size_t)(k0 + 8 * wave) * sstride + scol + 4 * lane; \
        _Pragma("unroll") for (int i_ = 0; i_ < 8; ++i_) ld[i_] = __builtin_nontemporal_load((const f32x4*)(wp_ + (size_t)i_ * sstride)); } while (0)
      const int p_lo = part == 0 ? 0 : (part == 1 ? T_IN : (part == 2 ? T_IN + T_OUT : T_IN + T_OUT + 2 * T_G)), p_hi = part == 0 ? T_IN : (part == 1 ? T_IN + T_OUT : (part == 2 ? T_IN + T_OUT + 2 * T_G : T_LAYER));
      unsigned* cq = (unsigned*)(ws + WS_CTL) + CW_CONV + (lsel * 8 + part) * 64; LAS unsigned* cw = (LAS unsigned*)(lds + RING_OFF + 65536);
      const int tbase = lsel * T_LAYER + p_lo, ntile = p_hi - p_lo;
      if (tid == 0) { const unsigned a0 = __hip_atomic_fetch_add(cq, 2u, __ATOMIC_RELAXED, __HIP_MEMORY_SCOPE_AGENT); cw[0] = a0; }
      __syncthreads();
      int ta = (int)cw[0], tb = ta + 1;
      __syncthreads();
      if (ta < ntile) { P0_DECODE(tbase + ta); P0_LOADS(); }
      while (ta < ntile) {
        unsigned fc = 0u; if (tid == 0) fc = __hip_atomic_fetch_add(cq, 1u, __ATOMIC_RELAXED, __HIP_MEMORY_SCOPE_AGENT);
#pragma unroll
        for (int i_ = 0; i_ < 8; ++i_) *(LAS f32x4*)(img + (8 * wave + i_) * 1024 + ((lane ^ wave) << 4)) = ld[i_];
        bf16* WTc = WT; const int k0c = k0, n0c = n0d, modec = mode, nrc = nrows; const float* gkc = gk; (void)K_;
        __syncthreads();
        if (tb < ntile) { P0_DECODE(tbase + tb); P0_LOADS(); }
        { const int c = tid & 7; f32x4 ga = {1.f, 1.f, 1.f, 1.f}, gb = {1.f, 1.f, 1.f, 1.f};
          if (gkc) { ga = *(const f32x4*)(gkc + k0c + 8 * c); gb = *(const f32x4*)(gkc + k0c + 8 * c + 4); }
#pragma unroll
          for (int j_ = 0; j_ < 4; ++j_) { const int n = (tid >> 3) + 64 * j_;
            const LAS unsigned char* sp = img + (8 * c) * 1024 + ((((n >> 2) ^ c) & 63) << 4) + ((n & 3) << 2);
            float v[8];
#pragma unroll
            for (int i_ = 0; i_ < 8; ++i_) v[i_] = *(const LAS float*)(sp + i_ * 1024);
            v4u o; o.x = pk2(v[0] * ga.x, v[1] * ga.y); o.y = pk2(v[2] * ga.z, v[3] * ga.w); o.z = pk2(v[4] * gb.x, v[5] * gb.y); o.w = pk2(v[6] * gb.z, v[7] * gb.w);
            const int na = n0c + n; const int drow = (modec == 0) ? na : ((na >> 7) * 256 + (modec - 1) * 128 + (na & 127));
            bf16* dp = WTc + ((size_t)(k0c >> 6) * nrc + drow) * 64 + 8 * c;
            *(GAS v4u*)dp = o; } }
        if (tid == 0) cw[0] = fc;
        __syncthreads();
        ta = tb; tb = (int)cw[0];
      }
      __syncthreads();
#undef P0_DECODE
#undef P0_LOADS
    }
    if (lsel != 0 || part != 0) return;
    const int gt = gw * 64 + lane, NGT = NGW * 64;
    for (int i = gt; i < DEPTH * 16 * DM; i += NGT) { const int l = i / (16 * DM), c = (i / DM) & 15, k = i % DM;
        ((bf16*)(ws + WS_WF))[i] = (c < 12) ? (bf16)f2bf(in2[((size_t)l * DM + k) * INW + 9216 + c] * gA[l * DM + k]) : (bf16)0; }
    { const float* x = ka->in[0]; float* ssq0 = (float*)(ws + WS_CTL) + CW_SSQ;
      for (int m = gw; m < M; m += NGW) { const GAS f32x4* xr = (const GAS f32x4*)(x + (size_t)m * DM) + lane; bf16* xa = (bf16*)(ws + WS_XN); float sq = 0.f;
#pragma unroll
        for (int j = 0; j < 16; ++j) { const f32x4 v = xr[64 * j]; sq += (v.x * v.x + v.y * v.y) + (v.z * v.z + v.w * v.w); v2u o; o.x = pk2(v.x, v.y); o.y = pk2(v.z, v.w); const int col = 4 * lane + 256 * j; *(GAS v2u*)(xa + ((size_t)(col >> 6) * M + m) * 64 + (col & 63)) = o; }
        sq = wave_sum(sq, lane); if (lane == 0) ssq0[m] = 1.0f / sqrtf(sq * (1.0f / DM) + NORM_EPS); } }
    for (int i = gt; i < SEQ * 64; i += NGT) { const int pos = i >> 6, fi = i & 63;
        const float invf = 1.0f / powf(10000.0f, (float)fi * (1.0f / 64.0f)); const float ang = (float)pos * invf;
        const double rev = (double)ang * 0.15915494309189533576888; const float fr = (float)(rev - rint(rev));
        ((f32x2*)(ws + WS_ROPE))[i] = (f32x2){__builtin_amdgcn_cosf(fr), __builtin_amdgcn_sinf(fr)}; }
}

constexpr int T3B_TILES = M / 16;
#define DPPF(v, ctrl) __int_as_float(__builtin_amdgcn_mov_dpp(__float_as_int(v), (ctrl), 0xf, 0xf, true))
__device__ __forceinline__ void t3_phase(unsigned char* ws, LAS unsigned char* lds, int l, int vcu, int G, int wave0) {
    FRESH_IDS(vcu);
    KArgs ka = kargs();
    { LAS f32x4* red = (LAS f32x4*)(lds + RING_OFF);
      const int tsel = wave >> 2, kq = wave & 3;
      for (int tb0 = vcu * 2; tb0 < T3B_TILES; tb0 += 2 * G) {
        const int t = tb0 + tsel;
        const bf16* A = (const bf16*)(ws + WS_XN) + ((size_t)(kq * 16) * M + (16 * t + (lane & 15))) * 64 + 8 * (lane >> 4);
        const bf16* B = (const bf16*)(ws + WS_WF) + (size_t)l * 16 * DM + (size_t)(lane & 15) * DM + kq * 1024 + 8 * (lane >> 4);
        f32x4 acc = {0.f, 0.f, 0.f, 0.f};
#pragma unroll 16
        for (int i = 0; i < 32; ++i) { const bf16x8 a = *(const bf16x8*)(A + (size_t)(i >> 1) * M * 64 + 32 * (i & 1)), b = *(const bf16x8*)(B + 32 * i); acc = __builtin_amdgcn_mfma_f32_16x16x32_bf16(a, b, acc, 0, 0, 0); }
        red[(tsel * 4 + kq) * 64 + lane] = acc;
        __syncthreads();
        if (kq == 0) {
            const f32x4 s4 = (red[(tsel * 4 + 0) * 64 + lane] + red[(tsel * 4 + 1) * 64 + lane]) + (red[(tsel * 4 + 2) * 64 + lane] + red[(tsel * 4 + 3) * 64 + lane]);
            const int c = lane & 15;
            if (c < 12) { const float fb = ka->in[7][l * 12 + c]; const float* ssq = (const float*)(ws + WS_CTL) + CW_SSQ + 2 * l * M;
                const int row0 = 16 * t + 4 * (lane >> 4), b = row0 / SEQ, s0 = row0 & (SEQ - 1); f32x4 ls;
#pragma unroll
                for (int r = 0; r < 4; ++r) { const float z = s4[r] * pg8::rs_of(ssq, row0 + r, 1.0f / DM, NORM_EPS) + fb; ls[r] = fminf(z, 0.f) - log1pf(expf(-fabsf(z))); }
                *(f32x4*)((float*)(ws + WS_LOGF) + (size_t)(b * 12 + c) * SEQ + s0) = ls; } }
        __syncthreads();
      } }
    bf16* PROJ = (bf16*)(ws + WS_PROJ);
    const int g = gw & 15; constexpr int NCH = M / T3A_ROWS;
    int col0; const float* gsel; bool rot, km = false;
    if (g < 3) { col0 = C_QM + 512 * g; gsel = ka->in[3]; rot = true; }
    else if (g < 6) { col0 = C_KM + 512 * (g - 3); gsel = ka->in[4]; rot = true; km = true; }
    else if (g < 9) { col0 = C_QF + 512 * (g - 6); gsel = ka->in[5]; rot = false; }
    else if (g < 12) { col0 = C_KF + 512 * (g - 9); gsel = ka->in[6]; rot = false; }
    else if (g < 14) { col0 = C_QD + 512 * (g - 12); gsel = ka->in[8]; rot = true; }
    else { col0 = C_KD + 512 * (g - 14); gsel = ka->in[9]; rot = true; }
    const int hv = lane >> 4, c8 = (lane & 15) * 8, cstep = (G * NWAVES) >> 4;
    float gn[8], dc[8], dsn[8];
    { const float* gp = gsel + l * HD + c8;
#pragma unroll
      for (int e = 0; e < 8; ++e) gn[e] = gp[e];
      const GAS f32x4* r1 = (const GAS f32x4*)((const float*)(ws + WS_ROPE) + ((size_t)1 * 64 + (c8 & 63)) * 2);
#pragma unroll
      for (int q = 0; q < 4; ++q) { const f32x4 b = r1[q]; dc[2 * q] = b.x; dsn[2 * q] = b.y; dc[2 * q + 1] = b.z; dsn[2 * q + 1] = b.w; } }
    const bool up = (lane & 8) != 0;
    const unsigned voff = (unsigned)(col0 + hv * 128 + c8) * 2u;
    for (int chunk = gw >> 4; chunk < NCH; chunk += cstep) {
        v4u w[T3A_ROWS]; float cs[8], sn[8];
        { const int row0_ = chunk * T3A_ROWS; GAS char* ub_ = (GAS char*)PROJ + (size_t)row0_ * PW * 2;
#pragma unroll
          for (int rr = 0; rr < T3A_ROWS; ++rr) w[rr] = *(GAS v4u*)(ub_ + (size_t)rr * PW * 2 + voff);
          const GAS f32x4* rp_ = (const GAS f32x4*)((const float*)(ws + WS_ROPE) + ((size_t)(row0_ & (SEQ - 1)) * 64 + (c8 & 63)) * 2);
#pragma unroll
          for (int q = 0; q < 4; ++q) { const f32x4 a = rp_[q]; cs[2 * q] = a.x; sn[2 * q] = a.y; cs[2 * q + 1] = a.z; sn[2 * q + 1] = a.w; } }
        const int row0 = chunk * T3A_ROWS, pos0 = row0 & (SEQ - 1);
        GAS char* ub0 = (GAS char*)PROJ + (size_t)row0 * PW * 2;
        float ks[8];
#pragma unroll
        for (int e = 0; e < 8; ++e) ks[e] = 0.f;
#pragma unroll
        for (int rr = 0; rr < T3A_ROWS; ++rr) {
            float y[8];
            y[0] = bflo(w[rr].x); y[1] = bfhi(w[rr].x); y[2] = bflo(w[rr].y); y[3] = bfhi(w[rr].y); y[4] = bflo(w[rr].z); y[5] = bfhi(w[rr].z); y[6] = bflo(w[rr].w); y[7] = bfhi(w[rr].w);
            float ss = 0.f;
#pragma unroll
            for (int e = 0; e < 8; ++e) ss += y[e] * y[e];
            ss += DPPF(ss, 0xB1); ss += DPPF(ss, 0x4E); ss += DPPF(ss, 0x141); ss += DPPF(ss, 0x140);
            const float sc = 1.0f / sqrtf(ss * (1.0f / HD) + NORM_EPS);
#pragma unroll
            for (int e = 0; e < 8; ++e) y[e] = y[e] * sc * gn[e];
            if (rot) {
#pragma unroll
                for (int e = 0; e < 8; ++e) { const float o = DPPF(y[e], 0x128);
                    y[e] = up ? (y[e] * cs[e] + o * sn[e]) : (y[e] * cs[e] - o * sn[e]);
                    const float cn = cs[e] * dc[e] - sn[e] * dsn[e]; sn[e] = sn[e] * dc[e] + cs[e] * dsn[e]; cs[e] = cn; }
            }
            v4u o; o.x = pk2(y[0], y[1]); o.y = pk2(y[2], y[3]); o.z = pk2(y[4], y[5]); o.w = pk2(y[6], y[7]);
            *(GAS v4u*)(ub0 + (size_t)rr * PW * 2 + voff) = o;
            if (km) {
#pragma unroll
                for (int e = 0; e < 8; ++e) ks[e] += y[e];
            }
        }
        if (km) {
            const int b = row0 / SEQ, blk = pos0 >> 8, sub = (pos0 & 255) / T3A_ROWS, h = 4 * (g - 3) + hv;
            float* kp = (float*)(ws + WS_KPART) + ((((size_t)(b * 12 + h) * NBLK + blk) * KSUB + sub) * HD) + c8;
            *(f32x4*)kp = (f32x4){ks[0], ks[1], ks[2], ks[3]}; *(f32x4*)(kp + 4) = (f32x4){ks[4], ks[5], ks[6], ks[7]};
        }
    }
}
__device__ __forceinline__ void attn_phase(unsigned char* ws, char* lds, int vcu, int G, int wave0, int layer) {
    const int tid = fresh_tid(wave0);
    int qx = (vcu * 8) / G; if (qx > 7) qx = 7;
    unsigned* qctr = (unsigned*)(ws + WS_CTL) + CW_ATTQ + (layer * 8 + qx) * 64;
    if (tid == 0) *(volatile unsigned*)(lds + att::OFF_NXT) = __hip_atomic_fetch_add(qctr, 1u, __ATOMIC_RELAXED, __HIP_MEMORY_SCOPE_AGENT);
    __syncthreads();
    int k = __builtin_amdgcn_readfirstlane((int)*(volatile unsigned*)(lds + att::OFF_NXT));
    __syncthreads();
    if (k >= att::QITEMS) return;
    float fox_thr;
    { const float* gq = kargs()->in[5] + layer * HD; const float* gk_ = kargs()->in[6] + layer * HD; const int lane = tid & 63;
      float mq = fmaxf(fabsf(gq[lane]), fabsf(gq[lane + 64])), mk = fmaxf(fabsf(gk_[lane]), fabsf(gk_[lane + 64]));
      mq = wave_max(mq, lane); mk = wave_max(mk, lane);
      fox_thr = __int_as_float(__builtin_amdgcn_readfirstlane(__float_as_int(106.0f * 11.313708498984761f + 2.0f * (128.0f * 1.02f) * mq * mk))); }
    att::Seam S;
    att::prime(att::q_item(qx, k), ws, lds, S, tid);
    for (;;) {
        const int nk = att::block(att::q_item(qx, k), qctr, qx, ws, lds, S, tid, fox_thr);
        if (nk >= att::QITEMS) break;
        k = nk;
    }
}
__device__ __forceinline__ void t5_phase(unsigned char* ws, int l, int vcu, int NGW, int wave0) {
    FRESH_IDS(vcu);
    KArgs ka = kargs(); const float* q1 = ka->in[10]; const float* k1 = ka->in[11]; const float* q2 = ka->in[12]; const float* k2 = ka->in[13];
    float s1 = q1[l * HD + lane] * k1[l * HD + lane] + q1[l * HD + 64 + lane] * k1[l * HD + 64 + lane];
    float s2 = q2[l * HD + lane] * k2[l * HD + lane] + q2[l * HD + 64 + lane] * k2[l * HD + 64 + lane];
    const float lam_init = 0.8f - 0.6f * expf(-0.3f * (float)l);
    const float lam = expf(wave_sum(s1, lane)) - expf(wave_sum(s2, lane)) + lam_init;
    const f32x4 gn = *(const f32x4*)(ka->in[14] + l * 256 + 4 * lane);
    const bf16* D0 = (const bf16*)(ws + WS_DIFF); const bf16* D1 = D0 + (size_t)M * 1024; bf16* MIX = (bf16*)(ws + WS_MIX);
    for (int it0 = gw * 4; it0 < M * NH_D; it0 += NGW * 4) {
        v2u a[4], b[4];
#pragma unroll
        for (int u = 0; u < 4; ++u) { const int it = it0 + u, row = it >> 2, h = it & 3;
            a[u] = *(const v2u*)(D0 + (size_t)row * 1024 + h * 256 + 4 * lane); b[u] = *(const v2u*)(D1 + (size_t)row * 1024 + h * 256 + 4 * lane); }
#pragma unroll
        for (int u = 0; u < 4; ++u) { const int it = it0 + u, row = it >> 2, h = it & 3;
            const float v0 = bflo(a[u].x) - lam * bflo(b[u].x), v1 = bfhi(a[u].x) - lam * bfhi(b[u].x), v2 = bflo(a[u].y) - lam * bflo(b[u].y), v3 = bfhi(a[u].y) - lam * bfhi(b[u].y);
            const float ss = wave_sum((v0 * v0 + v1 * v1) + (v2 * v2 + v3 * v3), lane);
            const float sc = (1.0f / sqrtf(ss * (1.0f / 256.0f) + NORM_EPS)) * (1.0f - lam_init);
            v2u o; o.x = pk2(v0 * sc * gn.x, v1 * sc * gn.y); o.y = pk2(v2 * sc * gn.z, v3 * sc * gn.w);
            const int col = 3072 + h * 256 + 4 * lane; *(v2u*)(MIX + ((size_t)(col >> 6) * M + row) * 64 + (col & 63)) = o; }
    }
}

__global__ void __launch_bounds__(NWAVES * 64, 2) mk_fwd(Args args_unused) {
    extern __shared__ __attribute__((aligned(16))) unsigned char lds_raw[];
    LAS unsigned char* lds = (LAS unsigned char*)lds_raw;
    volatile LAS unsigned* MISC = (volatile LAS unsigned*)(lds + MISC_OFF);
    const int wave0 = __builtin_amdgcn_readfirstlane((int)threadIdx.x >> 6);
    const int tid = fresh_tid(wave0);
    const int G = gridDim.x; const int bx = blockIdx.x; const int vcu = (G % 8 == 0) ? (bx % 8) * (G / 8) + bx / 8 : bx;
    const int NGW = G * NWAVES;
    for (int u = tid; u < (LDS_BYTES - LDSCTL_OFF) / 4; u += NWAVES * 64) ((LAS unsigned*)(lds + LDSCTL_OFF))[u] = 0u;
    __syncthreads();
    XcdBarrier bar; { unsigned char* ws0 = kargs()->ws; bar.bar = (unsigned*)(ws0 + WS_CTL) + CW_BAR; bar.x = 0; bar.st = nullptr;
        if (MK_N_LAUNCHES == 1) bar = xcd_barrier_post((unsigned*)(ws0 + WS_CTL) + CW_BAR, MISC + 8); }
#define GRID_BAR() do { if (MK_N_LAUNCHES == 1) xcd_barrier(bar); } while (0)
    const int lo = kargs()->ph_lo, hi = kargs()->ph_hi;
#define IN(k) (lo <= (k) && (k) < hi)
    unsigned long long tpA = 0ull, tpD = 0ull;
#define TP_BEGIN(k) do { if (MK_TIME_PHASE >= 0 && (k) == MK_TIME_PHASE) tpA = __builtin_amdgcn_s_memrealtime(); } while (0)
#define TP_END(k) do { if (MK_TIME_PHASE >= 0 && (k) == MK_TIME_PHASE) tpD = __builtin_amdgcn_s_memrealtime() - tpA; } while (0)
#define BOTH(k) (IN(k) && IN((k) + 1))
    if (IN(0)) { TP_BEGIN(0); for (int rep = 0; rep < REPS(100); ++rep) p0_prologue(kargs()->ws, lds, vcu, NGW, wave0, 0, 0); if (BOTH(0)) GRID_BAR(); TP_END(0); }
    for (int l = 0; l < DEPTH; ++l) {
        const int pb = 2 + 8 * l;
        if (l > 0 && IN(pb - 1)) { TP_BEGIN(pb - 1); p0_prologue(kargs()->ws, lds, vcu, NGW, wave0, l, 0); if (BOTH(pb - 1)) GRID_BAR(); TP_END(pb - 1); }
        if (IN(pb + 0)) { TP_BEGIN(pb + 0); unsigned char* ws = kargs()->ws;
            pg8::Gemm g{(const bf16*)(ws + WS_XN), (const bf16*)(ws + WS_WIN) + (size_t)l * PW * DM, M, PW, DM}; pg8::StaticOrder S; S.init(M, PW, G, bx);
            pg8::EpiStoreBf16 E{(bf16*)(ws + WS_PROJ), PW, (const float*)(ws + WS_CTL) + CW_SSQ + 2 * l * M, 1.0f / DM, NORM_EPS};
            for (int rep = 0; rep < REPS(0); ++rep) pg8::gemm_phase<pg8::EpiStoreBf16, pg8::StaticOrder, true, true, true>(lds + RING_OFF, g, S, E, fresh_tid(wave0));
            if (BOTH(pb + 0)) GRID_BAR(); TP_END(pb + 0); }
        if (IN(pb + 1)) { TP_BEGIN(pb + 1); t3_phase(kargs()->ws, lds, l, vcu, G, wave0); p0_prologue(kargs()->ws, lds, vcu, NGW, wave0, l, 1);     if (BOTH(pb + 1)) GRID_BAR(); TP_END(pb + 1); }
        if (IN(pb + 2)) { TP_BEGIN(pb + 2);
            attn_phase(kargs()->ws, (char*)lds_raw + RING_OFF, vcu, G, wave0, l);
            if (BOTH(pb + 2)) GRID_BAR(); TP_END(pb + 2); }
        if (IN(pb + 3)) { TP_BEGIN(pb + 3); for (int rep = 0; rep < REPS(4); ++rep) t5_phase(kargs()->ws, l, vcu, NGW, wave0); if (BOTH(pb + 3)) GRID_BAR(); TP_END(pb + 3); }
        if (IN(pb + 4)) { TP_BEGIN(pb + 4); KArgs ka = kargs(); unsigned char* ws = ka->ws; const float* xin = (l == 0) ? ka->in[0] : (const float*)(ws + WS_XB);
            pg8::Gemm g{(const bf16*)(ws + WS_MIX), (const bf16*)(ws + WS_WOUT) + (size_t)l * DM * DM, M, DM, DM}; pg8::StaticOrder S; S.init(M, DM, G, bx);
            pg8::EpiResid E{xin, ka->out, DM, (bf16*)(ws + WS_XN), (float*)(ws + WS_CTL) + CW_SSQ + (2 * l + 1) * M, (float*)(ws + WS_SSP) + (size_t)(2 * l) * M * 16, (unsigned*)(ws + WS_CTL) + CW_PCNT + (2 * l) * 32 * 64, (LAS float*)(lds + XL_OFF), DM / 256, M, 1.0f / DM, NORM_EPS};
            pg8::gemm_phase<pg8::EpiResid, pg8::StaticOrder, true, true, true>(lds + RING_OFF, g, S, E, fresh_tid(wave0));
            p0_prologue(ws, lds, vcu, NGW, wave0, l, 2);
            if (BOTH(pb + 4)) GRID_BAR(); TP_END(pb + 4); }
        if (IN(pb + 5)) { TP_BEGIN(pb + 5); unsigned char* ws = kargs()->ws;
            pg8::Gemm g{(const bf16*)(ws + WS_XN), (const bf16*)(ws + WS_WGU) + (size_t)l * NGU * DM, M, NGU, DM}; pg8::StaticOrder S; S.init(M, NGU, G, bx);
            pg8::EpiSwiGLU E{(bf16*)(ws + WS_HB), FF, (const float*)(ws + WS_CTL) + CW_SSQ + (2 * l + 1) * M, 1.0f / DM, NORM_EPS, M};
            for (int rep = 0; rep < REPS(6); ++rep) pg8::gemm_phase<pg8::EpiSwiGLU, pg8::StaticOrder, true, true, true>(lds + RING_OFF, g, S, E, fresh_tid(wave0));
            p0_prologue(ws, lds, vcu, NGW, wave0, l, 3);
            if (BOTH(pb + 5)) GRID_BAR(); TP_END(pb + 5); }
        if (IN(pb + 6)) { TP_BEGIN(pb + 6); KArgs ka = kargs(); unsigned char* ws = ka->ws; const bool lastl = (l == DEPTH - 1); float* x2 = lastl ? ka->out : (float*)(ws + WS_XB);
            pg8::Gemm g{(const bf16*)(ws + WS_HB), (const bf16*)(ws + WS_WD) + (size_t)l * DM * FF, M, DM, FF}; pg8::StaticOrder S; S.init(M, DM, G, bx);
            pg8::EpiResid E{ka->out, x2, DM, lastl ? (bf16*)nullptr : (bf16*)(ws + WS_XN), (float*)(ws + WS_CTL) + CW_SSQ + (2 * l + 2) * M, (float*)(ws + WS_SSP) + (size_t)(2 * l + 1) * M * 16, (unsigned*)(ws + WS_CTL) + CW_PCNT + (2 * l + 1) * 32 * 64, (LAS float*)(lds + XL_OFF), DM / 256, M, 1.0f / DM, NORM_EPS};
            pg8::gemm_phase<pg8::EpiResid, pg8::StaticOrder, true, true, true>(lds + RING_OFF, g, S, E, fresh_tid(wave0));
              TP_END(pb + 6); }
    }
    if (MK_TIME_PHASE >= 0 && blockIdx.x == 0) { const unsigned long long t0 = __builtin_amdgcn_s_memrealtime(); while (__builtin_amdgcn_s_memrealtime() - t0 < tpD) __builtin_amdgcn_s_sleep(8); }
#undef IN
#undef BOTH
}

extern "C" void kernel_launch(void* const* d_in, const int* in_sizes, int n_in, void* d_out, int out_size, void* d_ws, size_t ws_size, hipStream_t stream) {
    static int grid = 0;
    if (grid == 0) {
        if (n_in != 20 || in_sizes[0] != M * DM || out_size != M * DM || ws_size < WS_END) { fprintf(stderr, "kernel_launch: unexpected shapes (n_in %d, in0 %d, out %d, ws %zu < %zu); nothing launched\n", n_in, n_in > 0 ? in_sizes[0] : -1, out_size, ws_size, (size_t)WS_END); grid = -1; return; }
        int dev = 0, cus = 0, per_cu = 0;
        if (hipGetDevice(&dev) != hipSuccess || hipDeviceGetAttribute(&cus, hipDeviceAttributeMultiprocessorCount, dev) != hipSuccess) { grid = -1; return; }
        if (hipFuncSetAttribute((const void*)mk_fwd, hipFuncAttributeMaxDynamicSharedMemorySize, LDS_BYTES) != hipSuccess) { fprintf(stderr, "kernel_launch: hipFuncSetAttribute failed\n"); grid = -1; return; }
        if (hipOccupancyMaxActiveBlocksPerMultiprocessor(&per_cu, (const void*)mk_fwd, NWAVES * 64, LDS_BYTES) != hipSuccess || per_cu < 1) fprintf(stderr, "kernel_launch: occupancy query says %d\n", per_cu);
        (void)hipGetLastError();
        grid = cus;
    }
    if (grid < 0) return;
    if (hipMemsetAsync((char*)d_ws + WS_CTL, 0, CTL_ZERO_BYTES, stream) != hipSuccess) return;
    Args a{};
    for (int i = 0; i < 20; ++i) a.in[i] = (const float*)d_in[i];
    a.out = (float*)d_out; a.ws = (unsigned char*)d_ws;
    if (MK_N_LAUNCHES == 1) { a.ph_lo = 0; a.ph_hi = NPH; hipLaunchKernelGGL(mk_fwd, dim3(grid), dim3(NWAVES * 64), LDS_BYTES, stream, a); }
    else for (int p = 0; p < NPH; ++p) { a.ph_lo = p; a.ph_hi = p + 1; hipLaunchKernelGGL(mk_fwd, dim3(grid), dim3(NWAVES * 64), LDS_BYTES, stream, a); }
}
```
